# Optimizing an MI355X kernel written in HIP

```python
import jax, jax.numpy as jnp
from jax import lax
import numpy as np

D_MODEL = 2048
BATCH = 4
SEQ = 8192
DEPTH = 1

GRID_W = 64
EPS = 1e-6
ROPE_THETA = 10000.0
DA_HEADS = 4
DA_HEAD_DIM = 128
DA_WIDTH = DA_HEADS * 2 * DA_HEAD_DIM
Q_BLOCK = 128
NA_HEADS = 8
NA_HEAD_DIM = 128
NA_WIDTH = NA_HEADS * NA_HEAD_DIM
NA_KH_MAX = 8
NA_KW = 16
D_FF = 4 * D_MODEL
N_BRANCHES = 2
IN_SPLITS = [DA_WIDTH, DA_WIDTH, DA_WIDTH, NA_WIDTH, NA_WIDTH, NA_WIDTH, N_BRANCHES * D_MODEL]
IN_COLS = sum(IN_SPLITS)

kernel_name = "hybrid_diffattn_neighattn_gated_encoder"


def rms_norm(x, w):
    xf = x.astype(jnp.float32)
    y = xf * lax.rsqrt(jnp.mean(xf * xf, axis=-1, keepdims=True) + EPS)
    return (y * w.astype(jnp.float32)).astype(x.dtype)


def rope_tables(seq, dim):
    inv = 1.0 / (ROPE_THETA ** (jnp.arange(0, dim, 2, dtype=jnp.float32) / dim))
    ang = jnp.arange(seq, dtype=jnp.float32)[:, None] * inv[None, :]
    return jnp.cos(ang), jnp.sin(ang)


def apply_rope(x, cos, sin):
    xf = x.astype(jnp.float32)
    x1, x2 = jnp.split(xf, 2, axis=-1)
    c = cos[:, None, None, :]
    s = sin[:, None, None, :]
    out = jnp.concatenate([x1 * c - x2 * s, x2 * c + x1 * s], axis=-1)
    return out.astype(x.dtype)


def diff_attention(q, k, v, lam):
    B, S, H, _, d = q.shape
    nb = S // Q_BLOCK
    qb = q.reshape(B, nb, Q_BLOCK, H, 2, d).transpose(1, 0, 2, 3, 4, 5)
    scale = d ** -0.5

    def block(qi):
        s = jnp.einsum('bqhcd,bkhcd->bhcqk', qi, k, preferred_element_type=jnp.float32) * scale
        p = jax.nn.softmax(s, axis=-1)
        p = p[:, :, 0] - lam * p[:, :, 1]
        return jnp.einsum('bhqk,bkhe->bqhe', p.astype(v.dtype), v)

    o = lax.map(block, qb)
    return o.transpose(1, 0, 2, 3, 4).reshape(B, S, H, 2 * d)


def neighbourhood_attention(q, k, v, rpb):
    B, S, H, d = q.shape
    rows = S // GRID_W
    kh = min(NA_KH_MAX, rows)
    qg = q.reshape(B, rows, GRID_W, H, d).transpose(1, 0, 2, 3, 4)
    kg = k.reshape(B, rows, GRID_W, H, d)
    vg = v.reshape(B, rows, GRID_W, H, d)
    col = jnp.arange(GRID_W)
    col_start = jnp.clip(col - NA_KW // 2, 0, GRID_W - NA_KW)
    col_idx = col_start[:, None] + jnp.arange(NA_KW)[None, :]
    dc = col_idx - col[:, None] + (NA_KW - 1)
    row_ids = jnp.arange(rows)
    row_start = jnp.clip(row_ids - kh // 2, 0, rows - kh)
    scale = d ** -0.5

    def row_block(args):
        qr, r, rs = args
        kb = lax.dynamic_slice_in_dim(kg, rs, kh, axis=1)
        vb = lax.dynamic_slice_in_dim(vg, rs, kh, axis=1)
        kw = kb[:, :, col_idx]
        vw = vb[:, :, col_idx]
        dr = rs + jnp.arange(kh) - r + (NA_KH_MAX - 1)
        bias = rpb[:, dr[None, :, None], dc[:, None, :]]
        s = jnp.einsum('bqhd,bnqwhd->bhqnw', qr, kw, preferred_element_type=jnp.float32) * scale
        s = s + bias.astype(jnp.float32)[None]
        p = jax.nn.softmax(s, axis=(-2, -1))
        return jnp.einsum('bhqnw,bnqwhd->bqhd', p.astype(v.dtype), vw)

    o = lax.map(row_block, (qg, row_ids, row_start))
    return o.transpose(1, 0, 2, 3, 4).reshape(B, S, H, d)


def setup_inputs(seed: int = 0) -> dict:
    key = jax.random.key(seed)
    ks = jax.random.split(key, 20)
    f32 = jnp.float32

    def nrm(k, shape, scale):
        return jax.random.normal(k, shape, f32) * scale

    def gain(k, n):
        return 1.0 + 0.05 * jax.random.normal(k, (DEPTH, n), f32)

    return {
        "x": jax.random.normal(ks[0], (BATCH, SEQ, D_MODEL), f32),
        "w_in": nrm(ks[1], (DEPTH, D_MODEL, IN_COLS), D_MODEL ** -0.5),
        "w_branch_a": nrm(ks[2], (DEPTH, DA_WIDTH, D_MODEL), DA_WIDTH ** -0.5),
        "w_branch_b": nrm(ks[3], (DEPTH, NA_WIDTH, D_MODEL), NA_WIDTH ** -0.5),
        "w_out": nrm(ks[4], (DEPTH, D_MODEL, D_MODEL), D_MODEL ** -0.5),
        "norm_mix_pre": gain(ks[5], D_MODEL),
        "norm_mix_post": gain(ks[6], D_MODEL),
        "norm_mlp_pre": gain(ks[7], D_MODEL),
        "norm_mlp_post": gain(ks[8], D_MODEL),
        "lam_q1": nrm(ks[9], (DEPTH, DA_HEAD_DIM), 0.1),
        "lam_k1": nrm(ks[10], (DEPTH, DA_HEAD_DIM), 0.1),
        "lam_q2": nrm(ks[11], (DEPTH, DA_HEAD_DIM), 0.1),
        "lam_k2": nrm(ks[12], (DEPTH, DA_HEAD_DIM), 0.1),
        "subln_w": gain(ks[13], 2 * DA_HEAD_DIM),
        "na_rpb": nrm(ks[14], (DEPTH, NA_HEADS, 2 * NA_KH_MAX - 1, 2 * NA_KW - 1), 0.1),
        "w_up": nrm(ks[15], (DEPTH, D_MODEL, D_FF), D_MODEL ** -0.5),
        "w_down": nrm(ks[16], (DEPTH, D_FF, D_MODEL), D_FF ** -0.5),
    }


def reference(x, w_in, w_branch_a, w_branch_b, w_out, norm_mix_pre, norm_mix_post,
              norm_mlp_pre, norm_mlp_post, lam_q1, lam_k1, lam_q2, lam_k2, subln_w,
              na_rpb, w_up, w_down):
    B, S, _ = x.shape
    cos, sin = rope_tables(S, DA_HEAD_DIM)
    split_at = [int(c) for c in np.cumsum(IN_SPLITS)[:-1]]
    for l in range(DEPTH):
        lambda_init = 0.8 - 0.6 * float(np.exp(-0.3 * l))
        h = rms_norm(x, norm_mix_pre[l])
        proj = jnp.einsum('bsd,dc->bsc', h, w_in[l])
        qa, ka, va, qn, kn, vn, gates = jnp.split(proj, split_at, axis=-1)
        qa = apply_rope(qa.reshape(B, S, DA_HEADS, 2, DA_HEAD_DIM), cos, sin)
        ka = apply_rope(ka.reshape(B, S, DA_HEADS, 2, DA_HEAD_DIM), cos, sin)
        va = va.reshape(B, S, DA_HEADS, 2 * DA_HEAD_DIM)
        lam = (jnp.exp(jnp.sum(lam_q1[l].astype(jnp.float32) * lam_k1[l].astype(jnp.float32)))
               - jnp.exp(jnp.sum(lam_q2[l].astype(jnp.float32) * lam_k2[l].astype(jnp.float32)))
               + lambda_init)
        oa = diff_attention(qa, ka, va, lam)
        oa = (rms_norm(oa, subln_w[l]) * (1.0 - lambda_init)).reshape(B, S, DA_WIDTH)
        on = neighbourhood_attention(qn.reshape(B, S, NA_HEADS, NA_HEAD_DIM),
                                     kn.reshape(B, S, NA_HEADS, NA_HEAD_DIM),
                                     vn.reshape(B, S, NA_HEADS, NA_HEAD_DIM),
                                     na_rpb[l]).reshape(B, S, NA_WIDTH)
        g_a, g_b = jnp.split(jax.nn.sigmoid(gates), N_BRANCHES, axis=-1)
        mixed = (g_a * jnp.einsum('bsc,cd->bsd', oa, w_branch_a[l])
                 + g_b * jnp.einsum('bsc,cd->bsd', on, w_branch_b[l]))
        y = jnp.einsum('bsd,de->bse', mixed, w_out[l])
        x = x + rms_norm(y, norm_mix_post[l])
        h = rms_norm(x, norm_mlp_pre[l])
        u = jnp.square(jax.nn.relu(jnp.einsum('bsd,df->bsf', h, w_up[l])))
        x = x + rms_norm(jnp.einsum('bsf,fd->bsd', u, w_down[l]), norm_mlp_post[l])
    return x
```

```cpp
#include <hip/hip_runtime.h>
#include <hip/hip_cooperative_groups.h>
#include <cstdio>
#include <cstdint>
#include <cmath>
namespace cg = cooperative_groups;
namespace pg8 {
#define PG8_LAS __attribute__((address_space(3)))
typedef unsigned short bf16_t;
typedef short bf16x8 __attribute__((ext_vector_type(8)));
typedef float f32x4 __attribute__((ext_vector_type(4)));
typedef unsigned u32x4 __attribute__((ext_vector_type(4)));
constexpr int BM = 256, BK = 64, HALF = 128, HTB = HALF * BK * 2  , STAGE_BYTES = 8 * HTB, NXCD = 8, WGM = 8;

__host__ __device__ __forceinline__ int lds_byte(int r, int c) { const int st = (r >> 4) * 2 + (c >> 5), rr = r & 15, cc = c & 31, ob = rr * 64 + cc * 2; return st * 1024 + (ob ^ (((ob >> 9) & 1) << 5)); }
__host__ __device__ __forceinline__ void stage_rc(int b, int& R, int& C) { const int st = b / 1024, sb = b % 1024, swz = sb ^ (((sb >> 9) & 1) << 5); R = (st >> 1) * 16 + swz / 64; C = (st & 1) * 32 + (swz % 64) / 2; }
__host__ __device__ __forceinline__ int perm32(int rho) { const int n = rho >> 4, i = rho & 15; return 8 * (i >> 2) + 4 * n + (i & 3); }

struct Unit { int pm, pn; };
struct Gemm { const bf16_t* A; const bf16_t* Bt; int M, N, K; };

struct StaticOrder {
    int nM, nN, nwg, G, c;
    __host__ __device__ void init(int M, int N, int G_, int c_) { nM = M / BM; nN = N / BM; nwg = nM * nN; G = G_; c = c_; }
    __host__ __device__ bool next(int i, Unit& u) const {
        const long L = (long)i * G + c; if (L >= nwg) return false;
        int wgid = (int)L; { const int q = nwg / NXCD, r = nwg % NXCD, xcd = wgid % NXCD, off = wgid / NXCD; wgid = (xcd < r ? xcd * (q + 1) : r * (q + 1) + (xcd - r) * q) + off; }
        const int nig = WGM * nN, gid = wgid / nig, fm = gid * WGM, gsz = (nM - fm) < WGM ? (nM - fm) : WGM;
        u.pm = fm + ((wgid % nig) % gsz); u.pn = (wgid % nig) / gsz; return true;
    }
    __device__ __forceinline__ void a_ready(const Unit&) const {}
    __device__ __forceinline__ void done(const Unit&) const {}
};

typedef __bf16 bf16x2_t __attribute__((ext_vector_type(2))); typedef float f32x2_t __attribute__((ext_vector_type(2)));
__device__ __forceinline__ unsigned cvt_pk_bf16(float lo, float hi) { f32x2_t v = {lo, hi}; bf16x2_t b = __builtin_convertvector(v, bf16x2_t); return __builtin_bit_cast(unsigned, b); }
__device__ __forceinline__ float bf2f(unsigned short b) { return __uint_as_float(((unsigned)b) << 16); }
__device__ __forceinline__ void unpack8(const u32x4 w, float (&f)[8]) {
    f[0] = __uint_as_float(w.x << 16); f[1] = __uint_as_float(w.x & 0xffff0000u); f[2] = __uint_as_float(w.y << 16); f[3] = __uint_as_float(w.y & 0xffff0000u);
    f[4] = __uint_as_float(w.z << 16); f[5] = __uint_as_float(w.z & 0xffff0000u); f[6] = __uint_as_float(w.w << 16); f[7] = __uint_as_float(w.w & 0xffff0000u);
}
__device__ __forceinline__ u32x4 pack8(const f32x4 v0, const f32x4 v1) { u32x4 w; w.x = cvt_pk_bf16(v0[0], v0[1]); w.y = cvt_pk_bf16(v0[2], v0[3]); w.z = cvt_pk_bf16(v1[0], v1[1]); w.w = cvt_pk_bf16(v1[2], v1[3]); return w; }
__device__ __forceinline__ float sigmoidf_(float v) { return __builtin_amdgcn_rcpf(1.0f + __builtin_amdgcn_exp2f(-1.4426950408889634f * v)); }

struct EpiProj {
    static constexpr bool PERM = true, AFTER_DRAIN = false;
    bf16_t* QKV; bf16_t* G; const float* ropeC; const float* ropeS;
    __device__ __forceinline__ void operator()(const f32x4 (&acc)[2][2][4][2], const Unit& u, int wr, int wc, int fr, int fq) const {
        const int row0 = u.pm * BM + wr * 64 + fr, colt = u.pn * BM, cl = wc * 32 + 8 * fq;
        if (colt < 2048) {
            const int i0 = 16 * wc + 4 * fq;
#pragma unroll
            for (int ai = 0; ai < 2; ++ai)
#pragma unroll
                for (int m = 0; m < 4; ++m) { const int row = row0 + ai * HALF + m * 16, pos = row & 8191;
                    const f32x4 c = *(const f32x4*)(ropeC + (size_t)pos * 64 + i0), s = *(const f32x4*)(ropeS + (size_t)pos * 64 + i0);
                    bf16_t* rowp = QKV + (size_t)row * 6144 + colt + cl;
#pragma unroll
                    for (int bj = 0; bj < 2; ++bj) { const f32x4 v0 = acc[ai][bj][m][0], v1 = acc[ai][bj][m][1]; f32x4 o0, o1;
                        o0[0] = v0[0] * c[0] - v0[1] * s[0]; o0[1] = v0[1] * c[0] + v0[0] * s[0]; o0[2] = v0[2] * c[1] - v0[3] * s[1]; o0[3] = v0[3] * c[1] + v0[2] * s[1];
                        o1[0] = v1[0] * c[2] - v1[1] * s[2]; o1[1] = v1[1] * c[2] + v1[0] * s[2]; o1[2] = v1[2] * c[3] - v1[3] * s[3]; o1[3] = v1[3] * c[3] + v1[2] * s[3];
                        *(u32x4*)(rowp + bj * HALF) = pack8(o0, o1); } }
        } else if (colt < 6144) {
#pragma unroll
            for (int ai = 0; ai < 2; ++ai)
#pragma unroll
                for (int m = 0; m < 4; ++m) { bf16_t* rowp = QKV + (size_t)(row0 + ai * HALF + m * 16) * 6144 + colt + cl;
#pragma unroll
                    for (int bj = 0; bj < 2; ++bj) *(u32x4*)(rowp + bj * HALF) = pack8(acc[ai][bj][m][0], acc[ai][bj][m][1]); }
        } else {
#pragma unroll
            for (int ai = 0; ai < 2; ++ai)
#pragma unroll
                for (int m = 0; m < 4; ++m) { bf16_t* rowp = G + (size_t)(row0 + ai * HALF + m * 16) * 4096 + (colt - 6144) + cl;
#pragma unroll
                    for (int bj = 0; bj < 2; ++bj) { f32x4 v0 = acc[ai][bj][m][0], v1 = acc[ai][bj][m][1];
#pragma unroll
                        for (int j = 0; j < 4; ++j) { v0[j] = sigmoidf_(v0[j]); v1[j] = sigmoidf_(v1[j]); }
                        *(u32x4*)(rowp + bj * HALF) = pack8(v0, v1); } }
        }
    }
};
template <int SECOND> struct EpiBranch {
    static constexpr bool PERM = true, AFTER_DRAIN = false;
    const bf16_t* G; float* T; bf16_t* MX;
    __device__ __forceinline__ void operator()(const f32x4 (&acc)[2][2][4][2], const Unit& u, int wr, int wc, int fr, int fq) const {
        const int row0 = u.pm * BM + wr * 64 + fr, col0 = u.pn * BM + wc * 32 + 8 * fq;
#pragma unroll
        for (int ai = 0; ai < 2; ++ai)
#pragma unroll
            for (int m = 0; m < 4; ++m) { const size_t row = (size_t)(row0 + ai * HALF + m * 16);
#pragma unroll
                for (int bj = 0; bj < 2; ++bj) { const int col = col0 + bj * HALF;
                    const u32x4 gw = *(const u32x4*)(G + row * 4096 + SECOND * 2048 + col); float g[8]; unpack8(gw, g);
                    f32x4 v0 = acc[ai][bj][m][0], v1 = acc[ai][bj][m][1];
#pragma unroll
                    for (int j = 0; j < 4; ++j) { v0[j] *= g[j]; v1[j] *= g[4 + j]; }
                    float* tp = T + row * 2048 + col;
                    if (SECOND == 0) { *(f32x4*)tp = v0; *(f32x4*)(tp + 4) = v1; }
                    else { v0 += *(const f32x4*)tp; v1 += *(const f32x4*)(tp + 4); *(u32x4*)(MX + row * 2048 + col) = pack8(v0, v1); } } }
    }
};
template <typename TO> struct EpiYss {
    static constexpr bool PERM = true, AFTER_DRAIN = false;
    TO* Y; float* SS;
    __device__ __forceinline__ void operator()(const f32x4 (&acc)[2][2][4][2], const Unit& u, int wr, int wc, int fr, int fq) const {
        const int row0 = u.pm * BM + wr * 64 + fr, col0 = u.pn * BM + wc * 32 + 8 * fq;
#pragma unroll
        for (int ai = 0; ai < 2; ++ai)
#pragma unroll
            for (int m = 0; m < 4; ++m) { const size_t row = (size_t)(row0 + ai * HALF + m * 16); float s = 0.f;
#pragma unroll
                for (int bj = 0; bj < 2; ++bj) { const f32x4 v0 = acc[ai][bj][m][0], v1 = acc[ai][bj][m][1];
                    s += (v0[0] * v0[0] + v0[1] * v0[1]) + (v0[2] * v0[2] + v0[3] * v0[3]) + (v1[0] * v1[0] + v1[1] * v1[1]) + (v1[2] * v1[2] + v1[3] * v1[3]);
                    if constexpr (sizeof(TO) == 2) *(u32x4*)((bf16_t*)Y + row * 2048 + col0 + bj * HALF) = pack8(v0, v1);
                    else { float* yp = (float*)Y + row * 2048 + col0 + bj * HALF; *(f32x4*)yp = v0; *(f32x4*)(yp + 4) = v1; } }
                s += __shfl_xor(s, 16); s += __shfl_xor(s, 32);
                if (fq == 0) SS[row * 32 + u.pn * 4 + wc] = s; }
    }
};
struct EpiRelu2 {
    static constexpr bool PERM = true, AFTER_DRAIN = false;
    bf16_t* U; int ldc;
    __device__ __forceinline__ void operator()(const f32x4 (&acc)[2][2][4][2], const Unit& u, int wr, int wc, int fr, int fq) const {
        const int row0 = u.pm * BM + wr * 64 + fr, col0 = u.pn * BM + wc * 32 + 8 * fq;
#pragma unroll
        for (int ai = 0; ai < 2; ++ai)
#pragma unroll
            for (int m = 0; m < 4; ++m) { bf16_t* rowp = U + (size_t)(row0 + ai * HALF + m * 16) * ldc + col0;
#pragma unroll
                for (int bj = 0; bj < 2; ++bj) { f32x4 v0 = acc[ai][bj][m][0], v1 = acc[ai][bj][m][1];
#pragma unroll
                    for (int j = 0; j < 4; ++j) { const float a = fmaxf(v0[j], 0.f), b = fmaxf(v1[j], 0.f); v0[j] = a * a; v1[j] = b * b; }
                    *(u32x4*)(rowp + bj * HALF) = pack8(v0, v1); } }
    }
};

template <class Epi, class Sched, bool ALIGN_EPI = false, bool SP2 = false>
__device__ __forceinline__ void gemm_phase(PG8_LAS unsigned char* lds, const Gemm g, const Sched& S, const Epi& E) {
    const int tid = threadIdx.x, wid = __builtin_amdgcn_readfirstlane(tid >> 6), lane = tid & 63, wr = wid >> 2, wc = wid & 3, fr = lane & 15, fq = lane >> 4;
    const int K = g.K, nt = K / BK;
    unsigned voffA[2], voffB[2];
#pragma unroll
    for (int i = 0; i < 2; ++i) { int R, C; stage_rc(tid * 16 + i * 8192, R, C); const int Rb = Epi::PERM ? ((R & ~31) + perm32(R & 31)) : R;
        voffA[i] = (unsigned)(R * K + C) * 2u; voffB[i] = (unsigned)(Rb * K + C) * 2u; }
    const size_t kstep = (size_t)(BK * 2);
    const size_t hstep = (size_t)HALF * K * 2;
    const size_t tstep = 2 * hstep;
    const unsigned ldsw = (unsigned)wid * 1024u;
    const int aoff = lds_byte(wr * 64 + fr, fq * 8), boff = lds_byte(wc * 32 + fr, fq * 8);
#define PG8_SA(b, h) (((b) * 2 + (h)) * HTB)
#define PG8_SB(b, h) ((4 + (b) * 2 + (h)) * HTB)
#define PG8_STAGE(bufoff, gbase, voff) do { _Pragma("unroll") for (int _i = 0; _i < 2; ++_i) \
        __builtin_amdgcn_global_load_lds((const unsigned*)((const char*)(gbase) + (voff)[_i]), (PG8_LAS unsigned*)(lds + (bufoff) + ldsw + _i * 8192), 16, 0, 0); } while (0)
#define PG8_LDA(dst, b, h) do { _Pragma("unroll") for (int m = 0; m < 4; ++m) _Pragma("unroll") for (int k = 0; k < 2; ++k) dst[m][k] = *(const PG8_LAS bf16x8*)(lds + PG8_SA(b, h) + aoff + m * 2048 + k * 1024); } while (0)
#define PG8_LDB(dst, b, h) do { _Pragma("unroll") for (int n = 0; n < 2; ++n) _Pragma("unroll") for (int k = 0; k < 2; ++k) dst[n][k] = *(const PG8_LAS bf16x8*)(lds + PG8_SB(b, h) + boff + n * 2048 + k * 1024); } while (0)
#define PG8_MMA(ai, bj, At, Bt) do { __builtin_amdgcn_s_setprio(1); _Pragma("unroll") for (int m = 0; m < 4; ++m) _Pragma("unroll") for (int n = 0; n < 2; ++n) _Pragma("unroll") for (int k = 0; k < 2; ++k) \
        acc[ai][bj][m][n] = __builtin_amdgcn_mfma_f32_16x16x32_bf16(Bt[n][k], At[m][k], acc[ai][bj][m][n], 0, 0, 0); __builtin_amdgcn_s_setprio(0); } while (0)
#define PG8_WAIT_V(n) asm volatile("s_waitcnt vmcnt(" #n ")" ::: "memory")
#define PG8_WAIT_L(n) asm volatile("s_waitcnt lgkmcnt(" #n ")" ::: "memory")
#define PG8_BAR __builtin_amdgcn_s_barrier()
#define PG8_SCHED __builtin_amdgcn_sched_barrier(0)
    Unit cur, nxt; int ui = 0;
    if (!S.next(0, cur)) return;
    f32x4 acc[2][2][4][2];
#pragma unroll
    for (int a = 0; a < 2; ++a)
#pragma unroll
        for (int b = 0; b < 2; ++b)
#pragma unroll
            for (int m = 0; m < 4; ++m)
#pragma unroll
                for (int n = 0; n < 2; ++n) acc[a][b][m][n] = (f32x4){0.f, 0.f, 0.f, 0.f};
    bf16x8 At[4][2], B0[2][2], B1[2][2];
    const char* cA = (const char*)g.A + (size_t)cur.pm * tstep; const char* cB = (const char*)g.Bt + (size_t)cur.pn * tstep;
    S.a_ready(cur);
    if constexpr (SP2) {
        PG8_STAGE(PG8_SB(0, 0), cB, voffB); PG8_STAGE(PG8_SB(0, 1), cB + hstep, voffB); PG8_STAGE(PG8_SA(0, 0), cA, voffA); PG8_STAGE(PG8_SA(0, 1), cA + hstep, voffA);
        if (wr == 1) PG8_BAR;
        PG8_WAIT_V(2); PG8_BAR;
        PG8_STAGE(PG8_SB(1, 0), cB + kstep, voffB); PG8_STAGE(PG8_SA(1, 0), cA + kstep, voffA); PG8_STAGE(PG8_SB(1, 1), cB + hstep + kstep, voffB);
        PG8_WAIT_V(6); PG8_BAR;
    } else {
        PG8_STAGE(PG8_SB(0, 0), cB, voffB); PG8_STAGE(PG8_SA(0, 0), cA, voffA); PG8_STAGE(PG8_SB(0, 1), cB + hstep, voffB); PG8_STAGE(PG8_SA(0, 1), cA + hstep, voffA);
        if (wr == 1) PG8_BAR;
        PG8_WAIT_V(4); PG8_BAR;
        PG8_STAGE(PG8_SB(1, 0), cB + kstep, voffB); PG8_STAGE(PG8_SA(1, 0), cA + kstep, voffA); PG8_STAGE(PG8_SB(1, 1), cB + hstep + kstep, voffB);
        PG8_WAIT_V(6); PG8_BAR;
    }
    for (;;) {
        const bool has_next = S.next(ui + 1, nxt);
        const char* nA = has_next ? (const char*)g.A + (size_t)nxt.pm * tstep : cA; const char* nB = has_next ? (const char*)g.Bt + (size_t)nxt.pn * tstep : cB;
        for (int t = 0; t < nt; t += 2) {
            const bool last = (t == nt - 2);
            const char* a1 = cA + (size_t)(t + 1) * kstep;
            const char* a2 = last ? nA : cA + (size_t)(t + 2) * kstep; const char* b2 = last ? nB : cB + (size_t)(t + 2) * kstep;
            const char* a3 = a2 + kstep; const char* b3 = b2 + kstep;
            if (last && has_next) S.a_ready(nxt);
            if constexpr (SP2) {
            PG8_LDB(B0, 0, 0); PG8_LDB(B1, 0, 1); PG8_SCHED; PG8_LDA(At, 0, 0); PG8_STAGE(PG8_SA(1, 1), a1 + hstep, voffA);
            PG8_WAIT_V(8); PG8_WAIT_L(0); PG8_BAR; PG8_MMA(0, 0, At, B0); PG8_MMA(0, 1, At, B1); PG8_BAR; PG8_SCHED;
            PG8_LDA(At, 0, 1); PG8_STAGE(PG8_SB(0, 0), b2, voffB); PG8_STAGE(PG8_SB(0, 1), b2 + hstep, voffB); PG8_STAGE(PG8_SA(0, 0), a2, voffA);
            PG8_WAIT_V(8); PG8_WAIT_L(0); PG8_BAR; PG8_MMA(1, 0, At, B0); PG8_MMA(1, 1, At, B1); PG8_BAR; PG8_SCHED;
            PG8_LDB(B0, 1, 0); PG8_LDB(B1, 1, 1); PG8_SCHED; PG8_LDA(At, 1, 0); PG8_STAGE(PG8_SA(0, 1), a2 + hstep, voffA);
            PG8_WAIT_V(8); PG8_WAIT_L(0); PG8_BAR; PG8_MMA(0, 0, At, B0); PG8_MMA(0, 1, At, B1); PG8_BAR; PG8_SCHED;
            PG8_LDA(At, 1, 1); PG8_STAGE(PG8_SB(1, 0), b3, voffB); PG8_STAGE(PG8_SB(1, 1), b3 + hstep, voffB); PG8_STAGE(PG8_SA(1, 0), a3, voffA);
            PG8_WAIT_V(8); PG8_WAIT_L(0); PG8_BAR; PG8_MMA(1, 0, At, B0); PG8_MMA(1, 1, At, B1); PG8_BAR; PG8_SCHED;
            } else {
            PG8_LDB(B0, 0, 0); PG8_SCHED; PG8_LDA(At, 0, 0); PG8_STAGE(PG8_SA(1, 1), a1 + hstep, voffA);
            PG8_WAIT_L(8); PG8_BAR; PG8_WAIT_L(0); PG8_MMA(0, 0, At, B0); PG8_BAR; PG8_SCHED;
            PG8_LDB(B1, 0, 1); PG8_STAGE(PG8_SB(0, 0), b2, voffB);
            PG8_BAR; PG8_WAIT_L(0); PG8_MMA(0, 1, At, B1); PG8_BAR;
            PG8_LDA(At, 0, 1); PG8_STAGE(PG8_SA(0, 0), a2, voffA);
            PG8_BAR; PG8_WAIT_L(0); PG8_MMA(1, 0, At, B0); PG8_BAR; PG8_SCHED;
            PG8_STAGE(PG8_SB(0, 1), b2 + hstep, voffB);
            PG8_WAIT_V(6); PG8_BAR; PG8_MMA(1, 1, At, B1); PG8_BAR;
            PG8_LDB(B0, 1, 0); PG8_SCHED; PG8_LDA(At, 1, 0); PG8_STAGE(PG8_SA(0, 1), a2 + hstep, voffA);
            PG8_WAIT_L(8); PG8_BAR; PG8_WAIT_L(0); PG8_MMA(0, 0, At, B0); PG8_BAR; PG8_SCHED;
            PG8_LDB(B1, 1, 1); PG8_STAGE(PG8_SB(1, 0), b3, voffB);
            PG8_BAR; PG8_WAIT_L(0); PG8_MMA(0, 1, At, B1); PG8_BAR;
            PG8_LDA(At, 1, 1); PG8_STAGE(PG8_SA(1, 0), a3, voffA);
            PG8_BAR; PG8_WAIT_L(0); PG8_MMA(1, 0, At, B0); PG8_BAR; PG8_SCHED;
            PG8_STAGE(PG8_SB(1, 1), b3 + hstep, voffB);
            PG8_WAIT_V(6); PG8_BAR; PG8_MMA(1, 1, At, B1); PG8_BAR;
            }
        }
        if constexpr (ALIGN_EPI) { if (wr == 0) PG8_BAR; }
        if constexpr (!Epi::AFTER_DRAIN) { E(acc, cur, wr, wc, fr, fq); S.done(cur); }
        if (!has_next) break;
#pragma unroll
        for (int a = 0; a < 2; ++a)
#pragma unroll
            for (int b = 0; b < 2; ++b)
#pragma unroll
                for (int m = 0; m < 4; ++m)
#pragma unroll
                    for (int n = 0; n < 2; ++n) acc[a][b][m][n] = (f32x4){0.f, 0.f, 0.f, 0.f};
        cur = nxt; cA = nA; cB = nB; ++ui;
        if constexpr (ALIGN_EPI) { if (wr == 1) PG8_BAR; }
    }
    PG8_WAIT_V(0);
    if constexpr (!ALIGN_EPI) { if (wr == 0) PG8_BAR; }
    PG8_BAR;
    if constexpr (Epi::AFTER_DRAIN) { E.fused(acc, cur, wr, wc, fr, fq, lds, wid, lane); S.done(cur); }
#undef PG8_SA
#undef PG8_SB
#undef PG8_STAGE
#undef PG8_LDA
#undef PG8_LDB
#undef PG8_MMA
#undef PG8_WAIT_V
#undef PG8_WAIT_L
#undef PG8_BAR
#undef PG8_SCHED
}
}
namespace att {
using bf16 = unsigned short;
constexpr int   D = 128, NW = 8, QBLK = 32, KVBLK = 64;
constexpr float SCALE = 0.088388347648318440f;
constexpr float THR = 8.f;
constexpr int SDEPTH = 2;
constexpr int LDQ = 6144, LDK = 6144, LDO = 2048;
constexpr size_t SHM_V = KVBLK * D * 2, SHM_K = KVBLK * D * 2, SHM_ATTN = 2 * SHM_V + 2 * SHM_K + NW * 64 * 4;
using bf16x8 = __attribute__((ext_vector_type(8))) short;
using s16x4  = __attribute__((ext_vector_type(4))) short;
using f32x16 = __attribute__((ext_vector_type(16))) float;
using f32x8  = __attribute__((ext_vector_type(8))) float;
using u32x4  = __attribute__((ext_vector_type(4))) unsigned;
#define KSWZ(row, colB) ((row) * 256 + ((colB) ^ (((row) & 7) << 4)))
#define SBAR() __builtin_amdgcn_sched_barrier(0)
__device__ __forceinline__ int crow(int r, int hi) { return (r & 3) + 8 * (r >> 2) + 4 * hi; }
__device__ __forceinline__ unsigned cvtpk(float lo, float hi) {
  unsigned r; asm volatile("v_cvt_pk_bf16_f32 %0, %1, %2" : "=v"(r) : "v"(lo), "v"(hi)); return r;
}
template <typename TIn> struct Stage;
template <> struct Stage<bf16>  { using T = bf16x8;
  __device__ static __forceinline__ T ld8(const bf16* p) { return *reinterpret_cast<const bf16x8*>(p); }
  __device__ static __forceinline__ bf16x8 tobf(T x) { return x; } };
template <> struct Stage<float> { using T = f32x8;
  __device__ static __forceinline__ T ld8(const float* p) { return *reinterpret_cast<const f32x8*>(p); }
  __device__ static __forceinline__ bf16x8 tobf(T x) {
    u32x4 w = {cvtpk(x[0], x[1]), cvtpk(x[2], x[3]), cvtpk(x[4], x[5]), cvtpk(x[6], x[7])}; return *reinterpret_cast<bf16x8*>(&w); } };

__device__ __forceinline__ void partialSM(f32x16& p0, f32x16& p1, float& m_reg, float& mn, float& alpha) {
  constexpr float C = SCALE * 1.4426950408889634f;
  float pmax = p0[0]; for (int r = 1; r < 16; ++r) pmax = fmaxf(pmax, p0[r]); for (int r = 0; r < 16; ++r) pmax = fmaxf(pmax, p1[r]);
  { auto rr = __builtin_amdgcn_permlane32_swap(__float_as_uint(pmax), __float_as_uint(pmax), false, false);
    pmax = fmaxf(__uint_as_float(rr[0]), __uint_as_float(rr[1])); }
  if (__builtin_expect(__all(pmax - m_reg <= THR / SCALE), 1)) { mn = m_reg; alpha = 1.f; }
  else { mn = fmaxf(m_reg, pmax); alpha = __builtin_amdgcn_exp2f((m_reg - mn) * C); m_reg = mn; }
  float mnC = -mn * C;
  for (int r = 0; r < 16; ++r) p0[r] = fmaf(p0[r], C, mnC); for (int r = 0; r < 16; ++r) p1[r] = fmaf(p1[r], C, mnC);
  for (int r = 0; r < 16; ++r) p0[r] = __builtin_amdgcn_exp2f(p0[r]);
}
__device__ __forceinline__ void finishSM(f32x16& p0, f32x16& p1, float alpha, float& l_reg, bf16x8& pa0, bf16x8& pa1, bf16x8& pa2, bf16x8& pa3) {
  for (int r = 0; r < 16; ++r) p1[r] = __builtin_amdgcn_exp2f(p1[r]);
  float ps = 0; for (int r = 0; r < 16; ++r) ps += p0[r]; for (int r = 0; r < 16; ++r) ps += p1[r];
  { auto rr = __builtin_amdgcn_permlane32_swap(__float_as_uint(ps), __float_as_uint(ps), false, false);
    ps = __uint_as_float(rr[0]) + __uint_as_float(rr[1]); }
  l_reg = l_reg * alpha + ps;
#define PK4(P, BASE, OUT) do { unsigned a0 = cvtpk(P[BASE + 0], P[BASE + 1]), a1 = cvtpk(P[BASE + 2], P[BASE + 3]);   \
    unsigned b0 = cvtpk(P[BASE + 4], P[BASE + 5]), b1 = cvtpk(P[BASE + 6], P[BASE + 7]);                              \
    auto r0 = __builtin_amdgcn_permlane32_swap(a0, b0, false, false); auto r1 = __builtin_amdgcn_permlane32_swap(a1, b1, false, false); \
    u32x4 w = {r0[0], r1[0], r0[1], r1[1]}; OUT = *reinterpret_cast<bf16x8*>(&w); } while (0)
  PK4(p0, 0, pa0); PK4(p0, 8, pa1); PK4(p1, 0, pa2); PK4(p1, 8, pa3);
#undef PK4
}
__device__ __forceinline__ void qkt(f32x16& p0, f32x16& p1, const bf16* Ks, const bf16x8* qr, int r32, int hi) {
  p0 = f32x16{}; p1 = f32x16{};
  for (int d0 = 0; d0 < 8; ++d0) { int cb = (d0 * 16 + hi * 8) * 2;
    bf16x8 b0 = *reinterpret_cast<const bf16x8*>((const char*)Ks + KSWZ(r32, cb));
    bf16x8 b1 = *reinterpret_cast<const bf16x8*>((const char*)Ks + KSWZ(32 + r32, cb));
    p0 = __builtin_amdgcn_mfma_f32_32x32x16_bf16(b0, qr[d0], p0, 0, 0, 0);
    p1 = __builtin_amdgcn_mfma_f32_32x32x16_bf16(b1, qr[d0], p1, 0, 0, 0); }
}
__device__ __forceinline__ int v_st(int k, int c) { const int kk = (k & ~0xC) | ((k & 4) << 1) | ((k & 8) >> 1); return ((kk >> 3) * 4 + (c >> 5)) * 512 + ((kk & 7) * 32 + (c & 31)) * 2; }
__device__ __forceinline__ int v_rd_base(int lane) { return ((lane & 3) << 3) | (((lane >> 2) & 3) << 6) | (((lane >> 4) & 1) << 5) | (((lane >> 5) & 1) << 8); }
constexpr int v_rd_off(int d0, int ks, int half) { return d0 * 512 + ks * 4096 + half * 2048; }
template <int OFF> __device__ __forceinline__ s16x4 tr_read(int vb) {
  s16x4 r; asm volatile("ds_read_b64_tr_b16 %0, %1 offset:%2" : "=&v"(r) : "v"(vb), "i"(OFF) : "memory"); return r;
}
template <int D0> __device__ __forceinline__ void pv_one(f32x16& od, int vb, bf16x8 pa0, bf16x8 pa1, bf16x8 pa2, bf16x8 pa3) {
  const s16x4 l0 = tr_read<v_rd_off(D0, 0, 0)>(vb), h0 = tr_read<v_rd_off(D0, 0, 1)>(vb), l1 = tr_read<v_rd_off(D0, 1, 0)>(vb), h1 = tr_read<v_rd_off(D0, 1, 1)>(vb);
  const s16x4 l2 = tr_read<v_rd_off(D0, 2, 0)>(vb), h2 = tr_read<v_rd_off(D0, 2, 1)>(vb), l3 = tr_read<v_rd_off(D0, 3, 0)>(vb), h3 = tr_read<v_rd_off(D0, 3, 1)>(vb);
  asm volatile("s_waitcnt lgkmcnt(0)" ::: "memory"); SBAR();
#define PK(L, H) (bf16x8){L[0], L[1], L[2], L[3], H[0], H[1], H[2], H[3]}
  od = __builtin_amdgcn_mfma_f32_32x32x16_bf16(pa0, PK(l0, h0), od, 0, 0, 0);
  od = __builtin_amdgcn_mfma_f32_32x32x16_bf16(pa1, PK(l1, h1), od, 0, 0, 0);
  od = __builtin_amdgcn_mfma_f32_32x32x16_bf16(pa2, PK(l2, h2), od, 0, 0, 0);
  od = __builtin_amdgcn_mfma_f32_32x32x16_bf16(pa3, PK(l3, h3), od, 0, 0, 0);
#undef PK
}
__device__ __forceinline__ void pv_d0(f32x16* o, int vb, bf16x8 pa0, bf16x8 pa1, bf16x8 pa2, bf16x8 pa3) {
  pv_one<0>(o[0], vb, pa0, pa1, pa2, pa3); pv_one<1>(o[1], vb, pa0, pa1, pa2, pa3); pv_one<2>(o[2], vb, pa0, pa1, pa2, pa3); pv_one<3>(o[3], vb, pa0, pa1, pa2, pa3);
}

template <typename TQ>
__device__ __forceinline__ void attn_dense_body(const TQ* __restrict__ Qb, const bf16* __restrict__ Kh, const bf16* __restrict__ Vh,
                                                bf16* __restrict__ Ob, int seq, char* lds) {
  using St = Stage<bf16>; using SQ = Stage<TQ>;
  const int tid = threadIdx.x, wid = tid >> 6, lane = tid & 63, r32 = lane & 31, hi = lane >> 5;
  bf16* V_lds = (bf16*)lds; bf16* K_lds = (bf16*)(lds + 2 * SHM_V);
  float* ws = (float*)(lds + 2 * SHM_V + 2 * SHM_K) + wid * 64; float* li_l = ws; float* al_l = ws + 32;
  float m_reg = -1e30f, l_reg = 0; f32x16 o[4] = {}; bf16x8 qr[8];
  const TQ* Qw = Qb + (long)(wid * QBLK + r32) * LDQ + hi * 8;
#pragma unroll
  for (int d0 = 0; d0 < 8; ++d0) qr[d0] = SQ::tobf(SQ::ld8(Qw + d0 * 16));
  const int sr = tid >> 4, sc = (tid & 15) * 8, vst0 = v_st(sr, sc), vst1 = v_st(32 + sr, sc);
  const int vb0 = (int)(uintptr_t)V_lds + v_rd_base(lane);
  struct { typename St::T vs0, vs1, ks0, ks1; } sr_[SDEPTH];
#define SLOAD(i, k0) do { sr_[i].vs0 = St::ld8(&Vh[(long)((k0) + sr) * LDK + sc]); sr_[i].vs1 = St::ld8(&Vh[(long)((k0) + 32 + sr) * LDK + sc]); \
    sr_[i].ks0 = St::ld8(&Kh[(long)((k0) + sr) * LDK + sc]); sr_[i].ks1 = St::ld8(&Kh[(long)((k0) + 32 + sr) * LDK + sc]); } while (0)
#define SWRITE(b, i) do { *(bf16x8*)((char*)V_lds + (b) * SHM_V + vst0) = St::tobf(sr_[i].vs0);          \
    *(bf16x8*)((char*)V_lds + (b) * SHM_V + vst1) = St::tobf(sr_[i].vs1); int kc = sc * 2;               \
    *(bf16x8*)((char*)K_lds + (b) * SHM_K + KSWZ(sr, kc)) = St::tobf(sr_[i].ks0);                       \
    *(bf16x8*)((char*)K_lds + (b) * SHM_K + KSWZ(32 + sr, kc)) = St::tobf(sr_[i].ks1); } while (0)
#define SWAIT() do { if constexpr (SDEPTH == 2) asm volatile("s_waitcnt vmcnt(4)" ::: "memory"); else asm volatile("s_waitcnt vmcnt(0)" ::: "memory"); } while (0)
#define RESC(a) do { if (__any((a) < 1.f)) { if (hi == 0) al_l[r32] = (a); asm volatile("s_waitcnt lgkmcnt(0)" ::: "memory"); \
    for (int d = 0; d < 4; ++d) for (int r = 0; r < 16; ++r) o[d][r] *= al_l[crow(r, hi)]; } } while (0)
  f32x16 pA0, pA1, pB0, pB1; float mnA, mnB, alA, alB; bf16x8 pa0, pa1, pa2, pa3; const int NT = seq / KVBLK;
  constexpr int SE = 0, SO = SDEPTH - 1;
  SLOAD(SE, 0); asm volatile("s_waitcnt vmcnt(0)" ::: "memory"); SWRITE(0, SE); __syncthreads();
  qkt(pA0, pA1, K_lds, qr, r32, hi); partialSM(pA0, pA1, m_reg, mnA, alA);
  SLOAD(SO, KVBLK); if constexpr (SDEPTH == 2) { if (2 < NT) SLOAD(SE, 2 * KVBLK); }
  SWAIT(); SWRITE(1, SO); __syncthreads();
  for (int j = 1; j + 1 < NT; j += 2) {
    SBAR(); qkt(pB0, pB1, (bf16*)((char*)K_lds + SHM_K), qr, r32, hi);
    finishSM(pA0, pA1, alA, l_reg, pa0, pa1, pa2, pa3); SBAR();
    SLOAD(SO, (j + SDEPTH) * KVBLK); SBAR();
    pv_d0(o, vb0, pa0, pa1, pa2, pa3); partialSM(pB0, pB1, m_reg, mnB, alB);
    __syncthreads(); SWAIT(); SWRITE(0, SE);
    RESC(alB); __syncthreads();
    SBAR(); qkt(pA0, pA1, K_lds, qr, r32, hi);
    finishSM(pB0, pB1, alB, l_reg, pa0, pa1, pa2, pa3); SBAR();
    if (SDEPTH == 1 || j + 3 < NT) SLOAD(SE, (j + 1 + SDEPTH) * KVBLK); SBAR();
    pv_d0(o, vb0 + (int)SHM_V, pa0, pa1, pa2, pa3); partialSM(pA0, pA1, m_reg, mnA, alA);
    __syncthreads(); SWAIT(); SWRITE(1, SO);
    RESC(alA); __syncthreads();
  }
  SBAR(); qkt(pB0, pB1, (bf16*)((char*)K_lds + SHM_K), qr, r32, hi);
  finishSM(pA0, pA1, alA, l_reg, pa0, pa1, pa2, pa3); SBAR();
  pv_d0(o, vb0, pa0, pa1, pa2, pa3); partialSM(pB0, pB1, m_reg, mnB, alB);
  __syncthreads(); RESC(alB);
  finishSM(pB0, pB1, alB, l_reg, pa0, pa1, pa2, pa3); SBAR();
  pv_d0(o, vb0 + (int)SHM_V, pa0, pa1, pa2, pa3);
  if (hi == 0) li_l[r32] = l_reg; asm volatile("s_waitcnt lgkmcnt(0)" ::: "memory");
  float rli[16];
#pragma unroll
  for (int r = 0; r < 16; ++r) rli[r] = __builtin_amdgcn_rcpf(li_l[crow(r, hi)]);
  bf16* Ow = Ob + (long)(wid * QBLK) * LDO;
#pragma unroll
  for (int r = 0; r < 16; ++r) { int orow = crow(r, hi);
    for (int d0 = 0; d0 < 4; ++d0) Ow[(long)orow * LDO + d0 * 32 + r32] = (bf16)(cvtpk(o[d0][r] * rli[r], 0.f) & 0xffffu); }
#undef SLOAD
#undef SWRITE
#undef SWAIT
#undef RESC
}

__device__ __forceinline__ void na_unit(const bf16* __restrict__ QKV, bf16* __restrict__ ON, const float* __restrict__ rpb, int b, int h, int rblk, char* lds) {
  constexpr float C = SCALE * 1.4426950408889634f, L2E = 1.4426950408889634f;
  const int tid = threadIdx.x, wid = tid >> 6, lane = tid & 63, r32 = lane & 31, hi = lane >> 5;
  bf16* V_lds = (bf16*)lds; bf16* K_lds = (bf16*)(lds + SHM_V);
  float* wsf = (float*)(lds + SHM_V + SHM_K) + wid * 64; float* li_l = wsf; float* al_l = wsf + 32;
  float* biasL = (float*)(lds + SHM_V + SHM_K + NW * 64 * 4);
  const int r = rblk * 4 + (wid >> 1), c = (wid & 1) * 32 + r32;
  const int rs = min(max(r - 4, 0), 120), cs = min(max(c - 8, 0), 48);
  const long tok = (long)b * 8192 + r * 64 + c;
  bf16x8 qr[8];
  { const bf16* Qw = QKV + tok * 6144 + 3072 + h * 128 + hi * 8;
#pragma unroll
    for (int d0 = 0; d0 < 8; ++d0) qr[d0] = *reinterpret_cast<const bf16x8*>(Qw + d0 * 16); }
  for (int idx = tid; idx < 15 * 32; idx += 512) { const int dr = idx >> 5, dc = idx & 31; biasL[idx] = dc < 31 ? rpb[(h * 15 + dr) * 31 + dc] * L2E : 0.f; }
  const int kr_lo = min(max(rblk * 4 - 4, 0), 120), kr_hi = min(max(rblk * 4 + 3 - 4, 0), 120) + 7;
  const int sr = tid >> 4, sc = (tid & 15) * 8, vst0 = v_st(sr, sc), vst1 = v_st(32 + sr, sc);
  const int vb0 = (int)(uintptr_t)V_lds + v_rd_base(lane);
  float m_reg = -1e30f, l_reg = 0.f; f32x16 o[4] = {};
  for (int kr = kr_lo; kr <= kr_hi; ++kr) {
    const bf16* kp = QKV + ((long)b * 8192 + kr * 64) * 6144 + h * 128 + sc;
    const bf16x8 k0 = *reinterpret_cast<const bf16x8*>(kp + (long)sr * 6144 + 4096), k1 = *reinterpret_cast<const bf16x8*>(kp + (long)(32 + sr) * 6144 + 4096);
    const bf16x8 v0 = *reinterpret_cast<const bf16x8*>(kp + (long)sr * 6144 + 5120), v1 = *reinterpret_cast<const bf16x8*>(kp + (long)(32 + sr) * 6144 + 5120);
    __syncthreads();
    *(bf16x8*)((char*)K_lds + KSWZ(sr, sc * 2)) = k0; *(bf16x8*)((char*)K_lds + KSWZ(32 + sr, sc * 2)) = k1;
    *(bf16x8*)((char*)V_lds + vst0) = v0; *(bf16x8*)((char*)V_lds + vst1) = v1;
    __syncthreads();
    if (kr >= rs && kr < rs + 8) {
      f32x16 p0, p1; qkt(p0, p1, K_lds, qr, r32, hi);
      const float* bl = biasL + (kr - r + 7) * 32;
      float pmax = -INFINITY;
#pragma unroll
      for (int rr = 0; rr < 16; ++rr) { const int kc0 = crow(rr, hi), kc1 = kc0 + 32;
        const bool ok0 = (unsigned)(kc0 - cs) < 16u, ok1 = (unsigned)(kc1 - cs) < 16u;
        const float b0 = bl[ok0 ? kc0 - c + 15 : 0], b1 = bl[ok1 ? kc1 - c + 15 : 0];
        p0[rr] = ok0 ? fmaf(p0[rr], C, b0) : -INFINITY; p1[rr] = ok1 ? fmaf(p1[rr], C, b1) : -INFINITY;
        pmax = fmaxf(pmax, fmaxf(p0[rr], p1[rr])); }
      { auto t = __builtin_amdgcn_permlane32_swap(__float_as_uint(pmax), __float_as_uint(pmax), false, false);
        pmax = fmaxf(__uint_as_float(t[0]), __uint_as_float(t[1])); }
      const float mn = fmaxf(m_reg, pmax), alpha = __builtin_amdgcn_exp2f(m_reg - mn); m_reg = mn;
      float ps = 0.f;
#pragma unroll
      for (int rr = 0; rr < 16; ++rr) { p0[rr] = __builtin_amdgcn_exp2f(p0[rr] - mn); p1[rr] = __builtin_amdgcn_exp2f(p1[rr] - mn); ps += p0[rr] + p1[rr]; }
      { auto t = __builtin_amdgcn_permlane32_swap(__float_as_uint(ps), __float_as_uint(ps), false, false);
        ps = __uint_as_float(t[0]) + __uint_as_float(t[1]); }
      l_reg = l_reg * alpha + ps;
      if (hi == 0) al_l[r32] = alpha; asm volatile("s_waitcnt lgkmcnt(0)" ::: "memory");
#pragma unroll
      for (int d = 0; d < 4; ++d)
#pragma unroll
        for (int rr = 0; rr < 16; ++rr) o[d][rr] *= al_l[crow(rr, hi)];
      bf16x8 pa0, pa1, pa2, pa3;
#define PK4(P, BASE, OUT) do { unsigned a0 = cvtpk(P[BASE + 0], P[BASE + 1]), a1 = cvtpk(P[BASE + 2], P[BASE + 3]);   \
    unsigned b0_ = cvtpk(P[BASE + 4], P[BASE + 5]), b1_ = cvtpk(P[BASE + 6], P[BASE + 7]);                              \
    auto r0 = __builtin_amdgcn_permlane32_swap(a0, b0_, false, false); auto r1 = __builtin_amdgcn_permlane32_swap(a1, b1_, false, false); \
    u32x4 w = {r0[0], r1[0], r0[1], r1[1]}; OUT = *reinterpret_cast<bf16x8*>(&w); } while (0)
      PK4(p0, 0, pa0); PK4(p0, 8, pa1); PK4(p1, 0, pa2); PK4(p1, 8, pa3);
#undef PK4
      pv_d0(o, vb0, pa0, pa1, pa2, pa3);
    }
  }
  if (hi == 0) li_l[r32] = l_reg; asm volatile("s_waitcnt lgkmcnt(0)" ::: "memory");
  bf16* Ow = ON + ((long)b * 8192 + r * 64 + (wid & 1) * 32) * 1024 + h * 128;
#pragma unroll
  for (int rr = 0; rr < 16; ++rr) { const int orow = crow(rr, hi); const float rl = __builtin_amdgcn_rcpf(li_l[orow]);
#pragma unroll
    for (int d0 = 0; d0 < 4; ++d0) Ow[(long)orow * 1024 + d0 * 32 + r32] = (bf16)(cvtpk(o[d0][rr] * rl, 0.f) & 0xffffu); }
  __syncthreads();
}
}

constexpr int NWAVES = 8;
constexpr int BATCH = 4, SEQ = 8192, DM = 2048, MTOK = BATCH * SEQ, DFF = 8192, NIN = 10240;
constexpr float EPS = 1e-6f;
constexpr size_t MiB = 1u << 20;
constexpr size_t WS_SS = 0;
constexpr size_t WS_ROPE = 0;
constexpr size_t WS_CTL = 4 * MiB, CTL_ZERO_BYTES = 65536;
constexpr size_t WS_WIN = 8 * MiB, WS_WA = 48 * MiB, WS_WB = 52 * MiB, WS_WOUT = 56 * MiB, WS_WUP = 64 * MiB, WS_WDN = 96 * MiB;
constexpr size_t WS_H1 = 128 * MiB;
constexpr size_t WS_ON = 128 * MiB, WS_OA = 192 * MiB, WS_H2 = 128 * MiB;
constexpr size_t WS_QKV = 256 * MiB;
constexpr size_t WS_T = 256 * MiB, WS_MX = 512 * MiB, WS_U = 256 * MiB;
constexpr size_t WS_G = 640 * MiB;
constexpr size_t WS_OD = 896 * MiB;
constexpr size_t WS_Y = 896 * MiB;
constexpr size_t WS_Y2 = 768 * MiB;
constexpr size_t WS_END = 1024 * MiB;
constexpr int LDS_BYTES = 147456, MISC_OFF = 131072 + 320;

typedef unsigned short bf16;
typedef float f32x4 __attribute__((ext_vector_type(4)));
typedef unsigned u32x4v __attribute__((ext_vector_type(4)));
typedef unsigned u32x2v __attribute__((ext_vector_type(2)));
#define LAS __attribute__((address_space(3)))
#define LDS_WAIT() asm volatile("s_waitcnt lgkmcnt(0)" ::: "memory")

__device__ __forceinline__ unsigned pk2(float lo, float hi) { return pg8::cvt_pk_bf16(lo, hi); }
__device__ __forceinline__ float wave_sum(float v) {
#pragma unroll
    for (int o = 1; o < 64; o <<= 1) v += __shfl_xor(v, o);
    return v;
}
template <bool ROPE> __device__ __forceinline__ void p0_transpose_item(const float* W, int K, int N, bf16* WT, LAS float* scr, int item, int lane) {
    const int nblk = N / 32, kb = item / nblk, nb = item % nblk, k0 = 64 * kb, n0 = 32 * nb;
#pragma unroll 8
    for (int i = 0; i < 32; ++i) { const int kk = 2 * i + (lane >> 5); scr[kk * 33 + (lane & 31)] = W[(size_t)(k0 + kk) * N + n0 + (lane & 31)]; }
    LDS_WAIT(); asm volatile("" ::: "memory");
    const int c = lane & 7;
#pragma unroll
    for (int j = 0; j < 4; ++j) { const int n = (lane >> 3) + 8 * j; const LAS float* s = scr + (8 * c) * 33 + n;
        u32x4v o; o.x = pk2(s[0 * 33], s[1 * 33]); o.y = pk2(s[2 * 33], s[3 * 33]); o.z = pk2(s[4 * 33], s[5 * 33]); o.w = pk2(s[6 * 33], s[7 * 33]);
        int dn = n0 + n;
        if (ROPE && dn < 2048) { const int jj = dn & 127; dn = (dn & ~127) + (jj < 64 ? 2 * jj : 2 * (jj - 64) + 1); }
        *(u32x4v*)(WT + (size_t)dn * K + k0 + 8 * c) = o; }
    LDS_WAIT(); asm volatile("" ::: "memory");
}

#define XB_TMO      128
#define XB_XCNT(j)  (256  + 64 * (j))
#define XB_XSUB(j)  (1280 + 64 * (j))
#define XB_XGEN(j)  (2304 + 64 * (j))
#define XB_TOP      3328
#define XB_TOPGEN   3392
#define XCD_BAR_WORDS 3456
#define XB_SPIN_CAP (1u << 18)

__device__ __forceinline__ unsigned xb_ld(unsigned* p)              { return __hip_atomic_load(p, __ATOMIC_RELAXED, __HIP_MEMORY_SCOPE_AGENT); }
__device__ __forceinline__ unsigned xb_add(unsigned* p, unsigned v) { return __hip_atomic_fetch_add(p, v, __ATOMIC_RELAXED, __HIP_MEMORY_SCOPE_AGENT); }
__device__ __forceinline__ unsigned xb_xcc_id() { return (unsigned)__builtin_amdgcn_s_getreg((3 << 11) | 20) & 0xFu; }
#define XB_SPIN(cond, bar) do { unsigned _sp = 0; while (cond) { __builtin_amdgcn_s_sleep(1); \
    if ((++_sp & 255u) == 0u) { if (xb_ld(&(bar)[XB_TMO])) break; if (_sp > XB_SPIN_CAP) { atomicAdd(&(bar)[XB_TMO], 1u); break; } } } } while (0)

struct XcdBarrier {
    unsigned* bar; unsigned x;
    volatile LAS unsigned* st;
};

__device__ __forceinline__ XcdBarrier xcd_barrier_post(unsigned* bar, volatile LAS unsigned* st) {
    XcdBarrier b; b.bar = bar; b.x = xb_xcc_id(); b.st = st;
    if (threadIdx.x == 0) (void)xb_add(&bar[XB_XCNT(b.x)], 1u);
    return b;
}
__device__ __forceinline__ void xcd_barrier_complete(unsigned* bar, unsigned x, unsigned& nloc, unsigned& nx) {
    const unsigned G = gridDim.x * gridDim.y * gridDim.z;
    unsigned sum, cnt, mine, sp = 0u;
    for (;;) {
        sum = 0u; cnt = 0u; mine = 0u;
#pragma unroll
        for (unsigned j = 0; j < 16; ++j) { const unsigned c = xb_ld(&bar[XB_XCNT(j)]); sum += c; cnt += (c > 0u) ? 1u : 0u; mine = (j == x) ? c : mine; }
        if (sum == G) break;
        __builtin_amdgcn_s_sleep(1);
        if ((++sp & 255u) == 0u) { if (xb_ld(&bar[XB_TMO])) break; if (sp > XB_SPIN_CAP) { atomicAdd(&bar[XB_TMO], 1u); break; } }
    }
    nloc = mine > 0u ? mine : 1u; nx = cnt > 0u ? cnt : 1u;
}

__device__ __forceinline__ void xcd_barrier(const XcdBarrier& b) {
    asm volatile("s_waitcnt vmcnt(0)" ::: "memory");
    __syncthreads();
    if (threadIdx.x == 0) {
        unsigned* bar = b.bar;
        __builtin_amdgcn_s_waitcnt(0);
        unsigned nloc = b.st[0], nx = b.st[1];
        if (nloc == 0u) { xcd_barrier_complete(bar, b.x, nloc, nx); b.st[0] = nloc; b.st[1] = nx; }
        const unsigned old = xb_add(&bar[XB_XSUB(b.x)], 1u);
        const unsigned gen = old / nloc;
        if (old + 1u == (gen + 1u) * nloc) {
            __builtin_amdgcn_fence(__ATOMIC_RELEASE, "agent");
            asm volatile("s_waitcnt vmcnt(0)" ::: "memory");
            const unsigned og = xb_add(&bar[XB_TOP], 1u);
            const unsigned tg = og / nx;
            if (og + 1u == (tg + 1u) * nx) xb_add(&bar[XB_TOPGEN], 1u);
            else XB_SPIN(xb_ld(&bar[XB_TOPGEN]) == tg, bar);
            __builtin_amdgcn_fence(__ATOMIC_ACQUIRE, "agent");
            xb_add(&bar[XB_XGEN(b.x)], 1u);
            asm volatile("s_waitcnt vmcnt(0)" ::: "memory");
        } else {
            XB_SPIN(xb_ld(&bar[XB_XGEN(b.x)]) == gen, bar);
            __builtin_amdgcn_fence(__ATOMIC_ACQUIRE, "agent");
            asm volatile("s_waitcnt vmcnt(0)" ::: "memory");
        }
    }
    __syncthreads();
}

struct Args { const float* in[17]; float* out; unsigned char* ws; int ph_lo, ph_hi; };

__global__ void __launch_bounds__(NWAVES * 64, 2) mk_fwd(Args a) {
    extern __shared__ __attribute__((aligned(16))) unsigned char lds[];
    cg::grid_group grid = cg::this_grid();
    const int tid = threadIdx.x, lane = tid & 63, wave = __builtin_amdgcn_readfirstlane(tid >> 6);
    const int G = gridDim.x, gw = blockIdx.x * NWAVES + wave, NGW = G * NWAVES;
    unsigned char* ws = a.ws;
    const float* x = a.in[0];
    float* out = a.out;
    float* SS = (float*)(ws + WS_SS); float* ropeC = (float*)(ws + WS_ROPE); float* ropeS = ropeC + 8192 * 64;
    bf16* Win_t = (bf16*)(ws + WS_WIN); bf16* Wa_t = (bf16*)(ws + WS_WA); bf16* Wb_t = (bf16*)(ws + WS_WB); bf16* Wout_t = (bf16*)(ws + WS_WOUT); bf16* Wup_t = (bf16*)(ws + WS_WUP); bf16* Wdn_t = (bf16*)(ws + WS_WDN);
    bf16* H1 = (bf16*)(ws + WS_H1); bf16* ONb = (bf16*)(ws + WS_ON); bf16* OAb = (bf16*)(ws + WS_OA); bf16* H2 = (bf16*)(ws + WS_H2);
    bf16* QKV = (bf16*)(ws + WS_QKV); float* Tb = (float*)(ws + WS_T); bf16* MX = (bf16*)(ws + WS_MX); bf16* Ub = (bf16*)(ws + WS_U);
    bf16* Gb = (bf16*)(ws + WS_G); bf16* OD = (bf16*)(ws + WS_OD); bf16* Yb = (bf16*)(ws + WS_Y); float* Y2 = (float*)(ws + WS_Y2);
    const int lo = a.ph_lo, hi = a.ph_hi;
    for (int u = tid; u < (LDS_BYTES - 131072) / 4; u += NWAVES * 64) ((LAS unsigned*)((LAS unsigned char*)lds + 131072))[u] = 0u;
    __syncthreads();
    XcdBarrier bar = xcd_barrier_post((unsigned*)(ws + WS_CTL), (volatile LAS unsigned*)((LAS unsigned char*)lds + MISC_OFF) + 8);
    grid.sync();
#ifndef PHMASK
#define PHMASK 0x3ff
#endif
#define IN(k) (((PHMASK >> (k)) & 1) && lo <= (k) && (k) < hi)
#define SEAM(k) do { if (lo <= (k) && (k) + 1 < hi) xcd_barrier(bar); } while (0)

    if (IN(0)) {
        LAS float* scr = (LAS float*)((LAS unsigned char*)lds + wave * 16384);
        constexpr int I_IN = (DM / 64) * (NIN / 32), I_A = (1024 / 64) * (DM / 32), I_O = (DM / 64) * (DM / 32), I_UP = (DM / 64) * (DFF / 32), I_DN = (DFF / 64) * (DM / 32);
        constexpr int NITEMS = I_IN + 2 * I_A + I_O + I_UP + I_DN;
        for (int it = gw; it < NITEMS; it += NGW) {
            int r = it;
            if (r < I_IN) { p0_transpose_item<true>(a.in[1], DM, NIN, Win_t, scr, r, lane); continue; } r -= I_IN;
            if (r < I_A) { p0_transpose_item<false>(a.in[2], 1024, DM, Wa_t, scr, r, lane); continue; } r -= I_A;
            if (r < I_A) { p0_transpose_item<false>(a.in[3], 1024, DM, Wb_t, scr, r, lane); continue; } r -= I_A;
            if (r < I_O) { p0_transpose_item<false>(a.in[4], DM, DM, Wout_t, scr, r, lane); continue; } r -= I_O;
            if (r < I_UP) { p0_transpose_item<false>(a.in[15], DM, DFF, Wup_t, scr, r, lane); continue; } r -= I_UP;
            p0_transpose_item<false>(a.in[16], DFF, DM, Wdn_t, scr, r, lane);
        }
        for (int e = blockIdx.x * 512 + tid; e < 8192 * 64; e += G * 512) {
            const int pos = e >> 6, i = e & 63;
            const float inv = (float)exp(-(double)i * (9.210340371976184 / 64.0));
            const float ang = (float)pos * inv;
            const double t = (double)ang * 0.15915494309189535; const float fr = (float)(t - rint(t));
            ropeC[e] = __builtin_amdgcn_cosf(fr); ropeS[e] = __builtin_amdgcn_sinf(fr);
        }
        const float* g0 = a.in[5];
        for (int m = gw; m < MTOK; m += NGW) {
            const f32x4* xr = (const f32x4*)(x + (size_t)m * DM) + lane; f32x4 v[8]; float s = 0.f;
#pragma unroll
            for (int j = 0; j < 8; ++j) { v[j] = xr[64 * j]; s += (v[j].x * v[j].x + v[j].y * v[j].y) + (v[j].z * v[j].z + v[j].w * v[j].w); }
            const float rstd = __builtin_amdgcn_rsqf(wave_sum(s) * (1.f / DM) + EPS);
            u32x2v* o8 = (u32x2v*)(H1 + (size_t)m * DM) + lane;
#pragma unroll
            for (int j = 0; j < 8; ++j) { const f32x4 gv = ((const f32x4*)g0)[lane + 64 * j]; u32x2v w; w.x = pk2(v[j].x * rstd * gv.x, v[j].y * rstd * gv.y); w.y = pk2(v[j].z * rstd * gv.z, v[j].w * rstd * gv.w); o8[64 * j] = w; }
        }
    }
    SEAM(0);
    if (IN(1)) {
        pg8::Gemm g{H1, Win_t, MTOK, NIN, DM}; pg8::StaticOrder S; S.init(MTOK, NIN, G, (int)blockIdx.x);
        pg8::EpiProj E{QKV, Gb, ropeC, ropeS};
        pg8::gemm_phase<pg8::EpiProj, pg8::StaticOrder, true, true>((LAS unsigned char*)lds, g, S, E);
    }
    SEAM(1);
#if defined(DBG_STOP)
#define DBG_DUMP(k, off_mib, nseg) do { if (DBG_STOP == (k)) { xcd_barrier(bar); const bf16* rg = (const bf16*)(ws + (size_t)(off_mib) * MiB); \
        for (size_t i = (size_t)blockIdx.x * 512 + tid; i < (size_t)MTOK * DM; i += (size_t)G * 512) { float acc_ = 0.f; for (int sg = 0; sg < (nseg); ++sg) acc_ += __uint_as_float(((unsigned)rg[i + (size_t)sg * MTOK * DM]) << 16); out[i] = acc_; } return; } } while (0)
#else
#define DBG_DUMP(k, off_mib, nseg) do { } while (0)
#endif
    DBG_DUMP(1, 256, 5);
    DBG_DUMP(11, 256, 3);
    DBG_DUMP(12, 640, 2);
    if (IN(2)) {
#ifndef NO_DENSE
        int seqv = SEQ; asm volatile("" : "+s"(seqv));
        for (int u = blockIdx.x; u < 2048; u += G) {
            const int xs = u & 7, qb = (u >> 3) & 31, combo = (u >> 8) * 8 + xs, b = combo >> 4, vh = combo & 15, h = vh >> 2, c = (vh >> 1) & 1, hf = vh & 1;
            const bf16* base = QKV + (size_t)b * SEQ * 6144;
            att::attn_dense_body<bf16>(base + (size_t)qb * 256 * 6144 + (h * 2 + c) * 128, base + 1024 + (h * 2 + c) * 128, base + 2048 + h * 256 + hf * 128,
                                       OD + ((size_t)b * SEQ + qb * 256) * 2048 + vh * 128, seqv, (char*)lds);
            __syncthreads();
        }
#endif
#ifndef NO_NA
        for (int u = blockIdx.x; u < 1024; u += G) {
            const int xs = u & 7, rb = (u >> 3) & 31, combo = (u >> 8) * 8 + xs, b = combo >> 3, h = combo & 7;
            att::na_unit(QKV, ONb, a.in[14], b, h, rb, (char*)lds);
        }
#endif
    }
    SEAM(2);
    DBG_DUMP(2, 896, 1);
    DBG_DUMP(22, 128, 1);
    if (IN(3)) {
        const float s1 = wave_sum(a.in[9][lane] * a.in[10][lane] + a.in[9][lane + 64] * a.in[10][lane + 64]);
        const float s2 = wave_sum(a.in[11][lane] * a.in[12][lane] + a.in[11][lane + 64] * a.in[12][lane + 64]);
        const float lam = __builtin_amdgcn_exp2f(s1 * 1.4426950408889634f) - __builtin_amdgcn_exp2f(s2 * 1.4426950408889634f) + 0.2f;
        const f32x4 sw = ((const f32x4*)a.in[13])[lane];
        for (int m = gw; m < MTOK; m += NGW) {
#pragma unroll
            for (int h = 0; h < 4; ++h) {
                const bf16* od = OD + (size_t)m * 2048 + h * 512 + 4 * lane;
                const u32x2v p = *(const u32x2v*)od, q = *(const u32x2v*)(od + 256);
                f32x4 d;
                d.x = __uint_as_float(p.x << 16) - lam * __uint_as_float(q.x << 16); d.y = __uint_as_float(p.x & 0xffff0000u) - lam * __uint_as_float(q.x & 0xffff0000u);
                d.z = __uint_as_float(p.y << 16) - lam * __uint_as_float(q.y << 16); d.w = __uint_as_float(p.y & 0xffff0000u) - lam * __uint_as_float(q.y & 0xffff0000u);
                const float rstd = __builtin_amdgcn_rsqf(wave_sum((d.x * d.x + d.y * d.y) + (d.z * d.z + d.w * d.w)) * (1.f / 256.f) + EPS) * 0.8f;
                u32x2v w; w.x = pk2(d.x * rstd * sw.x, d.y * rstd * sw.y); w.y = pk2(d.z * rstd * sw.z, d.w * rstd * sw.w);
                *(u32x2v*)(OAb + (size_t)m * 1024 + h * 256 + 4 * lane) = w;
            }
        }
    }
    SEAM(3);
    DBG_DUMP(3, 128, 1);
    if (IN(4)) {
        { pg8::Gemm g{OAb, Wa_t, MTOK, DM, 1024}; pg8::StaticOrder S; S.init(MTOK, DM, G, (int)blockIdx.x);
          pg8::EpiBranch<0> E{Gb, Tb, MX};
          pg8::gemm_phase<pg8::EpiBranch<0>, pg8::StaticOrder, true, true>((LAS unsigned char*)lds, g, S, E); }
        asm volatile("s_waitcnt vmcnt(0)" ::: "memory"); __syncthreads();
        { pg8::Gemm g{ONb, Wb_t, MTOK, DM, 1024}; pg8::StaticOrder S; S.init(MTOK, DM, G, (int)blockIdx.x);
          pg8::EpiBranch<1> E{Gb, Tb, MX};
          pg8::gemm_phase<pg8::EpiBranch<1>, pg8::StaticOrder, true, true>((LAS unsigned char*)lds, g, S, E); }
    }
    SEAM(4);
    DBG_DUMP(4, 512, 1);
    DBG_DUMP(41, 256, 2);
    if (IN(5)) {
        pg8::Gemm g{MX, Wout_t, MTOK, DM, DM}; pg8::StaticOrder S; S.init(MTOK, DM, G, (int)blockIdx.x);
        pg8::EpiYss<bf16> E{Yb, SS};
        pg8::gemm_phase<pg8::EpiYss<bf16>, pg8::StaticOrder, true, true>((LAS unsigned char*)lds, g, S, E);
    }
    SEAM(5);
    DBG_DUMP(5, 896, 1);
    if (IN(6)) {
        const float* g1 = a.in[6]; const float* g2 = a.in[7];
        for (int m = gw; m < MTOK; m += NGW) {
            const float rstd = __builtin_amdgcn_rsqf(wave_sum(lane < 32 ? SS[(size_t)m * 32 + lane] : 0.f) * (1.f / DM) + EPS);
            const f32x4* xr = (const f32x4*)(x + (size_t)m * DM) + lane; const u32x2v* yr = (const u32x2v*)(Yb + (size_t)m * DM) + lane; f32x4* orow = (f32x4*)(out + (size_t)m * DM) + lane;
            f32x4 v[8]; float s = 0.f;
#pragma unroll
            for (int j = 0; j < 8; ++j) { const f32x4 xv = xr[64 * j]; const u32x2v yw = yr[64 * j]; const f32x4 gv = ((const f32x4*)g1)[lane + 64 * j];
                f32x4 y; y.x = __uint_as_float(yw.x << 16); y.y = __uint_as_float(yw.x & 0xffff0000u); y.z = __uint_as_float(yw.y << 16); y.w = __uint_as_float(yw.y & 0xffff0000u);
                v[j] = xv + y * rstd * gv; orow[64 * j] = v[j];
                s += (v[j].x * v[j].x + v[j].y * v[j].y) + (v[j].z * v[j].z + v[j].w * v[j].w); }
            const float rstd1 = __builtin_amdgcn_rsqf(wave_sum(s) * (1.f / DM) + EPS);
            u32x2v* o8 = (u32x2v*)(H2 + (size_t)m * DM) + lane;
#pragma unroll
            for (int j = 0; j < 8; ++j) { const f32x4 gv = ((const f32x4*)g2)[lane + 64 * j]; u32x2v w; w.x = pk2(v[j].x * rstd1 * gv.x, v[j].y * rstd1 * gv.y); w.y = pk2(v[j].z * rstd1 * gv.z, v[j].w * rstd1 * gv.w); o8[64 * j] = w; }
        }
    }
    SEAM(6);
    DBG_DUMP(6, 128, 1);
    if (IN(7)) {
        pg8::Gemm g{H2, Wup_t, MTOK, DFF, DM}; pg8::StaticOrder S; S.init(MTOK, DFF, G, (int)blockIdx.x);
        pg8::EpiRelu2 E{Ub, DFF};
        pg8::gemm_phase<pg8::EpiRelu2, pg8::StaticOrder, true, true>((LAS unsigned char*)lds, g, S, E);
    }
    SEAM(7);
    DBG_DUMP(7, 256, 4);
    if (IN(8)) {
        pg8::Gemm g{Ub, Wdn_t, MTOK, DM, DFF}; pg8::StaticOrder S; S.init(MTOK, DM, G, (int)blockIdx.x);
        pg8::EpiYss<float> E{Y2, SS};
        pg8::gemm_phase<pg8::EpiYss<float>, pg8::StaticOrder, true, true>((LAS unsigned char*)lds, g, S, E);
    }
    SEAM(8);
    if (IN(9)) {
        const float* g3 = a.in[8];
        for (int m = gw; m < MTOK; m += NGW) {
            const float rstd = __builtin_amdgcn_rsqf(wave_sum(lane < 32 ? SS[(size_t)m * 32 + lane] : 0.f) * (1.f / DM) + EPS);
            const f32x4* yr = (const f32x4*)(Y2 + (size_t)m * DM) + lane; f32x4* orow = (f32x4*)(out + (size_t)m * DM) + lane;
#pragma unroll
            for (int j = 0; j < 8; ++j) { const f32x4 gv = ((const f32x4*)g3)[lane + 64 * j]; orow[64 * j] = orow[64 * j] + yr[64 * j] * rstd * gv; }
        }
    }
#undef IN
#undef SEAM
}

extern "C" void kernel_launch(void* const* d_in, const int* in_sizes, int n_in, void* d_out, int out_size, void* d_ws, size_t ws_size, hipStream_t stream) {
    static int grid = 0;
    if (grid == 0) {
        if (n_in != 17 || in_sizes[0] != MTOK * DM || out_size != MTOK * DM || ws_size < WS_END) { fprintf(stderr, "kernel_launch: shape/workspace mismatch: n_in %d in0 %d out %d ws %zu (need %zu)\n", n_in, n_in > 0 ? in_sizes[0] : -1, out_size, ws_size, (size_t)WS_END); grid = -1; return; }
        int dev = 0, cus = 0, per_cu = 0;
        (void)hipGetDevice(&dev); (void)hipDeviceGetAttribute(&cus, hipDeviceAttributeMultiprocessorCount, dev);
        if (hipFuncSetAttribute((const void*)mk_fwd, hipFuncAttributeMaxDynamicSharedMemorySize, LDS_BYTES) != hipSuccess) { fprintf(stderr, "kernel_launch: hipFuncSetAttribute failed\n"); grid = -1; return; }
        if (hipOccupancyMaxActiveBlocksPerMultiprocessor(&per_cu, (const void*)mk_fwd, NWAVES * 64, LDS_BYTES) != hipSuccess || per_cu < 1) { fprintf(stderr, "kernel_launch: occupancy query says %d\n", per_cu); per_cu = 1; }
        (void)hipGetLastError();
        grid = cus * per_cu;
    }
    if (grid < 0) return;
    if (hipMemsetAsync((char*)d_ws + WS_CTL, 0, CTL_ZERO_BYTES, stream) != hipSuccess) { fprintf(stderr, "kernel_launch: hipMemsetAsync failed\n"); return; }
    Args a{};
    for (int i = 0; i < 17; ++i) a.in[i] = (const float*)d_in[i];
    a.out = (float*)d_out; a.ws = (unsigned char*)d_ws; a.ph_lo = 0; a.ph_hi = 10;
    void* args[] = {&a};
    hipError_t e = hipLaunchCooperativeKernel((const void*)mk_fwd, dim3(grid), dim3(NWAVES * 64), args, LDS_BYTES, stream);
    if (e != hipSuccess) fprintf(stderr, "kernel_launch: cooperative launch failed: %s (grid %d)\n", hipGetErrorString(e), grid);
}
```

```cpp
#include <hip/hip_runtime.h>
#include <hip/hip_cooperative_groups.h>
#include <cstdio>
#include <cstdint>
#include <cmath>
namespace cg = cooperative_groups;
namespace pg8 {
#define PG8_LAS __attribute__((address_space(3)))
typedef unsigned short bf16_t;
typedef short bf16x8 __attribute__((ext_vector_type(8)));
typedef float f32x4 __attribute__((ext_vector_type(4)));
typedef unsigned u32x4 __attribute__((ext_vector_type(4)));
constexpr int BM = 256, BK = 64, HALF = 128, HTB = HALF * BK * 2  , STAGE_BYTES = 8 * HTB, NXCD = 8, WGM = 8;

__host__ __device__ __forceinline__ int lds_byte(int r, int c) { const int st = (r >> 4) * 2 + (c >> 5), rr = r & 15, cc = c & 31, ob = rr * 64 + cc * 2; return st * 1024 + (ob ^ (((ob >> 9) & 1) << 5)); }
__host__ __device__ __forceinline__ void stage_rc(int b, int& R, int& C) { const int st = b / 1024, sb = b % 1024, swz = sb ^ (((sb >> 9) & 1) << 5); R = (st >> 1) * 16 + swz / 64; C = (st & 1) * 32 + (swz % 64) / 2; }
__host__ __device__ __forceinline__ int perm32(int rho) { const int n = rho >> 4, i = rho & 15; return 8 * (i >> 2) + 4 * n + (i & 3); }

struct Unit { int pm, pn; };
struct Gemm { const bf16_t* A; const bf16_t* Bt; int M, N, K; };

struct StaticOrder {
    int nM, nN, nwg, G, c;
    __host__ __device__ void init(int M, int N, int G_, int c_) { nM = M / BM; nN = N / BM; nwg = nM * nN; G = G_; c = c_; }
    __host__ __device__ bool next(int i, Unit& u) const {
        const long L = (long)i * G + c; if (L >= nwg) return false;
        int wgid = (int)L; { const int q = nwg / NXCD, r = nwg % NXCD, xcd = wgid % NXCD, off = wgid / NXCD; wgid = (xcd < r ? xcd * (q + 1) : r * (q + 1) + (xcd - r) * q) + off; }
        const int nig = WGM * nN, gid = wgid / nig, fm = gid * WGM, gsz = (nM - fm) < WGM ? (nM - fm) : WGM;
        u.pm = fm + ((wgid % nig) % gsz); u.pn = (wgid % nig) / gsz; return true;
    }
    __device__ __forceinline__ void a_ready(const Unit&) const {}
    __device__ __forceinline__ void done(const Unit&) const {}
};

typedef __bf16 bf16x2_t __attribute__((ext_vector_type(2))); typedef float f32x2_t __attribute__((ext_vector_type(2)));
__device__ __forceinline__ unsigned cvt_pk_bf16(float lo, float hi) { f32x2_t v = {lo, hi}; bf16x2_t b = __builtin_convertvector(v, bf16x2_t); return __builtin_bit_cast(unsigned, b); }
__device__ __forceinline__ float bf2f(unsigned short b) { return __uint_as_float(((unsigned)b) << 16); }
__device__ __forceinline__ void unpack8(const u32x4 w, float (&f)[8]) {
    f[0] = __uint_as_float(w.x << 16); f[1] = __uint_as_float(w.x & 0xffff0000u); f[2] = __uint_as_float(w.y << 16); f[3] = __uint_as_float(w.y & 0xffff0000u);
    f[4] = __uint_as_float(w.z << 16); f[5] = __uint_as_float(w.z & 0xffff0000u); f[6] = __uint_as_float(w.w << 16); f[7] = __uint_as_float(w.w & 0xffff0000u);
}
__device__ __forceinline__ u32x4 pack8(const f32x4 v0, const f32x4 v1) { u32x4 w; w.x = cvt_pk_bf16(v0[0], v0[1]); w.y = cvt_pk_bf16(v0[2], v0[3]); w.z = cvt_pk_bf16(v1[0], v1[1]); w.w = cvt_pk_bf16(v1[2], v1[3]); return w; }
__device__ __forceinline__ float sigmoidf_(float v) { return __builtin_amdgcn_rcpf(1.0f + __builtin_amdgcn_exp2f(-1.4426950408889634f * v)); }

struct EpiProj {
    static constexpr bool PERM = true, AFTER_DRAIN = false;
    bf16_t* QKV; bf16_t* G; const float* ropeC; const float* ropeS;
    __device__ __forceinline__ void operator()(const f32x4 (&acc)[2][2][4][2], const Unit& u, int wr, int wc, int fr, int fq) const {
        const int row0 = u.pm * BM + wr * 64 + fr, colt = u.pn * BM, cl = wc * 32 + 8 * fq;
        if (colt < 2048) {
            const int i0 = 16 * wc + 4 * fq;
#pragma unroll
            for (int ai = 0; ai < 2; ++ai)
#pragma unroll
                for (int m = 0; m < 4; ++m) { const int row = row0 + ai * HALF + m * 16, pos = row & 8191;
                    const f32x4 c = *(const f32x4*)(ropeC + (size_t)pos * 64 + i0), s = *(const f32x4*)(ropeS + (size_t)pos * 64 + i0);
                    bf16_t* rowp = QKV + (size_t)row * 6144 + colt + cl;
#pragma unroll
                    for (int bj = 0; bj < 2; ++bj) { const f32x4 v0 = acc[ai][bj][m][0], v1 = acc[ai][bj][m][1]; f32x4 o0, o1;
                        o0[0] = v0[0] * c[0] - v0[1] * s[0]; o0[1] = v0[1] * c[0] + v0[0] * s[0]; o0[2] = v0[2] * c[1] - v0[3] * s[1]; o0[3] = v0[3] * c[1] + v0[2] * s[1];
                        o1[0] = v1[0] * c[2] - v1[1] * s[2]; o1[1] = v1[1] * c[2] + v1[0] * s[2]; o1[2] = v1[2] * c[3] - v1[3] * s[3]; o1[3] = v1[3] * c[3] + v1[2] * s[3];
                        *(u32x4*)(rowp + bj * HALF) = pack8(o0, o1); } }
        } else if (colt < 6144) {
#pragma unroll
            for (int ai = 0; ai < 2; ++ai)
#pragma unroll
                for (int m = 0; m < 4; ++m) { bf16_t* rowp = QKV + (size_t)(row0 + ai * HALF + m * 16) * 6144 + colt + cl;
#pragma unroll
                    for (int bj = 0; bj < 2; ++bj) *(u32x4*)(rowp + bj * HALF) = pack8(acc[ai][bj][m][0], acc[ai][bj][m][1]); }
        } else {
#pragma unroll
            for (int ai = 0; ai < 2; ++ai)
#pragma unroll
                for (int m = 0; m < 4; ++m) { bf16_t* rowp = G + (size_t)(row0 + ai * HALF + m * 16) * 4096 + (colt - 6144) + cl;
#pragma unroll
                    for (int bj = 0; bj < 2; ++bj) { f32x4 v0 = acc[ai][bj][m][0], v1 = acc[ai][bj][m][1];
#pragma unroll
                        for (int j = 0; j < 4; ++j) { v0[j] = sigmoidf_(v0[j]); v1[j] = sigmoidf_(v1[j]); }
                        *(u32x4*)(rowp + bj * HALF) = pack8(v0, v1); } }
        }
    }
};
template <int SECOND> struct EpiBranch {
    static constexpr bool PERM = true, AFTER_DRAIN = false;
    const bf16_t* G; bf16_t* T; bf16_t* MX;
    __device__ __forceinline__ void operator()(const f32x4 (&acc)[2][2][4][2], const Unit& u, int wr, int wc, int fr, int fq) const {
        const int row0 = u.pm * BM + wr * 64 + fr, col0 = u.pn * BM + wc * 32 + 8 * fq;
#pragma unroll
        for (int ai = 0; ai < 2; ++ai)
#pragma unroll
            for (int m = 0; m < 4; ++m) { const size_t row = (size_t)(row0 + ai * HALF + m * 16);
#pragma unroll
                for (int bj = 0; bj < 2; ++bj) { const int col = col0 + bj * HALF;
                    const u32x4 gw = *(const u32x4*)(G + row * 4096 + SECOND * 2048 + col); float g[8]; unpack8(gw, g);
                    f32x4 v0 = acc[ai][bj][m][0], v1 = acc[ai][bj][m][1];
#pragma unroll
                    for (int j = 0; j < 4; ++j) { v0[j] *= g[j]; v1[j] *= g[4 + j]; }
                    bf16_t* tp = T + row * 2048 + col;
                    if (SECOND == 0) { *(u32x4*)tp = pack8(v0, v1); }
                    else { float t[8]; unpack8(*(const u32x4*)tp, t);
#pragma unroll
                        for (int j = 0; j < 4; ++j) { v0[j] += t[j]; v1[j] += t[4 + j]; }
                        *(u32x4*)(MX + row * 2048 + col) = pack8(v0, v1); } } }
    }
};
template <typename TO> struct EpiYss {
    static constexpr bool PERM = true, AFTER_DRAIN = false;
    TO* Y; float* SS;
    __device__ __forceinline__ void operator()(const f32x4 (&acc)[2][2][4][2], const Unit& u, int wr, int wc, int fr, int fq) const {
        const int row0 = u.pm * BM + wr * 64 + fr, col0 = u.pn * BM + wc * 32 + 8 * fq;
#pragma unroll
        for (int ai = 0; ai < 2; ++ai)
#pragma unroll
            for (int m = 0; m < 4; ++m) { const size_t row = (size_t)(row0 + ai * HALF + m * 16); float s = 0.f;
#pragma unroll
                for (int bj = 0; bj < 2; ++bj) { const f32x4 v0 = acc[ai][bj][m][0], v1 = acc[ai][bj][m][1];
                    s += (v0[0] * v0[0] + v0[1] * v0[1]) + (v0[2] * v0[2] + v0[3] * v0[3]) + (v1[0] * v1[0] + v1[1] * v1[1]) + (v1[2] * v1[2] + v1[3] * v1[3]);
                    if constexpr (sizeof(TO) == 2) *(u32x4*)((bf16_t*)Y + row * 2048 + col0 + bj * HALF) = pack8(v0, v1);
                    else { float* yp = (float*)Y + row * 2048 + col0 + bj * HALF; *(f32x4*)yp = v0; *(f32x4*)(yp + 4) = v1; } }
                s += __shfl_xor(s, 16); s += __shfl_xor(s, 32);
                if (fq == 0) SS[row * 32 + u.pn * 4 + wc] = s; }
    }
};
struct EpiRelu2 {
    static constexpr bool PERM = true, AFTER_DRAIN = false;
    bf16_t* U; int ldc;
    __device__ __forceinline__ void operator()(const f32x4 (&acc)[2][2][4][2], const Unit& u, int wr, int wc, int fr, int fq) const {
        const int row0 = u.pm * BM + wr * 64 + fr, col0 = u.pn * BM + wc * 32 + 8 * fq;
#pragma unroll
        for (int ai = 0; ai < 2; ++ai)
#pragma unroll
            for (int m = 0; m < 4; ++m) { bf16_t* rowp = U + (size_t)(row0 + ai * HALF + m * 16) * ldc + col0;
#pragma unroll
                for (int bj = 0; bj < 2; ++bj) { f32x4 v0 = acc[ai][bj][m][0], v1 = acc[ai][bj][m][1];
#pragma unroll
                    for (int j = 0; j < 4; ++j) { const float a = fmaxf(v0[j], 0.f), b = fmaxf(v1[j], 0.f); v0[j] = a * a; v1[j] = b * b; }
                    *(u32x4*)(rowp + bj * HALF) = pack8(v0, v1); } }
    }
};

template <class Epi, class Sched, bool ALIGN_EPI = false, bool SP2 = false>
__device__ __forceinline__ void gemm_phase(PG8_LAS unsigned char* lds, const Gemm g, const Sched& S, const Epi& E) {
    const int tid = threadIdx.x, wid = __builtin_amdgcn_readfirstlane(tid >> 6), lane = tid & 63, wr = wid >> 2, wc = wid & 3, fr = lane & 15, fq = lane >> 4;
    const int K = g.K, nt = K / BK;
    unsigned voffA[2], voffB[2];
#pragma unroll
    for (int i = 0; i < 2; ++i) { int R, C; stage_rc(tid * 16 + i * 8192, R, C); const int Rb = Epi::PERM ? ((R & ~31) + perm32(R & 31)) : R;
        voffA[i] = (unsigned)(R * K + C) * 2u; voffB[i] = (unsigned)(Rb * K + C) * 2u; }
    const size_t kstep = (size_t)(BK * 2);
    const size_t hstep = (size_t)HALF * K * 2;
    const size_t tstep = 2 * hstep;
    const unsigned ldsw = (unsigned)wid * 1024u;
    const int aoff = lds_byte(wr * 64 + fr, fq * 8), boff = lds_byte(wc * 32 + fr, fq * 8);
#define PG8_SA(b, h) (((b) * 2 + (h)) * HTB)
#define PG8_SB(b, h) ((4 + (b) * 2 + (h)) * HTB)
#define PG8_STAGE(bufoff, gbase, voff) do { _Pragma("unroll") for (int _i = 0; _i < 2; ++_i) \
        __builtin_amdgcn_global_load_lds((const unsigned*)((const char*)(gbase) + (voff)[_i]), (PG8_LAS unsigned*)(lds + (bufoff) + ldsw + _i * 8192), 16, 0, 0); } while (0)
#define PG8_LDA(dst, b, h) do { _Pragma("unroll") for (int m = 0; m < 4; ++m) _Pragma("unroll") for (int k = 0; k < 2; ++k) dst[m][k] = *(const PG8_LAS bf16x8*)(lds + PG8_SA(b, h) + aoff + m * 2048 + k * 1024); } while (0)
#define PG8_LDB(dst, b, h) do { _Pragma("unroll") for (int n = 0; n < 2; ++n) _Pragma("unroll") for (int k = 0; k < 2; ++k) dst[n][k] = *(const PG8_LAS bf16x8*)(lds + PG8_SB(b, h) + boff + n * 2048 + k * 1024); } while (0)
#define PG8_MMA(ai, bj, At, Bt) do { __builtin_amdgcn_s_setprio(1); _Pragma("unroll") for (int m = 0; m < 4; ++m) _Pragma("unroll") for (int n = 0; n < 2; ++n) _Pragma("unroll") for (int k = 0; k < 2; ++k) \
        acc[ai][bj][m][n] = __builtin_amdgcn_mfma_f32_16x16x32_bf16(Bt[n][k], At[m][k], acc[ai][bj][m][n], 0, 0, 0); __builtin_amdgcn_s_setprio(0); } while (0)
#define PG8_WAIT_V(n) asm volatile("s_waitcnt vmcnt(" #n ")" ::: "memory")
#define PG8_WAIT_L(n) asm volatile("s_waitcnt lgkmcnt(" #n ")" ::: "memory")
#define PG8_BAR __builtin_amdgcn_s_barrier()
#define PG8_SCHED __builtin_amdgcn_sched_barrier(0)
    Unit cur, nxt; int ui = 0;
    if (!S.next(0, cur)) return;
    f32x4 acc[2][2][4][2];
#pragma unroll
    for (int a = 0; a < 2; ++a)
#pragma unroll
        for (int b = 0; b < 2; ++b)
#pragma unroll
            for (int m = 0; m < 4; ++m)
#pragma unroll
                for (int n = 0; n < 2; ++n) acc[a][b][m][n] = (f32x4){0.f, 0.f, 0.f, 0.f};
    bf16x8 At[4][2], B0[2][2], B1[2][2];
    const char* cA = (const char*)g.A + (size_t)cur.pm * tstep; const char* cB = (const char*)g.Bt + (size_t)cur.pn * tstep;
    S.a_ready(cur);
    if constexpr (SP2) {
        PG8_STAGE(PG8_SB(0, 0), cB, voffB); PG8_STAGE(PG8_SB(0, 1), cB + hstep, voffB); PG8_STAGE(PG8_SA(0, 0), cA, voffA); PG8_STAGE(PG8_SA(0, 1), cA + hstep, voffA);
        if (wr == 1) PG8_BAR;
        PG8_WAIT_V(2); PG8_BAR;
        PG8_STAGE(PG8_SB(1, 0), cB + kstep, voffB); PG8_STAGE(PG8_SA(1, 0), cA + kstep, voffA); PG8_STAGE(PG8_SB(1, 1), cB + hstep + kstep, voffB);
        PG8_WAIT_V(6); PG8_BAR;
    } else {
        PG8_STAGE(PG8_SB(0, 0), cB, voffB); PG8_STAGE(PG8_SA(0, 0), cA, voffA); PG8_STAGE(PG8_SB(0, 1), cB + hstep, voffB); PG8_STAGE(PG8_SA(0, 1), cA + hstep, voffA);
        if (wr == 1) PG8_BAR;
        PG8_WAIT_V(4); PG8_BAR;
        PG8_STAGE(PG8_SB(1, 0), cB + kstep, voffB); PG8_STAGE(PG8_SA(1, 0), cA + kstep, voffA); PG8_STAGE(PG8_SB(1, 1), cB + hstep + kstep, voffB);
        PG8_WAIT_V(6); PG8_BAR;
    }
    for (;;) {
        const bool has_next = S.next(ui + 1, nxt);
        const char* nA = has_next ? (const char*)g.A + (size_t)nxt.pm * tstep : cA; const char* nB = has_next ? (const char*)g.Bt + (size_t)nxt.pn * tstep : cB;
        for (int t = 0; t < nt; t += 2) {
            const bool last = (t == nt - 2);
            const char* a1 = cA + (size_t)(t + 1) * kstep;
            const char* a2 = last ? nA : cA + (size_t)(t + 2) * kstep; const char* b2 = last ? nB : cB + (size_t)(t + 2) * kstep;
            const char* a3 = a2 + kstep; const char* b3 = b2 + kstep;
            if (last && has_next) S.a_ready(nxt);
            if constexpr (SP2) {
            PG8_LDB(B0, 0, 0); PG8_LDB(B1, 0, 1); PG8_SCHED; PG8_LDA(At, 0, 0); PG8_STAGE(PG8_SA(1, 1), a1 + hstep, voffA);
            PG8_WAIT_V(8); PG8_WAIT_L(0); PG8_BAR; PG8_MMA(0, 0, At, B0); PG8_MMA(0, 1, At, B1); PG8_BAR; PG8_SCHED;
            PG8_LDA(At, 0, 1); PG8_STAGE(PG8_SB(0, 0), b2, voffB); PG8_STAGE(PG8_SB(0, 1), b2 + hstep, voffB); PG8_STAGE(PG8_SA(0, 0), a2, voffA);
            PG8_WAIT_V(8); PG8_WAIT_L(0); PG8_BAR; PG8_MMA(1, 0, At, B0); PG8_MMA(1, 1, At, B1); PG8_BAR; PG8_SCHED;
            PG8_LDB(B0, 1, 0); PG8_LDB(B1, 1, 1); PG8_SCHED; PG8_LDA(At, 1, 0); PG8_STAGE(PG8_SA(0, 1), a2 + hstep, voffA);
            PG8_WAIT_V(8); PG8_WAIT_L(0); PG8_BAR; PG8_MMA(0, 0, At, B0); PG8_MMA(0, 1, At, B1); PG8_BAR; PG8_SCHED;
            PG8_LDA(At, 1, 1); PG8_STAGE(PG8_SB(1, 0), b3, voffB); PG8_STAGE(PG8_SB(1, 1), b3 + hstep, voffB); PG8_STAGE(PG8_SA(1, 0), a3, voffA);
            PG8_WAIT_V(8); PG8_WAIT_L(0); PG8_BAR; PG8_MMA(1, 0, At, B0); PG8_MMA(1, 1, At, B1); PG8_BAR; PG8_SCHED;
            } else {
            PG8_LDB(B0, 0, 0); PG8_SCHED; PG8_LDA(At, 0, 0); PG8_STAGE(PG8_SA(1, 1), a1 + hstep, voffA);
            PG8_WAIT_L(8); PG8_BAR; PG8_WAIT_L(0); PG8_MMA(0, 0, At, B0); PG8_BAR; PG8_SCHED;
            PG8_LDB(B1, 0, 1); PG8_STAGE(PG8_SB(0, 0), b2, voffB);
            PG8_BAR; PG8_WAIT_L(0); PG8_MMA(0, 1, At, B1); PG8_BAR;
            PG8_LDA(At, 0, 1); PG8_STAGE(PG8_SA(0, 0), a2, voffA);
            PG8_BAR; PG8_WAIT_L(0); PG8_MMA(1, 0, At, B0); PG8_BAR; PG8_SCHED;
            PG8_STAGE(PG8_SB(0, 1), b2 + hstep, voffB);
            PG8_WAIT_V(6); PG8_BAR; PG8_MMA(1, 1, At, B1); PG8_BAR;
            PG8_LDB(B0, 1, 0); PG8_SCHED; PG8_LDA(At, 1, 0); PG8_STAGE(PG8_SA(0, 1), a2 + hstep, voffA);
            PG8_WAIT_L(8); PG8_BAR; PG8_WAIT_L(0); PG8_MMA(0, 0, At, B0); PG8_BAR; PG8_SCHED;
            PG8_LDB(B1, 1, 1); PG8_STAGE(PG8_SB(1, 0), b3, voffB);
            PG8_BAR; PG8_WAIT_L(0); PG8_MMA(0, 1, At, B1); PG8_BAR;
            PG8_LDA(At, 1, 1); PG8_STAGE(PG8_SA(1, 0), a3, voffA);
            PG8_BAR; PG8_WAIT_L(0); PG8_MMA(1, 0, At, B0); PG8_BAR; PG8_SCHED;
            PG8_STAGE(PG8_SB(1, 1), b3 + hstep, voffB);
            PG8_WAIT_V(6); PG8_BAR; PG8_MMA(1, 1, At, B1); PG8_BAR;
            }
        }
        if constexpr (ALIGN_EPI) { if (wr == 0) PG8_BAR; }
        if constexpr (!Epi::AFTER_DRAIN) { E(acc, cur, wr, wc, fr, fq); S.done(cur); }
        if (!has_next) break;
#pragma unroll
        for (int a = 0; a < 2; ++a)
#pragma unroll
            for (int b = 0; b < 2; ++b)
#pragma unroll
                for (int m = 0; m < 4; ++m)
#pragma unroll
                    for (int n = 0; n < 2; ++n) acc[a][b][m][n] = (f32x4){0.f, 0.f, 0.f, 0.f};
        cur = nxt; cA = nA; cB = nB; ++ui;
        if constexpr (ALIGN_EPI) { if (wr == 1) PG8_BAR; }
    }
    PG8_WAIT_V(0);
    if constexpr (!ALIGN_EPI) { if (wr == 0) PG8_BAR; }
    PG8_BAR;
    if constexpr (Epi::AFTER_DRAIN) { E.fused(acc, cur, wr, wc, fr, fq, lds, wid, lane); S.done(cur); }
#undef PG8_SA
#undef PG8_SB
#undef PG8_STAGE
#undef PG8_LDA
#undef PG8_LDB
#undef PG8_MMA
#undef PG8_WAIT_V
#undef PG8_WAIT_L
#undef PG8_BAR
#undef PG8_SCHED
}
}
namespace att {
using bf16 = unsigned short;
constexpr int   D = 128, NW = 8, QBLK = 32, KVBLK = 64;
constexpr float SCALE = 0.088388347648318440f;
constexpr float THR = 8.f;
constexpr int SDEPTH = 2;
constexpr int LDQ = 6144, LDK = 6144, LDO = 2048;
constexpr size_t SHM_V = KVBLK * D * 2, SHM_K = KVBLK * D * 2, SHM_ATTN = 2 * SHM_V + 2 * SHM_K + NW * 64 * 4;
using bf16x8 = __attribute__((ext_vector_type(8))) short;
using s16x4  = __attribute__((ext_vector_type(4))) short;
using f32x16 = __attribute__((ext_vector_type(16))) float;
using f32x8  = __attribute__((ext_vector_type(8))) float;
using u32x4  = __attribute__((ext_vector_type(4))) unsigned;
#define KSWZ(row, colB) ((row) * 256 + ((colB) ^ (((row) & 7) << 4)))
#define SBAR() __builtin_amdgcn_sched_barrier(0)
__device__ __forceinline__ int crow(int r, int hi) { return (r & 3) + 8 * (r >> 2) + 4 * hi; }
__device__ __forceinline__ unsigned cvtpk(float lo, float hi) {
  unsigned r; asm volatile("v_cvt_pk_bf16_f32 %0, %1, %2" : "=v"(r) : "v"(lo), "v"(hi)); return r;
}
template <typename TIn> struct Stage;
template <> struct Stage<bf16>  { using T = bf16x8;
  __device__ static __forceinline__ T ld8(const bf16* p) { return *reinterpret_cast<const bf16x8*>(p); }
  __device__ static __forceinline__ bf16x8 tobf(T x) { return x; } };
template <> struct Stage<float> { using T = f32x8;
  __device__ static __forceinline__ T ld8(const float* p) { return *reinterpret_cast<const f32x8*>(p); }
  __device__ static __forceinline__ bf16x8 tobf(T x) {
    u32x4 w = {cvtpk(x[0], x[1]), cvtpk(x[2], x[3]), cvtpk(x[4], x[5]), cvtpk(x[6], x[7])}; return *reinterpret_cast<bf16x8*>(&w); } };

__device__ __forceinline__ void partialSM(f32x16& p0, f32x16& p1, float& m_reg, float& mn, float& alpha) {
  constexpr float C = SCALE * 1.4426950408889634f;
  float pmax = p0[0]; for (int r = 1; r < 16; ++r) pmax = fmaxf(pmax, p0[r]); for (int r = 0; r < 16; ++r) pmax = fmaxf(pmax, p1[r]);
  { auto rr = __builtin_amdgcn_permlane32_swap(__float_as_uint(pmax), __float_as_uint(pmax), false, false);
    pmax = fmaxf(__uint_as_float(rr[0]), __uint_as_float(rr[1])); }
  if (__builtin_expect(__all(pmax - m_reg <= THR / SCALE), 1)) { mn = m_reg; alpha = 1.f; }
  else { mn = fmaxf(m_reg, pmax); alpha = __builtin_amdgcn_exp2f((m_reg - mn) * C); m_reg = mn; }
  float mnC = -mn * C;
  for (int r = 0; r < 16; ++r) p0[r] = fmaf(p0[r], C, mnC); for (int r = 0; r < 16; ++r) p1[r] = fmaf(p1[r], C, mnC);
  for (int r = 0; r < 16; ++r) p0[r] = __builtin_amdgcn_exp2f(p0[r]);
}
__device__ __forceinline__ void finishSM(f32x16& p0, f32x16& p1, float alpha, float& l_reg, bf16x8& pa0, bf16x8& pa1, bf16x8& pa2, bf16x8& pa3) {
  for (int r = 0; r < 16; ++r) p1[r] = __builtin_amdgcn_exp2f(p1[r]);
  float ps = 0; for (int r = 0; r < 16; ++r) ps += p0[r]; for (int r = 0; r < 16; ++r) ps += p1[r];
  { auto rr = __builtin_amdgcn_permlane32_swap(__float_as_uint(ps), __float_as_uint(ps), false, false);
    ps = __uint_as_float(rr[0]) + __uint_as_float(rr[1]); }
  l_reg = l_reg * alpha + ps;
#define PK4(P, BASE, OUT) do { unsigned a0 = cvtpk(P[BASE + 0], P[BASE + 1]), a1 = cvtpk(P[BASE + 2], P[BASE + 3]);   \
    unsigned b0 = cvtpk(P[BASE + 4], P[BASE + 5]), b1 = cvtpk(P[BASE + 6], P[BASE + 7]);                              \
    auto r0 = __builtin_amdgcn_permlane32_swap(a0, b0, false, false); auto r1 = __builtin_amdgcn_permlane32_swap(a1, b1, false, false); \
    u32x4 w = {r0[0], r1[0], r0[1], r1[1]}; OUT = *reinterpret_cast<bf16x8*>(&w); } while (0)
  PK4(p0, 0, pa0); PK4(p0, 8, pa1); PK4(p1, 0, pa2); PK4(p1, 8, pa3);
#undef PK4
}
__device__ __forceinline__ void qkt(f32x16& p0, f32x16& p1, const bf16* Ks, const bf16x8* qr, int r32, int hi) {
  p0 = f32x16{}; p1 = f32x16{};
  for (int d0 = 0; d0 < 8; ++d0) { int cb = (d0 * 16 + hi * 8) * 2;
    bf16x8 b0 = *reinterpret_cast<const bf16x8*>((const char*)Ks + KSWZ(r32, cb));
    bf16x8 b1 = *reinterpret_cast<const bf16x8*>((const char*)Ks + KSWZ(32 + r32, cb));
    p0 = __builtin_amdgcn_mfma_f32_32x32x16_bf16(b0, qr[d0], p0, 0, 0, 0);
    p1 = __builtin_amdgcn_mfma_f32_32x32x16_bf16(b1, qr[d0], p1, 0, 0, 0); }
}
__device__ __forceinline__ int v_st(int k, int c) { const int kk = (k & ~0xC) | ((k & 4) << 1) | ((k & 8) >> 1); return ((kk >> 3) * 4 + (c >> 5)) * 512 + ((kk & 7) * 32 + (c & 31)) * 2; }
__device__ __forceinline__ int v_rd_base(int lane) { return ((lane & 3) << 3) | (((lane >> 2) & 3) << 6) | (((lane >> 4) & 1) << 5) | (((lane >> 5) & 1) << 8); }
constexpr int v_rd_off(int d0, int ks, int half) { return d0 * 512 + ks * 4096 + half * 2048; }
template <int OFF> __device__ __forceinline__ s16x4 tr_read(int vb) {
  s16x4 r; asm volatile("ds_read_b64_tr_b16 %0, %1 offset:%2" : "=&v"(r) : "v"(vb), "i"(OFF) : "memory"); return r;
}
template <int D0> __device__ __forceinline__ void pv_one(f32x16& od, int vb, bf16x8 pa0, bf16x8 pa1, bf16x8 pa2, bf16x8 pa3) {
  const s16x4 l0 = tr_read<v_rd_off(D0, 0, 0)>(vb), h0 = tr_read<v_rd_off(D0, 0, 1)>(vb), l1 = tr_read<v_rd_off(D0, 1, 0)>(vb), h1 = tr_read<v_rd_off(D0, 1, 1)>(vb);
  const s16x4 l2 = tr_read<v_rd_off(D0, 2, 0)>(vb), h2 = tr_read<v_rd_off(D0, 2, 1)>(vb), l3 = tr_read<v_rd_off(D0, 3, 0)>(vb), h3 = tr_read<v_rd_off(D0, 3, 1)>(vb);
  asm volatile("s_waitcnt lgkmcnt(0)" ::: "memory"); SBAR();
#define PK(L, H) (bf16x8){L[0], L[1], L[2], L[3], H[0], H[1], H[2], H[3]}
  od = __builtin_amdgcn_mfma_f32_32x32x16_bf16(pa0, PK(l0, h0), od, 0, 0, 0);
  od = __builtin_amdgcn_mfma_f32_32x32x16_bf16(pa1, PK(l1, h1), od, 0, 0, 0);
  od = __builtin_amdgcn_mfma_f32_32x32x16_bf16(pa2, PK(l2, h2), od, 0, 0, 0);
  od = __builtin_amdgcn_mfma_f32_32x32x16_bf16(pa3, PK(l3, h3), od, 0, 0, 0);
#undef PK
}
__device__ __forceinline__ void pv_d0(f32x16* o, int vb, bf16x8 pa0, bf16x8 pa1, bf16x8 pa2, bf16x8 pa3) {
  pv_one<0>(o[0], vb, pa0, pa1, pa2, pa3); pv_one<1>(o[1], vb, pa0, pa1, pa2, pa3); pv_one<2>(o[2], vb, pa0, pa1, pa2, pa3); pv_one<3>(o[3], vb, pa0, pa1, pa2, pa3);
}

template <typename TQ>
__device__ __forceinline__ void attn_dense_body(const TQ* __restrict__ Qb, const bf16* __restrict__ Kh, const bf16* __restrict__ Vh,
                                                bf16* __restrict__ Ob, int seq, char* lds) {
  using St = Stage<bf16>; using SQ = Stage<TQ>;
  const int tid = threadIdx.x, wid = tid >> 6, lane = tid & 63, r32 = lane & 31, hi = lane >> 5;
  bf16* V_lds = (bf16*)lds; bf16* K_lds = (bf16*)(lds + 2 * SHM_V);
  float* ws = (float*)(lds + 2 * SHM_V + 2 * SHM_K) + wid * 64; float* li_l = ws; float* al_l = ws + 32;
  float m_reg = -1e30f, l_reg = 0; f32x16 o[4] = {}; bf16x8 qr[8];
  const TQ* Qw = Qb + (long)(wid * QBLK + r32) * LDQ + hi * 8;
#pragma unroll
  for (int d0 = 0; d0 < 8; ++d0) qr[d0] = SQ::tobf(SQ::ld8(Qw + d0 * 16));
  const int sr = tid >> 4, sc = (tid & 15) * 8, vst0 = v_st(sr, sc), vst1 = v_st(32 + sr, sc);
  const int vb0 = (int)(uintptr_t)V_lds + v_rd_base(lane);
  struct { typename St::T vs0, vs1, ks0, ks1; } sr_[SDEPTH];
#define SLOAD(i, k0) do { sr_[i].vs0 = St::ld8(&Vh[(long)((k0) + sr) * LDK + sc]); sr_[i].vs1 = St::ld8(&Vh[(long)((k0) + 32 + sr) * LDK + sc]); \
    sr_[i].ks0 = St::ld8(&Kh[(long)((k0) + sr) * LDK + sc]); sr_[i].ks1 = St::ld8(&Kh[(long)((k0) + 32 + sr) * LDK + sc]); } while (0)
#define SWRITE(b, i) do { *(bf16x8*)((char*)V_lds + (b) * SHM_V + vst0) = St::tobf(sr_[i].vs0);          \
    *(bf16x8*)((char*)V_lds + (b) * SHM_V + vst1) = St::tobf(sr_[i].vs1); int kc = sc * 2;               \
    *(bf16x8*)((char*)K_lds + (b) * SHM_K + KSWZ(sr, kc)) = St::tobf(sr_[i].ks0);                       \
    *(bf16x8*)((char*)K_lds + (b) * SHM_K + KSWZ(32 + sr, kc)) = St::tobf(sr_[i].ks1); } while (0)
#define SWAIT() do { if constexpr (SDEPTH == 2) asm volatile("s_waitcnt vmcnt(4)" ::: "memory"); else asm volatile("s_waitcnt vmcnt(0)" ::: "memory"); } while (0)
#define RESC(a) do { if (__any((a) < 1.f)) { if (hi == 0) al_l[r32] = (a); asm volatile("s_waitcnt lgkmcnt(0)" ::: "memory"); \
    for (int d = 0; d < 4; ++d) for (int r = 0; r < 16; ++r) o[d][r] *= al_l[crow(r, hi)]; } } while (0)
  f32x16 pA0, pA1, pB0, pB1; float mnA, mnB, alA, alB; bf16x8 pa0, pa1, pa2, pa3; const int NT = seq / KVBLK;
  constexpr int SE = 0, SO = SDEPTH - 1;
  SLOAD(SE, 0); asm volatile("s_waitcnt vmcnt(0)" ::: "memory"); SWRITE(0, SE); __syncthreads();
  qkt(pA0, pA1, K_lds, qr, r32, hi); partialSM(pA0, pA1, m_reg, mnA, alA);
  SLOAD(SO, KVBLK); if constexpr (SDEPTH == 2) { if (2 < NT) SLOAD(SE, 2 * KVBLK); }
  SWAIT(); SWRITE(1, SO); __syncthreads();
  for (int j = 1; j + 1 < NT; j += 2) {
    SBAR(); qkt(pB0, pB1, (bf16*)((char*)K_lds + SHM_K), qr, r32, hi);
    finishSM(pA0, pA1, alA, l_reg, pa0, pa1, pa2, pa3); SBAR();
    SLOAD(SO, (j + SDEPTH) * KVBLK); SBAR();
    pv_d0(o, vb0, pa0, pa1, pa2, pa3); partialSM(pB0, pB1, m_reg, mnB, alB);
    __syncthreads(); SWAIT(); SWRITE(0, SE);
    RESC(alB); __syncthreads();
    SBAR(); qkt(pA0, pA1, K_lds, qr, r32, hi);
    finishSM(pB0, pB1, alB, l_reg, pa0, pa1, pa2, pa3); SBAR();
    if (SDEPTH == 1 || j + 3 < NT) SLOAD(SE, (j + 1 + SDEPTH) * KVBLK); SBAR();
    pv_d0(o, vb0 + (int)SHM_V, pa0, pa1, pa2, pa3); partialSM(pA0, pA1, m_reg, mnA, alA);
    __syncthreads(); SWAIT(); SWRITE(1, SO);
    RESC(alA); __syncthreads();
  }
  SBAR(); qkt(pB0, pB1, (bf16*)((char*)K_lds + SHM_K), qr, r32, hi);
  finishSM(pA0, pA1, alA, l_reg, pa0, pa1, pa2, pa3); SBAR();
  pv_d0(o, vb0, pa0, pa1, pa2, pa3); partialSM(pB0, pB1, m_reg, mnB, alB);
  __syncthreads(); RESC(alB);
  finishSM(pB0, pB1, alB, l_reg, pa0, pa1, pa2, pa3); SBAR();
  pv_d0(o, vb0 + (int)SHM_V, pa0, pa1, pa2, pa3);
  if (hi == 0) li_l[r32] = l_reg; asm volatile("s_waitcnt lgkmcnt(0)" ::: "memory");
  float rli[16];
#pragma unroll
  for (int r = 0; r < 16; ++r) rli[r] = __builtin_amdgcn_rcpf(li_l[crow(r, hi)]);
  bf16* Ow = Ob + (long)(wid * QBLK) * LDO;
#pragma unroll
  for (int r = 0; r < 16; ++r) { int orow = crow(r, hi);
    for (int d0 = 0; d0 < 4; ++d0) Ow[(long)orow * LDO + d0 * 32 + r32] = (bf16)(cvtpk(o[d0][r] * rli[r], 0.f) & 0xffffu); }
#undef SLOAD
#undef SWRITE
#undef SWAIT
#undef RESC
}

__device__ __forceinline__ void na_unit(const bf16* __restrict__ QKV, bf16* __restrict__ ON, const float* __restrict__ rpb, int b, int h, int rblk, char* lds) {
  constexpr float C = SCALE * 1.4426950408889634f, L2E = 1.4426950408889634f;
  const int tid = threadIdx.x, wid = tid >> 6, lane = tid & 63, r32 = lane & 31, hi = lane >> 5;
  bf16* V_lds = (bf16*)lds; bf16* K_lds = (bf16*)(lds + SHM_V);
  float* wsf = (float*)(lds + SHM_V + SHM_K) + wid * 64; float* li_l = wsf; float* al_l = wsf + 32;
  float* biasL = (float*)(lds + SHM_V + SHM_K + NW * 64 * 4);
  const int r = rblk * 4 + (wid >> 1), c = (wid & 1) * 32 + r32;
  const int rs = min(max(r - 4, 0), 120), cs = min(max(c - 8, 0), 48);
  const long tok = (long)b * 8192 + r * 64 + c;
  bf16x8 qr[8];
  { const bf16* Qw = QKV + tok * 6144 + 3072 + h * 128 + hi * 8;
#pragma unroll
    for (int d0 = 0; d0 < 8; ++d0) qr[d0] = *reinterpret_cast<const bf16x8*>(Qw + d0 * 16); }
  for (int idx = tid; idx < 15 * 32; idx += 512) { const int dr = idx >> 5, dc = idx & 31; biasL[idx] = dc < 31 ? rpb[(h * 15 + dr) * 31 + dc] * L2E : 0.f; }
  const int kr_lo = min(max(rblk * 4 - 4, 0), 120), kr_hi = min(max(rblk * 4 + 3 - 4, 0), 120) + 7;
  const int sr = tid >> 4, sc = (tid & 15) * 8, vst0 = v_st(sr, sc), vst1 = v_st(32 + sr, sc);
  const int vb0 = (int)(uintptr_t)V_lds + v_rd_base(lane);
  float m_reg = -1e30f, l_reg = 0.f; f32x16 o[4] = {};
  for (int kr = kr_lo; kr <= kr_hi; ++kr) {
    const bf16* kp = QKV + ((long)b * 8192 + kr * 64) * 6144 + h * 128 + sc;
    const bf16x8 k0 = *reinterpret_cast<const bf16x8*>(kp + (long)sr * 6144 + 4096), k1 = *reinterpret_cast<const bf16x8*>(kp + (long)(32 + sr) * 6144 + 4096);
    const bf16x8 v0 = *reinterpret_cast<const bf16x8*>(kp + (long)sr * 6144 + 5120), v1 = *reinterpret_cast<const bf16x8*>(kp + (long)(32 + sr) * 6144 + 5120);
    __syncthreads();
    *(bf16x8*)((char*)K_lds + KSWZ(sr, sc * 2)) = k0; *(bf16x8*)((char*)K_lds + KSWZ(32 + sr, sc * 2)) = k1;
    *(bf16x8*)((char*)V_lds + vst0) = v0; *(bf16x8*)((char*)V_lds + vst1) = v1;
    __syncthreads();
    if (kr >= rs && kr < rs + 8) {
      f32x16 p0, p1; qkt(p0, p1, K_lds, qr, r32, hi);
      const float* bl = biasL + (kr - r + 7) * 32;
      float pmax = -INFINITY;
#pragma unroll
      for (int rr = 0; rr < 16; ++rr) { const int kc0 = crow(rr, hi), kc1 = kc0 + 32;
        const bool ok0 = (unsigned)(kc0 - cs) < 16u, ok1 = (unsigned)(kc1 - cs) < 16u;
        const float b0 = bl[ok0 ? kc0 - c + 15 : 0], b1 = bl[ok1 ? kc1 - c + 15 : 0];
        p0[rr] = ok0 ? fmaf(p0[rr], C, b0) : -INFINITY; p1[rr] = ok1 ? fmaf(p1[rr], C, b1) : -INFINITY;
        pmax = fmaxf(pmax, fmaxf(p0[rr], p1[rr])); }
      { auto t = __builtin_amdgcn_permlane32_swap(__float_as_uint(pmax), __float_as_uint(pmax), false, false);
        pmax = fmaxf(__uint_as_float(t[0]), __uint_as_float(t[1])); }
      const float mn = fmaxf(m_reg, pmax), alpha = __builtin_amdgcn_exp2f(m_reg - mn); m_reg = mn;
      float ps = 0.f;
#pragma unroll
      for (int rr = 0; rr < 16; ++rr) { p0[rr] = __builtin_amdgcn_exp2f(p0[rr] - mn); p1[rr] = __builtin_amdgcn_exp2f(p1[rr] - mn); ps += p0[rr] + p1[rr]; }
      { auto t = __builtin_amdgcn_permlane32_swap(__float_as_uint(ps), __float_as_uint(ps), false, false);
        ps = __uint_as_float(t[0]) + __uint_as_float(t[1]); }
      l_reg = l_reg * alpha + ps;
      if (hi == 0) al_l[r32] = alpha; asm volatile("s_waitcnt lgkmcnt(0)" ::: "memory");
#pragma unroll
      for (int d = 0; d < 4; ++d)
#pragma unroll
        for (int rr = 0; rr < 16; ++rr) o[d][rr] *= al_l[crow(rr, hi)];
      bf16x8 pa0, pa1, pa2, pa3;
#define PK4(P, BASE, OUT) do { unsigned a0 = cvtpk(P[BASE + 0], P[BASE + 1]), a1 = cvtpk(P[BASE + 2], P[BASE + 3]);   \
    unsigned b0_ = cvtpk(P[BASE + 4], P[BASE + 5]), b1_ = cvtpk(P[BASE + 6], P[BASE + 7]);                              \
    auto r0 = __builtin_amdgcn_permlane32_swap(a0, b0_, false, false); auto r1 = __builtin_amdgcn_permlane32_swap(a1, b1_, false, false); \
    u32x4 w = {r0[0], r1[0], r0[1], r1[1]}; OUT = *reinterpret_cast<bf16x8*>(&w); } while (0)
      PK4(p0, 0, pa0); PK4(p0, 8, pa1); PK4(p1, 0, pa2); PK4(p1, 8, pa3);
#undef PK4
      pv_d0(o, vb0, pa0, pa1, pa2, pa3);
    }
  }
  if (hi == 0) li_l[r32] = l_reg; asm volatile("s_waitcnt lgkmcnt(0)" ::: "memory");
  bf16* Ow = ON + ((long)b * 8192 + r * 64 + (wid & 1) * 32) * 1024 + h * 128;
#pragma unroll
  for (int rr = 0; rr < 16; ++rr) { const int orow = crow(rr, hi); const float rl = __builtin_amdgcn_rcpf(li_l[orow]);
#pragma unroll
    for (int d0 = 0; d0 < 4; ++d0) Ow[(long)orow * 1024 + d0 * 32 + r32] = (bf16)(cvtpk(o[d0][rr] * rl, 0.f) & 0xffffu); }
  __syncthreads();
}
}

constexpr int NWAVES = 8;
constexpr int BATCH = 4, SEQ = 8192, DM = 2048, MTOK = BATCH * SEQ, DFF = 8192, NIN = 10240;
constexpr float EPS = 1e-6f;
constexpr size_t MiB = 1u << 20;
constexpr size_t WS_SS = 0;
constexpr size_t WS_ROPE = 0;
constexpr size_t WS_CTL = 4 * MiB, CTL_ZERO_BYTES = 65536;
constexpr size_t WS_WIN = 8 * MiB, WS_WA = 48 * MiB, WS_WB = 52 * MiB, WS_WOUT = 56 * MiB, WS_WUP = 64 * MiB, WS_WDN = 96 * MiB;
constexpr size_t WS_H1 = 128 * MiB;
constexpr size_t WS_ON = 128 * MiB, WS_OA = 192 * MiB, WS_H2 = 128 * MiB;
constexpr size_t WS_QKV = 256 * MiB;
constexpr size_t WS_T = 256 * MiB, WS_MX = 512 * MiB, WS_U = 256 * MiB;
constexpr size_t WS_G = 640 * MiB;
constexpr size_t WS_OD = 896 * MiB;
constexpr size_t WS_Y = 896 * MiB;
constexpr size_t WS_Y2 = 768 * MiB;
constexpr size_t WS_END = 1024 * MiB;
constexpr int LDS_BYTES = 147456, MISC_OFF = 131072 + 320;

typedef unsigned short bf16;
typedef float f32x4 __attribute__((ext_vector_type(4)));
typedef unsigned u32x4v __attribute__((ext_vector_type(4)));
typedef unsigned u32x2v __attribute__((ext_vector_type(2)));
#define LAS __attribute__((address_space(3)))
#define LDS_WAIT() asm volatile("s_waitcnt lgkmcnt(0)" ::: "memory")

__device__ __forceinline__ unsigned pk2(float lo, float hi) { return pg8::cvt_pk_bf16(lo, hi); }
__device__ __forceinline__ float wave_sum(float v) {
#pragma unroll
    for (int o = 1; o < 64; o <<= 1) v += __shfl_xor(v, o);
    return v;
}
template <bool ROPE> __device__ __forceinline__ void p0_transpose_item(const float* W, int K, int N, bf16* WT, LAS float* scr, int item, int lane) {
    const int nblk = N / 32, kb = item / nblk, nb = item % nblk, k0 = 64 * kb, n0 = 32 * nb;
#pragma unroll 8
    for (int i = 0; i < 32; ++i) { const int kk = 2 * i + (lane >> 5); scr[kk * 33 + (lane & 31)] = W[(size_t)(k0 + kk) * N + n0 + (lane & 31)]; }
    LDS_WAIT(); asm volatile("" ::: "memory");
    const int c = lane & 7;
#pragma unroll
    for (int j = 0; j < 4; ++j) { const int n = (lane >> 3) + 8 * j; const LAS float* s = scr + (8 * c) * 33 + n;
        u32x4v o; o.x = pk2(s[0 * 33], s[1 * 33]); o.y = pk2(s[2 * 33], s[3 * 33]); o.z = pk2(s[4 * 33], s[5 * 33]); o.w = pk2(s[6 * 33], s[7 * 33]);
        int dn = n0 + n;
        if (ROPE && dn < 2048) { const int jj = dn & 127; dn = (dn & ~127) + (jj < 64 ? 2 * jj : 2 * (jj - 64) + 1); }
        *(u32x4v*)(WT + (size_t)dn * K + k0 + 8 * c) = o; }
    LDS_WAIT(); asm volatile("" ::: "memory");
}

#define XB_TMO      128
#define XB_XCNT(j)  (256  + 64 * (j))
#define XB_XSUB(j)  (1280 + 64 * (j))
#define XB_XGEN(j)  (2304 + 64 * (j))
#define XB_TOP      3328
#define XB_TOPGEN   3392
#define XCD_BAR_WORDS 3456
#define XB_SPIN_CAP (1u << 18)

__device__ __forceinline__ unsigned xb_ld(unsigned* p)              { return __hip_atomic_load(p, __ATOMIC_RELAXED, __HIP_MEMORY_SCOPE_AGENT); }
__device__ __forceinline__ unsigned xb_add(unsigned* p, unsigned v) { return __hip_atomic_fetch_add(p, v, __ATOMIC_RELAXED, __HIP_MEMORY_SCOPE_AGENT); }
__device__ __forceinline__ unsigned xb_xcc_id() { return (unsigned)__builtin_amdgcn_s_getreg((3 << 11) | 20) & 0xFu; }
#define XB_SPIN(cond, bar) do { unsigned _sp = 0; while (cond) { __builtin_amdgcn_s_sleep(1); \
    if ((++_sp & 255u) == 0u) { if (xb_ld(&(bar)[XB_TMO])) break; if (_sp > XB_SPIN_CAP) { atomicAdd(&(bar)[XB_TMO], 1u); break; } } } } while (0)

struct XcdBarrier {
    unsigned* bar; unsigned x;
    volatile LAS unsigned* st;
};

__device__ __forceinline__ XcdBarrier xcd_barrier_post(unsigned* bar, volatile LAS unsigned* st) {
    XcdBarrier b; b.bar = bar; b.x = xb_xcc_id(); b.st = st;
    if (threadIdx.x == 0) (void)xb_add(&bar[XB_XCNT(b.x)], 1u);
    return b;
}
__device__ __forceinline__ void xcd_barrier_complete(unsigned* bar, unsigned x, unsigned& nloc, unsigned& nx) {
    const unsigned G = gridDim.x * gridDim.y * gridDim.z;
    unsigned sum, cnt, mine, sp = 0u;
    for (;;) {
        sum = 0u; cnt = 0u; mine = 0u;
#pragma unroll
        for (unsigned j = 0; j < 16; ++j) { const unsigned c = xb_ld(&bar[XB_XCNT(j)]); sum += c; cnt += (c > 0u) ? 1u : 0u; mine = (j == x) ? c : mine; }
        if (sum == G) break;
        __builtin_amdgcn_s_sleep(1);
        if ((++sp & 255u) == 0u) { if (xb_ld(&bar[XB_TMO])) break; if (sp > XB_SPIN_CAP) { atomicAdd(&bar[XB_TMO], 1u); break; } }
    }
    nloc = mine > 0u ? mine : 1u; nx = cnt > 0u ? cnt : 1u;
}

__device__ __forceinline__ void xcd_barrier(const XcdBarrier& b) {
    asm volatile("s_waitcnt vmcnt(0)" ::: "memory");
    __syncthreads();
    if (threadIdx.x == 0) {
        unsigned* bar = b.bar;
        __builtin_amdgcn_s_waitcnt(0);
        unsigned nloc = b.st[0], nx = b.st[1];
        if (nloc == 0u) { xcd_barrier_complete(bar, b.x, nloc, nx); b.st[0] = nloc; b.st[1] = nx; }
        const unsigned old = xb_add(&bar[XB_XSUB(b.x)], 1u);
        const unsigned gen = old / nloc;
        if (old + 1u == (gen + 1u) * nloc) {
            __builtin_amdgcn_fence(__ATOMIC_RELEASE, "agent");
            asm volatile("s_waitcnt vmcnt(0)" ::: "memory");
            const unsigned og = xb_add(&bar[XB_TOP], 1u);
            const unsigned tg = og / nx;
            if (og + 1u == (tg + 1u) * nx) xb_add(&bar[XB_TOPGEN], 1u);
            else XB_SPIN(xb_ld(&bar[XB_TOPGEN]) == tg, bar);
            __builtin_amdgcn_fence(__ATOMIC_ACQUIRE, "agent");
            xb_add(&bar[XB_XGEN(b.x)], 1u);
            asm volatile("s_waitcnt vmcnt(0)" ::: "memory");
        } else {
            XB_SPIN(xb_ld(&bar[XB_XGEN(b.x)]) == gen, bar);
            __builtin_amdgcn_fence(__ATOMIC_ACQUIRE, "agent");
            asm volatile("s_waitcnt vmcnt(0)" ::: "memory");
        }
    }
    __syncthreads();
}

#ifndef REP_OTHERS
#define REP_OTHERS 1
#endif
struct Args { const float* in[17]; float* out; unsigned char* ws; int ph_lo, ph_hi; };

__global__ void __launch_bounds__(NWAVES * 64, 2) mk_fwd(Args a) {
    extern __shared__ __attribute__((aligned(16))) unsigned char lds[];
    cg::grid_group grid = cg::this_grid();
    const int tid = threadIdx.x, lane = tid & 63, wave = __builtin_amdgcn_readfirstlane(tid >> 6);
    const int G = gridDim.x, gw = blockIdx.x * NWAVES + wave, NGW = G * NWAVES;
    unsigned char* const ws = a.ws;
#define x_in (a.in[0])
#define out_p (a.out)
#define SS ((float*)(ws + WS_SS))
#define ropeC ((float*)(ws + WS_ROPE))
#define ropeS (ropeC + 8192 * 64)
#define Win_t ((bf16*)(ws + WS_WIN))
#define Wa_t ((bf16*)(ws + WS_WA))
#define Wb_t ((bf16*)(ws + WS_WB))
#define Wout_t ((bf16*)(ws + WS_WOUT))
#define Wup_t ((bf16*)(ws + WS_WUP))
#define Wdn_t ((bf16*)(ws + WS_WDN))
#define H1 ((bf16*)(ws + WS_H1))
#define ONb ((bf16*)(ws + WS_ON))
#define OAb ((bf16*)(ws + WS_OA))
#define H2 ((bf16*)(ws + WS_H2))
#define QKV ((bf16*)(ws + WS_QKV))
#define Tb ((bf16*)(ws + WS_T))
#define MX ((bf16*)(ws + WS_MX))
#define Ub ((bf16*)(ws + WS_U))
#define Gb ((bf16*)(ws + WS_G))
#define OD ((bf16*)(ws + WS_OD))
#define Yb ((bf16*)(ws + WS_Y))
#define Y2 ((bf16*)(ws + WS_Y2))
    const int lo = a.ph_lo, hi = a.ph_hi;
    for (int u = tid; u < (LDS_BYTES - 131072) / 4; u += NWAVES * 64) ((LAS unsigned*)((LAS unsigned char*)lds + 131072))[u] = 0u;
    __syncthreads();
    XcdBarrier bar = xcd_barrier_post((unsigned*)(ws + WS_CTL), (volatile LAS unsigned*)((LAS unsigned char*)lds + MISC_OFF) + 8);
    grid.sync();
#ifndef PHMASK
#define PHMASK 0x3ff
#endif
#define IN(k) (((PHMASK >> (k)) & 1) && lo <= (k) && (k) < hi)
#define SEAM(k) do { if (lo <= (k) && (k) + 1 < hi) xcd_barrier(bar); } while (0)

    if (IN(0)) {
        LAS float* scr = (LAS float*)((LAS unsigned char*)lds + wave * 16384);
        constexpr int I_IN = (DM / 64) * (NIN / 32), I_A = (1024 / 64) * (DM / 32), I_O = (DM / 64) * (DM / 32), I_UP = (DM / 64) * (DFF / 32), I_DN = (DFF / 64) * (DM / 32);
        constexpr int NITEMS = I_IN + 2 * I_A + I_O + I_UP + I_DN;
        for (int it = gw; it < NITEMS; it += NGW) {
            int r = it;
            if (r < I_IN) { p0_transpose_item<true>(a.in[1], DM, NIN, Win_t, scr, r, lane); continue; } r -= I_IN;
            if (r < I_A) { p0_transpose_item<false>(a.in[2], 1024, DM, Wa_t, scr, r, lane); continue; } r -= I_A;
            if (r < I_A) { p0_transpose_item<false>(a.in[3], 1024, DM, Wb_t, scr, r, lane); continue; } r -= I_A;
            if (r < I_O) { p0_transpose_item<false>(a.in[4], DM, DM, Wout_t, scr, r, lane); continue; } r -= I_O;
            if (r < I_UP) { p0_transpose_item<false>(a.in[15], DM, DFF, Wup_t, scr, r, lane); continue; } r -= I_UP;
            p0_transpose_item<false>(a.in[16], DFF, DM, Wdn_t, scr, r, lane);
        }
        for (int e = blockIdx.x * 512 + tid; e < 8192 * 64; e += G * 512) {
            const int pos = e >> 6, i = e & 63;
            const float inv = (float)exp(-(double)i * (9.210340371976184 / 64.0));
            const float ang = (float)pos * inv;
            const double t = (double)ang * 0.15915494309189535; const float fr = (float)(t - rint(t));
            ropeC[e] = __builtin_amdgcn_cosf(fr); ropeS[e] = __builtin_amdgcn_sinf(fr);
        }
        const float* g0 = a.in[5];
        for (int m = gw; m < MTOK; m += NGW) {
            const f32x4* xr = (const f32x4*)(x_in + (size_t)m * DM) + lane; f32x4 v[8]; float s = 0.f;
#pragma unroll
            for (int j = 0; j < 8; ++j) { v[j] = xr[64 * j]; s += (v[j].x * v[j].x + v[j].y * v[j].y) + (v[j].z * v[j].z + v[j].w * v[j].w); }
            const float rstd = __builtin_amdgcn_rsqf(wave_sum(s) * (1.f / DM) + EPS);
            u32x2v* o8 = (u32x2v*)(H1 + (size_t)m * DM) + lane;
#pragma unroll
            for (int j = 0; j < 8; ++j) { const f32x4 gv = ((const f32x4*)g0)[lane + 64 * j]; u32x2v w; w.x = pk2(v[j].x * rstd * gv.x, v[j].y * rstd * gv.y); w.y = pk2(v[j].z * rstd * gv.z, v[j].w * rstd * gv.w); o8[64 * j] = w; }
        }
    }
    SEAM(0);
    if (IN(1)) {
        pg8::Gemm g{H1, Win_t, MTOK, NIN, DM}; pg8::StaticOrder S; S.init(MTOK, NIN, G, (int)blockIdx.x);
        pg8::EpiProj E{QKV, Gb, ropeC, ropeS};
        pg8::gemm_phase<pg8::EpiProj, pg8::StaticOrder, true, true>((LAS unsigned char*)lds, g, S, E);
    }
    SEAM(1);
#if defined(DBG_STOP)
#define DBG_DUMP(k, off_mib, nseg) do { if (DBG_STOP == (k)) { xcd_barrier(bar); const bf16* rg = (const bf16*)(ws + (size_t)(off_mib) * MiB); \
        for (size_t i = (size_t)blockIdx.x * 512 + tid; i < (size_t)MTOK * DM; i += (size_t)G * 512) { float acc_ = 0.f; for (int sg = 0; sg < (nseg); ++sg) acc_ += __uint_as_float(((unsigned)rg[i + (size_t)sg * MTOK * DM]) << 16); out_p[i] = acc_; } return; } } while (0)
#else
#define DBG_DUMP(k, off_mib, nseg) do { } while (0)
#endif
    DBG_DUMP(1, 256, 5);
    DBG_DUMP(11, 256, 3);
    DBG_DUMP(12, 640, 2);
    if (IN(2)) {
#ifndef NO_DENSE
        int seqv = SEQ; asm volatile("" : "+s"(seqv));
        for (int u = blockIdx.x; u < 2048; u += G) {
            const int xs = u & 7, qb = (u >> 3) & 31, combo = (u >> 8) * 8 + xs, b = combo >> 4, vh = combo & 15, h = vh >> 2, c = (vh >> 1) & 1, hf = vh & 1;
            const bf16* base = QKV + (size_t)b * SEQ * 6144;
            att::attn_dense_body<bf16>(base + (size_t)qb * 256 * 6144 + (h * 2 + c) * 128, base + 1024 + (h * 2 + c) * 128, base + 2048 + h * 256 + hf * 128,
                                       OD + ((size_t)b * SEQ + qb * 256) * 2048 + vh * 128, seqv, (char*)lds);
            __syncthreads();
        }
#endif
#ifndef NO_NA
            for (int u = blockIdx.x; u < 1024; u += G) {
            const int xs = u & 7, rb = (u >> 3) & 31, combo = (u >> 8) * 8 + xs, b = combo >> 3, h = combo & 7;
            att::na_unit(QKV, ONb, a.in[14], b, h, rb, (char*)lds);
        }
#endif
    }
    SEAM(2);
    DBG_DUMP(2, 896, 1);
    DBG_DUMP(22, 128, 1);
    if (IN(3)) {
        const float s1 = wave_sum(a.in[9][lane] * a.in[10][lane] + a.in[9][lane + 64] * a.in[10][lane + 64]);
        const float s2 = wave_sum(a.in[11][lane] * a.in[12][lane] + a.in[11][lane + 64] * a.in[12][lane + 64]);
        const float lam = __builtin_amdgcn_exp2f(s1 * 1.4426950408889634f) - __builtin_amdgcn_exp2f(s2 * 1.4426950408889634f) + 0.2f;
        const f32x4 sw = ((const f32x4*)a.in[13])[lane];
        for (int m = gw; m < MTOK; m += NGW) {
#pragma unroll
            for (int h = 0; h < 4; ++h) {
                const bf16* od = OD + (size_t)m * 2048 + h * 512 + 4 * lane;
                const u32x2v p = *(const u32x2v*)od, q = *(const u32x2v*)(od + 256);
                f32x4 d;
                d.x = __uint_as_float(p.x << 16) - lam * __uint_as_float(q.x << 16); d.y = __uint_as_float(p.x & 0xffff0000u) - lam * __uint_as_float(q.x & 0xffff0000u);
                d.z = __uint_as_float(p.y << 16) - lam * __uint_as_float(q.y << 16); d.w = __uint_as_float(p.y & 0xffff0000u) - lam * __uint_as_float(q.y & 0xffff0000u);
                const float rstd = __builtin_amdgcn_rsqf(wave_sum((d.x * d.x + d.y * d.y) + (d.z * d.z + d.w * d.w)) * (1.f / 256.f) + EPS) * 0.8f;
                u32x2v w; w.x = pk2(d.x * rstd * sw.x, d.y * rstd * sw.y); w.y = pk2(d.z * rstd * sw.z, d.w * rstd * sw.w);
                *(u32x2v*)(OAb + (size_t)m * 1024 + h * 256 + 4 * lane) = w;
            }
        }
    }
    SEAM(3);
    DBG_DUMP(3, 128, 1);
    if (IN(4)) {
        { pg8::Gemm g{OAb, Wa_t, MTOK, DM, 1024}; pg8::StaticOrder S; S.init(MTOK, DM, G, (int)blockIdx.x);
          pg8::EpiBranch<0> E{Gb, Tb, MX};
          pg8::gemm_phase<pg8::EpiBranch<0>, pg8::StaticOrder, true, true>((LAS unsigned char*)lds, g, S, E); }
        asm volatile("s_waitcnt vmcnt(0)" ::: "memory"); __syncthreads();
        { pg8::Gemm g{ONb, Wb_t, MTOK, DM, 1024}; pg8::StaticOrder S; S.init(MTOK, DM, G, (int)blockIdx.x);
          pg8::EpiBranch<1> E{Gb, Tb, MX};
          pg8::gemm_phase<pg8::EpiBranch<1>, pg8::StaticOrder, true, true>((LAS unsigned char*)lds, g, S, E); }
    }
    SEAM(4);
    DBG_DUMP(4, 512, 1);
    DBG_DUMP(41, 256, 2);
    if (IN(5)) {
        pg8::Gemm g{MX, Wout_t, MTOK, DM, DM}; pg8::StaticOrder S; S.init(MTOK, DM, G, (int)blockIdx.x);
        pg8::EpiYss<bf16> E{Yb, SS};
        pg8::gemm_phase<pg8::EpiYss<bf16>, pg8::StaticOrder, true, true>((LAS unsigned char*)lds, g, S, E);
    }
    SEAM(5);
    DBG_DUMP(5, 896, 1);
    if (IN(6)) {
        const float* g1 = a.in[6]; const float* g2 = a.in[7];
        for (int m = gw; m < MTOK; m += NGW) {
            const float rstd = __builtin_amdgcn_rsqf(wave_sum(lane < 32 ? SS[(size_t)m * 32 + lane] : 0.f) * (1.f / DM) + EPS);
            const f32x4* xr = (const f32x4*)(x_in + (size_t)m * DM) + lane; const u32x2v* yr = (const u32x2v*)(Yb + (size_t)m * DM) + lane; f32x4* orow = (f32x4*)(out_p + (size_t)m * DM) + lane;
            f32x4 v[8]; float s = 0.f;
#pragma unroll
            for (int j = 0; j < 8; ++j) { const f32x4 xv = xr[64 * j]; const u32x2v yw = yr[64 * j]; const f32x4 gv = ((const f32x4*)g1)[lane + 64 * j];
                f32x4 y; y.x = __uint_as_float(yw.x << 16); y.y = __uint_as_float(yw.x & 0xffff0000u); y.z = __uint_as_float(yw.y << 16); y.w = __uint_as_float(yw.y & 0xffff0000u);
                v[j] = xv + y * rstd * gv; orow[64 * j] = v[j];
                s += (v[j].x * v[j].x + v[j].y * v[j].y) + (v[j].z * v[j].z + v[j].w * v[j].w); }
            const float rstd1 = __builtin_amdgcn_rsqf(wave_sum(s) * (1.f / DM) + EPS);
            u32x2v* o8 = (u32x2v*)(H2 + (size_t)m * DM) + lane;
#pragma unroll
            for (int j = 0; j < 8; ++j) { const f32x4 gv = ((const f32x4*)g2)[lane + 64 * j]; u32x2v w; w.x = pk2(v[j].x * rstd1 * gv.x, v[j].y * rstd1 * gv.y); w.y = pk2(v[j].z * rstd1 * gv.z, v[j].w * rstd1 * gv.w); o8[64 * j] = w; }
        }
    }
    SEAM(6);
    DBG_DUMP(6, 128, 1);
    if (IN(7)) {
        pg8::Gemm g{H2, Wup_t, MTOK, DFF, DM}; pg8::StaticOrder S; S.init(MTOK, DFF, G, (int)blockIdx.x);
        pg8::EpiRelu2 E{Ub, DFF};
        pg8::gemm_phase<pg8::EpiRelu2, pg8::StaticOrder, true, true>((LAS unsigned char*)lds, g, S, E);
    }
    SEAM(7);
    DBG_DUMP(7, 256, 4);
    if (IN(8)) {
        pg8::Gemm g{Ub, Wdn_t, MTOK, DM, DFF}; pg8::StaticOrder S; S.init(MTOK, DM, G, (int)blockIdx.x);
        pg8::EpiYss<bf16> E{Y2, SS};
        pg8::gemm_phase<pg8::EpiYss<bf16>, pg8::StaticOrder, true, true>((LAS unsigned char*)lds, g, S, E);
    }
    SEAM(8);
    if (IN(9)) {
        const float* g3 = a.in[8];
        for (int m = gw; m < MTOK; m += NGW) {
            const float rstd = __builtin_amdgcn_rsqf(wave_sum(lane < 32 ? SS[(size_t)m * 32 + lane] : 0.f) * (1.f / DM) + EPS);
            const u32x2v* yr = (const u32x2v*)(Y2 + (size_t)m * DM) + lane; f32x4* orow = (f32x4*)(out_p + (size_t)m * DM) + lane;
#pragma unroll
            for (int j = 0; j < 8; ++j) { const f32x4 gv = ((const f32x4*)g3)[lane + 64 * j]; const u32x2v yw = yr[64 * j];
                f32x4 y; y.x = __uint_as_float(yw.x << 16); y.y = __uint_as_float(yw.x & 0xffff0000u); y.z = __uint_as_float(yw.y << 16); y.w = __uint_as_float(yw.y & 0xffff0000u);
                orow[64 * j] = orow[64 * j] + y * rstd * gv; }
        }
    }
#undef IN
#undef SEAM
}

extern "C" void kernel_launch(void* const* d_in, const int* in_sizes, int n_in, void* d_out, int out_size, void* d_ws, size_t ws_size, hipStream_t stream) {
    static int grid = 0;
    if (grid == 0) {
        if (n_in != 17 || in_sizes[0] != MTOK * DM || out_size != MTOK * DM || ws_size < WS_END) { fprintf(stderr, "kernel_launch: shape/workspace mismatch: n_in %d in0 %d out %d ws %zu (need %zu)\n", n_in, n_in > 0 ? in_sizes[0] : -1, out_size, ws_size, (size_t)WS_END); grid = -1; return; }
        int dev = 0, cus = 0, per_cu = 0;
        (void)hipGetDevice(&dev); (void)hipDeviceGetAttribute(&cus, hipDeviceAttributeMultiprocessorCount, dev);
        if (hipFuncSetAttribute((const void*)mk_fwd, hipFuncAttributeMaxDynamicSharedMemorySize, LDS_BYTES) != hipSuccess) { fprintf(stderr, "kernel_launch: hipFuncSetAttribute failed\n"); grid = -1; return; }
        if (hipOccupancyMaxActiveBlocksPerMultiprocessor(&per_cu, (const void*)mk_fwd, NWAVES * 64, LDS_BYTES) != hipSuccess || per_cu < 1) { fprintf(stderr, "kernel_launch: occupancy query says %d\n", per_cu); per_cu = 1; }
        (void)hipGetLastError();
        grid = cus * per_cu;
    }
    if (grid < 0) return;
    if (hipMemsetAsync((char*)d_ws + WS_CTL, 0, CTL_ZERO_BYTES, stream) != hipSuccess) { fprintf(stderr, "kernel_launch: hipMemsetAsync failed\n"); return; }
    Args a{};
    for (int i = 0; i < 17; ++i) a.in[i] = (const float*)d_in[i];
    a.out = (float*)d_out; a.ws = (unsigned char*)d_ws; a.ph_lo = 0; a.ph_hi = 10;
    void* args[] = {&a};
    hipError_t e = hipLaunchCooperativeKernel((const void*)mk_fwd, dim3(grid), dim3(NWAVES * 64), args, LDS_BYTES, stream);
    if (e != hipSuccess) fprintf(stderr, "kernel_launch: cooperative launch failed: %s (grid %d)\n", hipGetErrorString(e), grid);
}
```

```cpp
#include <hip/hip_runtime.h>
#include <hip/hip_cooperative_groups.h>
#include <cstdio>
#include <cstdint>
#include <cmath>
namespace cg = cooperative_groups;
namespace pg8 {
#define PG8_LAS __attribute__((address_space(3)))
typedef unsigned short bf16_t;
typedef short bf16x8 __attribute__((ext_vector_type(8)));
typedef float f32x4 __attribute__((ext_vector_type(4)));
typedef unsigned u32x4 __attribute__((ext_vector_type(4)));
constexpr int BM = 256, BK = 64, HALF = 128, HTB = HALF * BK * 2  , STAGE_BYTES = 8 * HTB, NXCD = 8, WGM = 8;

__host__ __device__ __forceinline__ int lds_byte(int r, int c) { const int st = (r >> 4) * 2 + (c >> 5), rr = r & 15, cc = c & 31, ob = rr * 64 + cc * 2; return st * 1024 + (ob ^ (((ob >> 9) & 1) << 5)); }
__host__ __device__ __forceinline__ void stage_rc(int b, int& R, int& C) { const int st = b / 1024, sb = b % 1024, swz = sb ^ (((sb >> 9) & 1) << 5); R = (st >> 1) * 16 + swz / 64; C = (st & 1) * 32 + (swz % 64) / 2; }
__host__ __device__ __forceinline__ int perm32(int rho) { const int n = rho >> 4, i = rho & 15; return 8 * (i >> 2) + 4 * n + (i & 3); }

struct Unit { int pm, pn; };
struct Gemm { const bf16_t* A; const bf16_t* Bt; int M, N, K; };

struct StaticOrder {
    int nM, nN, nwg, G, c;
    __host__ __device__ void init(int M, int N, int G_, int c_) { nM = M / BM; nN = N / BM; nwg = nM * nN; G = G_; c = c_; }
    __host__ __device__ bool next(int i, Unit& u) const {
        const long L = (long)i * G + c; if (L >= nwg) return false;
        int wgid = (int)L; { const int q = nwg / NXCD, r = nwg % NXCD, xcd = wgid % NXCD, off = wgid / NXCD; wgid = (xcd < r ? xcd * (q + 1) : r * (q + 1) + (xcd - r) * q) + off; }
        const int nig = WGM * nN, gid = wgid / nig, fm = gid * WGM, gsz = (nM - fm) < WGM ? (nM - fm) : WGM;
        u.pm = fm + ((wgid % nig) % gsz); u.pn = (wgid % nig) / gsz; return true;
    }
    __device__ __forceinline__ void a_ready(const Unit&) const {}
    __device__ __forceinline__ void done(const Unit&) const {}
};

typedef __bf16 bf16x2_t __attribute__((ext_vector_type(2))); typedef float f32x2_t __attribute__((ext_vector_type(2)));
__device__ __forceinline__ unsigned cvt_pk_bf16(float lo, float hi) { f32x2_t v = {lo, hi}; bf16x2_t b = __builtin_convertvector(v, bf16x2_t); return __builtin_bit_cast(unsigned, b); }
__device__ __forceinline__ float bf2f(unsigned short b) { return __uint_as_float(((unsigned)b) << 16); }
__device__ __forceinline__ void unpack8(const u32x4 w, float (&f)[8]) {
    f[0] = __uint_as_float(w.x << 16); f[1] = __uint_as_float(w.x & 0xffff0000u); f[2] = __uint_as_float(w.y << 16); f[3] = __uint_as_float(w.y & 0xffff0000u);
    f[4] = __uint_as_float(w.z << 16); f[5] = __uint_as_float(w.z & 0xffff0000u); f[6] = __uint_as_float(w.w << 16); f[7] = __uint_as_float(w.w & 0xffff0000u);
}
__device__ __forceinline__ u32x4 pack8(const f32x4 v0, const f32x4 v1) { u32x4 w; w.x = cvt_pk_bf16(v0[0], v0[1]); w.y = cvt_pk_bf16(v0[2], v0[3]); w.z = cvt_pk_bf16(v1[0], v1[1]); w.w = cvt_pk_bf16(v1[2], v1[3]); return w; }
__device__ __forceinline__ float sigmoidf_(float v) { return __builtin_amdgcn_rcpf(1.0f + __builtin_amdgcn_exp2f(-1.4426950408889634f * v)); }

struct EpiProj {
    static constexpr bool PERM = true, AFTER_DRAIN = false;
    bf16_t* QKV; bf16_t* G; const float* ropeC; const float* ropeS;
    __device__ __forceinline__ void operator()(const f32x4 (&acc)[2][2][4][2], const Unit& u, int wr, int wc, int fr, int fq) const {
        const int row0 = u.pm * BM + wr * 64 + fr, colt = u.pn * BM, cl = wc * 32 + 8 * fq;
        if (colt < 2048) {
            const int i0 = 16 * wc + 4 * fq;
            f32x4 cc[2][4], sn[2][4];
#pragma unroll
            for (int ai = 0; ai < 2; ++ai)
#pragma unroll
                for (int m = 0; m < 4; ++m) { const int pos = (row0 + ai * HALF + m * 16) & 8191;
                    cc[ai][m] = *(const f32x4*)(ropeC + (size_t)pos * 64 + i0); sn[ai][m] = *(const f32x4*)(ropeS + (size_t)pos * 64 + i0); }
            asm volatile("" ::: "memory");
#pragma unroll
            for (int ai = 0; ai < 2; ++ai)
#pragma unroll
                for (int m = 0; m < 4; ++m) { const int row = row0 + ai * HALF + m * 16, pos = row & 8191;
                    const f32x4 c = cc[ai][m], s = sn[ai][m];
                    bf16_t* rowp = QKV + (((size_t)(row >> 13) * 48 + (colt >> 7)) * 8192 + pos) * 128 + cl;
#pragma unroll
                    for (int bj = 0; bj < 2; ++bj) { const f32x4 v0 = acc[ai][bj][m][0], v1 = acc[ai][bj][m][1]; f32x4 o0, o1;
                        o0[0] = v0[0] * c[0] - v0[1] * s[0]; o0[1] = v0[1] * c[0] + v0[0] * s[0]; o0[2] = v0[2] * c[1] - v0[3] * s[1]; o0[3] = v0[3] * c[1] + v0[2] * s[1];
                        o1[0] = v1[0] * c[2] - v1[1] * s[2]; o1[1] = v1[1] * c[2] + v1[0] * s[2]; o1[2] = v1[2] * c[3] - v1[3] * s[3]; o1[3] = v1[3] * c[3] + v1[2] * s[3];
                        *(u32x4*)(rowp + (size_t)bj * 8192 * 128) = pack8(o0, o1); } }
        } else if (colt < 6144) {
#pragma unroll
            for (int ai = 0; ai < 2; ++ai)
#pragma unroll
                for (int m = 0; m < 4; ++m) { const int row = row0 + ai * HALF + m * 16; bf16_t* rowp = QKV + (((size_t)(row >> 13) * 48 + (colt >> 7)) * 8192 + (row & 8191)) * 128 + cl;
#pragma unroll
                    for (int bj = 0; bj < 2; ++bj) *(u32x4*)(rowp + (size_t)bj * 8192 * 128) = pack8(acc[ai][bj][m][0], acc[ai][bj][m][1]); }
        } else {
#pragma unroll
            for (int ai = 0; ai < 2; ++ai)
#pragma unroll
                for (int m = 0; m < 4; ++m) { bf16_t* rowp = G + (size_t)(row0 + ai * HALF + m * 16) * 4096 + (colt - 6144) + cl;
#pragma unroll
                    for (int bj = 0; bj < 2; ++bj) { f32x4 v0 = acc[ai][bj][m][0], v1 = acc[ai][bj][m][1];
#pragma unroll
                        for (int j = 0; j < 4; ++j) { v0[j] = sigmoidf_(v0[j]); v1[j] = sigmoidf_(v1[j]); }
                        *(u32x4*)(rowp + bj * HALF) = pack8(v0, v1); } }
        }
    }
};
template <int SECOND> struct EpiBranch {
    static constexpr bool PERM = true, AFTER_DRAIN = false;
    const bf16_t* G; bf16_t* T; bf16_t* MX;
    __device__ __forceinline__ void operator()(const f32x4 (&acc)[2][2][4][2], const Unit& u, int wr, int wc, int fr, int fq) const {
        const int row0 = u.pm * BM + wr * 64 + fr, col0 = u.pn * BM + wc * 32 + 8 * fq;
#pragma unroll
        for (int ai = 0; ai < 2; ++ai) {
            u32x4 gw[4][2], tw[4][2];
#pragma unroll
            for (int m = 0; m < 4; ++m)
#pragma unroll
                for (int bj = 0; bj < 2; ++bj) { const size_t row = (size_t)(row0 + ai * HALF + m * 16); const int col = col0 + bj * HALF;
                    gw[m][bj] = *(const u32x4*)(G + row * 4096 + SECOND * 2048 + col);
                    if (SECOND) tw[m][bj] = *(const u32x4*)(T + row * 2048 + col); }
            asm volatile("" ::: "memory");
#pragma unroll
            for (int m = 0; m < 4; ++m)
#pragma unroll
                for (int bj = 0; bj < 2; ++bj) { const size_t row = (size_t)(row0 + ai * HALF + m * 16); const int col = col0 + bj * HALF;
                    float g[8]; unpack8(gw[m][bj], g);
                    f32x4 v0 = acc[ai][bj][m][0], v1 = acc[ai][bj][m][1];
#pragma unroll
                    for (int jj = 0; jj < 4; ++jj) { v0[jj] *= g[jj]; v1[jj] *= g[4 + jj]; }
                    if (SECOND == 0) { *(u32x4*)(T + row * 2048 + col) = pack8(v0, v1); }
                    else { float t[8]; unpack8(tw[m][bj], t);
#pragma unroll
                        for (int jj = 0; jj < 4; ++jj) { v0[jj] += t[jj]; v1[jj] += t[4 + jj]; }
                        *(u32x4*)(MX + row * 2048 + col) = pack8(v0, v1); } }
            asm volatile("" ::: "memory");
        }
    }
};
template <typename TO> struct EpiYss {
    static constexpr bool PERM = true, AFTER_DRAIN = false;
    TO* Y; float* SS;
    __device__ __forceinline__ void operator()(const f32x4 (&acc)[2][2][4][2], const Unit& u, int wr, int wc, int fr, int fq) const {
        const int row0 = u.pm * BM + wr * 64 + fr, col0 = u.pn * BM + wc * 32 + 8 * fq;
#pragma unroll
        for (int ai = 0; ai < 2; ++ai)
#pragma unroll
            for (int m = 0; m < 4; ++m) { const size_t row = (size_t)(row0 + ai * HALF + m * 16); float s = 0.f;
#pragma unroll
                for (int bj = 0; bj < 2; ++bj) { const f32x4 v0 = acc[ai][bj][m][0], v1 = acc[ai][bj][m][1];
                    s += (v0[0] * v0[0] + v0[1] * v0[1]) + (v0[2] * v0[2] + v0[3] * v0[3]) + (v1[0] * v1[0] + v1[1] * v1[1]) + (v1[2] * v1[2] + v1[3] * v1[3]);
                    if constexpr (sizeof(TO) == 2) *(u32x4*)((bf16_t*)Y + row * 2048 + col0 + bj * HALF) = pack8(v0, v1);
                    else { float* yp = (float*)Y + row * 2048 + col0 + bj * HALF; *(f32x4*)yp = v0; *(f32x4*)(yp + 4) = v1; } }
                s += __shfl_xor(s, 16); s += __shfl_xor(s, 32);
                if (fq == 0) SS[row * 32 + u.pn * 4 + wc] = s; }
    }
};
struct EpiRelu2 {
    static constexpr bool PERM = true, AFTER_DRAIN = false;
    bf16_t* U; int ldc;
    __device__ __forceinline__ void operator()(const f32x4 (&acc)[2][2][4][2], const Unit& u, int wr, int wc, int fr, int fq) const {
        const int row0 = u.pm * BM + wr * 64 + fr, col0 = u.pn * BM + wc * 32 + 8 * fq;
#pragma unroll
        for (int ai = 0; ai < 2; ++ai)
#pragma unroll
            for (int m = 0; m < 4; ++m) { bf16_t* rowp = U + (size_t)(row0 + ai * HALF + m * 16) * ldc + col0;
#pragma unroll
                for (int bj = 0; bj < 2; ++bj) { f32x4 v0 = acc[ai][bj][m][0], v1 = acc[ai][bj][m][1];
#pragma unroll
                    for (int j = 0; j < 4; ++j) { const float a = fmaxf(v0[j], 0.f), b = fmaxf(v1[j], 0.f); v0[j] = a * a; v1[j] = b * b; }
                    *(u32x4*)(rowp + bj * HALF) = pack8(v0, v1); } }
    }
};
struct PanelOrder {
    int c;
    __device__ void init(int c_) { c = c_; }
    __device__ bool next(int i, Unit& u) const { if (i >= 4) return false; const int li = c >> 3; u.pm = 16 * (c & 7) + 4 * i + (li >> 3); u.pn = li & 7; return true; }
    __device__ __forceinline__ void a_ready(const Unit&) const {}
    __device__ __forceinline__ void done(const Unit&) const {}
};
__device__ __forceinline__ void panel_publish(const float (&sq)[2][4], float* slots, unsigned* cnt, const Unit& u, int wr, int wc, int fr, int fq) {
#pragma unroll
    for (int ai = 0; ai < 2; ++ai)
#pragma unroll
        for (int m = 0; m < 4; ++m) { const size_t row = (size_t)(u.pm * BM + ai * HALF + wr * 64 + m * 16 + fr);
            if (fq == 0) __hip_atomic_store(slots + row * 32 + u.pn * 4 + wc, sq[ai][m], __ATOMIC_RELAXED, __HIP_MEMORY_SCOPE_AGENT); }
    asm volatile("s_waitcnt vmcnt(0)" ::: "memory");
    if ((threadIdx.x & 63) == 0) __hip_atomic_fetch_add(cnt + 64 * u.pm, 1u, __ATOMIC_RELAXED, __HIP_MEMORY_SCOPE_AGENT);
}
__device__ __forceinline__ void panel_collect(float (&sq)[2][4], const float* slots, unsigned* cnt, const Unit& u, int wr, int fr, int fq, float eps) {
    unsigned* cw = cnt + 64 * u.pm;
    { unsigned spins = 0;
      while ((unsigned)__builtin_amdgcn_readfirstlane(__hip_atomic_load(cw, __ATOMIC_RELAXED, __HIP_MEMORY_SCOPE_AGENT)) < 64u) { __builtin_amdgcn_s_sleep(2); if (++spins > (1u << 22)) break; } }
    __builtin_amdgcn_fence(__ATOMIC_ACQUIRE, "agent");
#pragma unroll
    for (int ai = 0; ai < 2; ++ai)
#pragma unroll
        for (int m = 0; m < 4; ++m) { const size_t row = (size_t)(u.pm * BM + ai * HALF + wr * 64 + m * 16 + fr);
            const unsigned long long* sp = (const unsigned long long*)(slots + row * 32 + fq * 8); float t = 0.f;
#pragma unroll
            for (int k = 0; k < 4; ++k) { const unsigned long long w = __hip_atomic_load(sp + k, __ATOMIC_RELAXED, __HIP_MEMORY_SCOPE_AGENT); t += __uint_as_float((unsigned)w) + __uint_as_float((unsigned)(w >> 32)); }
            t += __shfl_xor(t, 16); t += __shfl_xor(t, 32);
            sq[ai][m] = __builtin_amdgcn_rsqf(t * (1.0f / 2048.0f) + eps); }
}
struct EpiFinal {
    static constexpr bool PERM = false, AFTER_DRAIN = false;
    float* X; const float* gain; float* slots; unsigned* cnt; float eps;
    __device__ __forceinline__ void operator()(const f32x4 (&acc)[2][2][4][2], const Unit& u, int wr, int wc, int fr, int fq) const {
        float sq[2][4];
#pragma unroll
        for (int ai = 0; ai < 2; ++ai)
#pragma unroll
            for (int m = 0; m < 4; ++m) { float s = 0.f;
#pragma unroll
                for (int bj = 0; bj < 2; ++bj)
#pragma unroll
                    for (int n = 0; n < 2; ++n) { const f32x4 v = acc[ai][bj][m][n]; s += (v[0] * v[0] + v[1] * v[1]) + (v[2] * v[2] + v[3] * v[3]); }
                s += __shfl_xor(s, 16); s += __shfl_xor(s, 32); sq[ai][m] = s; }
        const int col0 = u.pn * BM + wc * 32 + 4 * fq;
        panel_publish(sq, slots, cnt, u, wr, wc, fr, fq);
        f32x4 pre[4][2][2];
#pragma unroll
        for (int m = 0; m < 4; ++m) { const float* rowp = X + (size_t)(u.pm * BM + wr * 64 + m * 16 + fr) * 2048 + col0;
#pragma unroll
            for (int bj = 0; bj < 2; ++bj)
#pragma unroll
                for (int n = 0; n < 2; ++n) pre[m][bj][n] = *(const f32x4*)(rowp + bj * HALF + n * 16); }
        panel_collect(sq, slots, cnt, u, wr, fr, fq, eps);
        f32x4 gv[2][2];
#pragma unroll
        for (int bj = 0; bj < 2; ++bj)
#pragma unroll
            for (int n = 0; n < 2; ++n) gv[bj][n] = *(const f32x4*)(gain + col0 + bj * HALF + n * 16);
#pragma unroll
        for (int ai = 0; ai < 2; ++ai) {
            if (ai == 1) {
#pragma unroll
                for (int m = 0; m < 4; ++m) { const float* rowp = X + (size_t)(u.pm * BM + HALF + wr * 64 + m * 16 + fr) * 2048 + col0;
#pragma unroll
                    for (int bj = 0; bj < 2; ++bj)
#pragma unroll
                        for (int n = 0; n < 2; ++n) pre[m][bj][n] = *(const f32x4*)(rowp + bj * HALF + n * 16); } }
#pragma unroll
            for (int m = 0; m < 4; ++m) { float* rowp = X + (size_t)(u.pm * BM + ai * HALF + wr * 64 + m * 16 + fr) * 2048 + col0; const float rs = sq[ai][m];
#pragma unroll
                for (int bj = 0; bj < 2; ++bj)
#pragma unroll
                    for (int n = 0; n < 2; ++n) *(f32x4*)(rowp + bj * HALF + n * 16) = pre[m][bj][n] + acc[ai][bj][m][n] * rs * gv[bj][n]; }
            asm volatile("" ::: "memory");
        }
    }
};

template <class Epi, class Sched, bool ALIGN_EPI = false, bool SP2 = false>
__device__ __forceinline__ void gemm_phase(PG8_LAS unsigned char* lds, const Gemm g, const Sched& S, const Epi& E) {
    const int tid = threadIdx.x, wid = __builtin_amdgcn_readfirstlane(tid >> 6), lane = tid & 63, wr = wid >> 2, wc = wid & 3, fr = lane & 15, fq = lane >> 4;
    const int K = g.K, nt = K / BK;
    unsigned voffA[2], voffB[2];
#pragma unroll
    for (int i = 0; i < 2; ++i) { int R, C; stage_rc(tid * 16 + i * 8192, R, C); const int Rb = Epi::PERM ? ((R & ~31) + perm32(R & 31)) : R;
        voffA[i] = (unsigned)(R * K + C) * 2u; voffB[i] = (unsigned)(Rb * K + C) * 2u; }
    const size_t kstep = (size_t)(BK * 2);
    const size_t hstep = (size_t)HALF * K * 2;
    const size_t tstep = 2 * hstep;
    const unsigned ldsw = (unsigned)wid * 1024u;
    const int aoff = lds_byte(wr * 64 + fr, fq * 8), boff = lds_byte(wc * 32 + fr, fq * 8);
#define PG8_SA(b, h) (((b) * 2 + (h)) * HTB)
#define PG8_SB(b, h) ((4 + (b) * 2 + (h)) * HTB)
#define PG8_STAGE(bufoff, gbase, voff) do { _Pragma("unroll") for (int _i = 0; _i < 2; ++_i) \
        __builtin_amdgcn_global_load_lds((const unsigned*)((const char*)(gbase) + (voff)[_i]), (PG8_LAS unsigned*)(lds + (bufoff) + ldsw + _i * 8192), 16, 0, 0); } while (0)
#define PG8_LDA(dst, b, h) do { _Pragma("unroll") for (int m = 0; m < 4; ++m) _Pragma("unroll") for (int k = 0; k < 2; ++k) dst[m][k] = *(const PG8_LAS bf16x8*)(lds + PG8_SA(b, h) + aoff + m * 2048 + k * 1024); } while (0)
#define PG8_LDB(dst, b, h) do { _Pragma("unroll") for (int n = 0; n < 2; ++n) _Pragma("unroll") for (int k = 0; k < 2; ++k) dst[n][k] = *(const PG8_LAS bf16x8*)(lds + PG8_SB(b, h) + boff + n * 2048 + k * 1024); } while (0)
#define PG8_MMA(ai, bj, At, Bt) do { __builtin_amdgcn_s_setprio(1); _Pragma("unroll") for (int m = 0; m < 4; ++m) _Pragma("unroll") for (int n = 0; n < 2; ++n) _Pragma("unroll") for (int k = 0; k < 2; ++k) \
        acc[ai][bj][m][n] = __builtin_amdgcn_mfma_f32_16x16x32_bf16(Bt[n][k], At[m][k], acc[ai][bj][m][n], 0, 0, 0); __builtin_amdgcn_s_setprio(0); } while (0)
#define PG8_WAIT_V(n) asm volatile("s_waitcnt vmcnt(" #n ")" ::: "memory")
#define PG8_WAIT_L(n) asm volatile("s_waitcnt lgkmcnt(" #n ")" ::: "memory")
#define PG8_BAR __builtin_amdgcn_s_barrier()
#define PG8_SCHED __builtin_amdgcn_sched_barrier(0)
    Unit cur, nxt; int ui = 0;
    if (!S.next(0, cur)) return;
    f32x4 acc[2][2][4][2];
#pragma unroll
    for (int a = 0; a < 2; ++a)
#pragma unroll
        for (int b = 0; b < 2; ++b)
#pragma unroll
            for (int m = 0; m < 4; ++m)
#pragma unroll
                for (int n = 0; n < 2; ++n) acc[a][b][m][n] = (f32x4){0.f, 0.f, 0.f, 0.f};
    bf16x8 At[4][2], B0[2][2], B1[2][2];
    const char* cA = (const char*)g.A + (size_t)cur.pm * tstep; const char* cB = (const char*)g.Bt + (size_t)cur.pn * tstep;
    S.a_ready(cur);
    if constexpr (SP2) {
        PG8_STAGE(PG8_SB(0, 0), cB, voffB); PG8_STAGE(PG8_SB(0, 1), cB + hstep, voffB); PG8_STAGE(PG8_SA(0, 0), cA, voffA); PG8_STAGE(PG8_SA(0, 1), cA + hstep, voffA);
        if (wr == 1) PG8_BAR;
        PG8_WAIT_V(2); PG8_BAR;
        PG8_STAGE(PG8_SB(1, 0), cB + kstep, voffB); PG8_STAGE(PG8_SA(1, 0), cA + kstep, voffA); PG8_STAGE(PG8_SB(1, 1), cB + hstep + kstep, voffB);
        PG8_WAIT_V(6); PG8_BAR;
    } else {
        PG8_STAGE(PG8_SB(0, 0), cB, voffB); PG8_STAGE(PG8_SA(0, 0), cA, voffA); PG8_STAGE(PG8_SB(0, 1), cB + hstep, voffB); PG8_STAGE(PG8_SA(0, 1), cA + hstep, voffA);
        if (wr == 1) PG8_BAR;
        PG8_WAIT_V(4); PG8_BAR;
        PG8_STAGE(PG8_SB(1, 0), cB + kstep, voffB); PG8_STAGE(PG8_SA(1, 0), cA + kstep, voffA); PG8_STAGE(PG8_SB(1, 1), cB + hstep + kstep, voffB);
        PG8_WAIT_V(6); PG8_BAR;
    }
    for (;;) {
        const bool has_next = S.next(ui + 1, nxt);
        const char* nA = has_next ? (const char*)g.A + (size_t)nxt.pm * tstep : cA; const char* nB = has_next ? (const char*)g.Bt + (size_t)nxt.pn * tstep : cB;
        for (int t = 0; t < nt; t += 2) {
            const bool last = (t == nt - 2);
            const char* a1 = cA + (size_t)(t + 1) * kstep;
            const char* a2 = last ? nA : cA + (size_t)(t + 2) * kstep; const char* b2 = last ? nB : cB + (size_t)(t + 2) * kstep;
            const char* a3 = a2 + kstep; const char* b3 = b2 + kstep;
            if (last && has_next) S.a_ready(nxt);
            if constexpr (SP2) {
            PG8_LDB(B0, 0, 0); PG8_LDB(B1, 0, 1); PG8_SCHED; PG8_LDA(At, 0, 0); PG8_STAGE(PG8_SA(1, 1), a1 + hstep, voffA);
            PG8_WAIT_V(8); PG8_WAIT_L(0); PG8_BAR; PG8_MMA(0, 0, At, B0); PG8_MMA(0, 1, At, B1); PG8_BAR; PG8_SCHED;
            PG8_LDA(At, 0, 1); PG8_STAGE(PG8_SB(0, 0), b2, voffB); PG8_STAGE(PG8_SB(0, 1), b2 + hstep, voffB); PG8_STAGE(PG8_SA(0, 0), a2, voffA);
            PG8_WAIT_V(8); PG8_WAIT_L(0); PG8_BAR; PG8_MMA(1, 0, At, B0); PG8_MMA(1, 1, At, B1); PG8_BAR; PG8_SCHED;
            PG8_LDB(B0, 1, 0); PG8_LDB(B1, 1, 1); PG8_SCHED; PG8_LDA(At, 1, 0); PG8_STAGE(PG8_SA(0, 1), a2 + hstep, voffA);
            PG8_WAIT_V(8); PG8_WAIT_L(0); PG8_BAR; PG8_MMA(0, 0, At, B0); PG8_MMA(0, 1, At, B1); PG8_BAR; PG8_SCHED;
            PG8_LDA(At, 1, 1); PG8_STAGE(PG8_SB(1, 0), b3, voffB); PG8_STAGE(PG8_SB(1, 1), b3 + hstep, voffB); PG8_STAGE(PG8_SA(1, 0), a3, voffA);
            PG8_WAIT_V(8); PG8_WAIT_L(0); PG8_BAR; PG8_MMA(1, 0, At, B0); PG8_MMA(1, 1, At, B1); PG8_BAR; PG8_SCHED;
            } else {
            PG8_LDB(B0, 0, 0); PG8_SCHED; PG8_LDA(At, 0, 0); PG8_STAGE(PG8_SA(1, 1), a1 + hstep, voffA);
            PG8_WAIT_L(8); PG8_BAR; PG8_WAIT_L(0); PG8_MMA(0, 0, At, B0); PG8_BAR; PG8_SCHED;
            PG8_LDB(B1, 0, 1); PG8_STAGE(PG8_SB(0, 0), b2, voffB);
            PG8_BAR; PG8_WAIT_L(0); PG8_MMA(0, 1, At, B1); PG8_BAR;
            PG8_LDA(At, 0, 1); PG8_STAGE(PG8_SA(0, 0), a2, voffA);
            PG8_BAR; PG8_WAIT_L(0); PG8_MMA(1, 0, At, B0); PG8_BAR; PG8_SCHED;
            PG8_STAGE(PG8_SB(0, 1), b2 + hstep, voffB);
            PG8_WAIT_V(6); PG8_BAR; PG8_MMA(1, 1, At, B1); PG8_BAR;
            PG8_LDB(B0, 1, 0); PG8_SCHED; PG8_LDA(At, 1, 0); PG8_STAGE(PG8_SA(0, 1), a2 + hstep, voffA);
            PG8_WAIT_L(8); PG8_BAR; PG8_WAIT_L(0); PG8_MMA(0, 0, At, B0); PG8_BAR; PG8_SCHED;
            PG8_LDB(B1, 1, 1); PG8_STAGE(PG8_SB(1, 0), b3, voffB);
            PG8_BAR; PG8_WAIT_L(0); PG8_MMA(0, 1, At, B1); PG8_BAR;
            PG8_LDA(At, 1, 1); PG8_STAGE(PG8_SA(1, 0), a3, voffA);
            PG8_BAR; PG8_WAIT_L(0); PG8_MMA(1, 0, At, B0); PG8_BAR; PG8_SCHED;
            PG8_STAGE(PG8_SB(1, 1), b3 + hstep, voffB);
            PG8_WAIT_V(6); PG8_BAR; PG8_MMA(1, 1, At, B1); PG8_BAR;
            }
        }
        if constexpr (ALIGN_EPI) { if (wr == 0) PG8_BAR; }
        if constexpr (!Epi::AFTER_DRAIN) { E(acc, cur, wr, wc, fr, fq); S.done(cur); }
        if (!has_next) break;
#pragma unroll
        for (int a = 0; a < 2; ++a)
#pragma unroll
            for (int b = 0; b < 2; ++b)
#pragma unroll
                for (int m = 0; m < 4; ++m)
#pragma unroll
                    for (int n = 0; n < 2; ++n) acc[a][b][m][n] = (f32x4){0.f, 0.f, 0.f, 0.f};
        cur = nxt; cA = nA; cB = nB; ++ui;
        if constexpr (ALIGN_EPI) { if (wr == 1) PG8_BAR; }
    }
    PG8_WAIT_V(0);
    if constexpr (!ALIGN_EPI) { if (wr == 0) PG8_BAR; }
    PG8_BAR;
    if constexpr (Epi::AFTER_DRAIN) { E.fused(acc, cur, wr, wc, fr, fq, lds, wid, lane); S.done(cur); }
#undef PG8_SA
#undef PG8_SB
#undef PG8_STAGE
#undef PG8_LDA
#undef PG8_LDB
#undef PG8_MMA
#undef PG8_WAIT_V
#undef PG8_WAIT_L
#undef PG8_BAR
#undef PG8_SCHED
}
}
namespace att {
using bf16 = unsigned short;
constexpr int   D = 128, NW = 8, QBLK = 32, KVBLK = 64;
constexpr float SCALE = 0.088388347648318440f;
#ifndef ATT_THR
#define ATT_THR 8.f
#endif
constexpr float THR = ATT_THR;
constexpr int SDEPTH = 2;
constexpr int LDQ = 128, LDK = 128, LDO = 2048;
constexpr size_t SHM_V = KVBLK * D * 2, SHM_K = KVBLK * D * 2, SHM_ATTN = 2 * SHM_V + 2 * SHM_K + NW * 64 * 4;
using bf16x8 = __attribute__((ext_vector_type(8))) short;
using s16x4  = __attribute__((ext_vector_type(4))) short;
using f32x16 = __attribute__((ext_vector_type(16))) float;
using f32x8  = __attribute__((ext_vector_type(8))) float;
using u32x4  = __attribute__((ext_vector_type(4))) unsigned;
#define KSWZ(row, colB) ((row) * 256 + ((colB) ^ (((row) & 7) << 4)))
#define SBAR() __builtin_amdgcn_sched_barrier(0)
__device__ __forceinline__ int crow(int r, int hi) { return (r & 3) + 8 * (r >> 2) + 4 * hi; }
__device__ __forceinline__ unsigned cvtpk(float lo, float hi) {
  unsigned r; asm volatile("v_cvt_pk_bf16_f32 %0, %1, %2" : "=v"(r) : "v"(lo), "v"(hi)); return r;
}
template <typename TIn> struct Stage;
template <> struct Stage<bf16>  { using T = bf16x8;
  __device__ static __forceinline__ T ld8(const bf16* p) { return *reinterpret_cast<const bf16x8*>(p); }
  __device__ static __forceinline__ bf16x8 tobf(T x) { return x; } };
template <> struct Stage<float> { using T = f32x8;
  __device__ static __forceinline__ T ld8(const float* p) { return *reinterpret_cast<const f32x8*>(p); }
  __device__ static __forceinline__ bf16x8 tobf(T x) {
    u32x4 w = {cvtpk(x[0], x[1]), cvtpk(x[2], x[3]), cvtpk(x[4], x[5]), cvtpk(x[6], x[7])}; return *reinterpret_cast<bf16x8*>(&w); } };

__device__ __forceinline__ void partialSM(f32x16& p0, f32x16& p1, float& m_reg, float& mn, float& alpha) {
  constexpr float C = SCALE * 1.4426950408889634f;
  float pmax = p0[0]; for (int r = 1; r < 16; ++r) pmax = fmaxf(pmax, p0[r]); for (int r = 0; r < 16; ++r) pmax = fmaxf(pmax, p1[r]);
  { auto rr = __builtin_amdgcn_permlane32_swap(__float_as_uint(pmax), __float_as_uint(pmax), false, false);
    pmax = fmaxf(__uint_as_float(rr[0]), __uint_as_float(rr[1])); }
  if (__builtin_expect(__all(pmax - m_reg <= THR / SCALE), 1)) { mn = m_reg; alpha = 1.f; }
  else { mn = fmaxf(m_reg, pmax); alpha = __builtin_amdgcn_exp2f((m_reg - mn) * C); m_reg = mn; }
  float mnC = -mn * C;
  for (int r = 0; r < 16; ++r) p0[r] = fmaf(p0[r], C, mnC); for (int r = 0; r < 16; ++r) p1[r] = fmaf(p1[r], C, mnC);
  for (int r = 0; r < 16; ++r) p0[r] = __builtin_amdgcn_exp2f(p0[r]);
}
__device__ __forceinline__ void finishSM(f32x16& p0, f32x16& p1, float alpha, float& l_reg, bf16x8& pa0, bf16x8& pa1, bf16x8& pa2, bf16x8& pa3) {
  for (int r = 0; r < 16; ++r) p1[r] = __builtin_amdgcn_exp2f(p1[r]);
  float ps = 0; for (int r = 0; r < 16; ++r) ps += p0[r]; for (int r = 0; r < 16; ++r) ps += p1[r];
  { auto rr = __builtin_amdgcn_permlane32_swap(__float_as_uint(ps), __float_as_uint(ps), false, false);
    ps = __uint_as_float(rr[0]) + __uint_as_float(rr[1]); }
  l_reg = l_reg * alpha + ps;
#define PK4(P, BASE, OUT) do { unsigned a0 = cvtpk(P[BASE + 0], P[BASE + 1]), a1 = cvtpk(P[BASE + 2], P[BASE + 3]);   \
    unsigned b0 = cvtpk(P[BASE + 4], P[BASE + 5]), b1 = cvtpk(P[BASE + 6], P[BASE + 7]);                              \
    auto r0 = __builtin_amdgcn_permlane32_swap(a0, b0, false, false); auto r1 = __builtin_amdgcn_permlane32_swap(a1, b1, false, false); \
    u32x4 w = {r0[0], r1[0], r0[1], r1[1]}; OUT = *reinterpret_cast<bf16x8*>(&w); } while (0)
  PK4(p0, 0, pa0); PK4(p0, 8, pa1); PK4(p1, 0, pa2); PK4(p1, 8, pa3);
#undef PK4
}
__device__ __forceinline__ void qkt(f32x16& p0, f32x16& p1, const bf16* Ks, const bf16x8* qr, int r32, int hi) {
  p0 = f32x16{}; p1 = f32x16{};
  for (int d0 = 0; d0 < 8; ++d0) { int cb = (d0 * 16 + hi * 8) * 2;
    bf16x8 b0 = *reinterpret_cast<const bf16x8*>((const char*)Ks + KSWZ(r32, cb));
    bf16x8 b1 = *reinterpret_cast<const bf16x8*>((const char*)Ks + KSWZ(32 + r32, cb));
    p0 = __builtin_amdgcn_mfma_f32_32x32x16_bf16(b0, qr[d0], p0, 0, 0, 0);
    p1 = __builtin_amdgcn_mfma_f32_32x32x16_bf16(b1, qr[d0], p1, 0, 0, 0); }
}
__device__ __forceinline__ int v_st(int k, int c) { const int kk = (k & ~0xC) | ((k & 4) << 1) | ((k & 8) >> 1); return ((kk >> 3) * 4 + (c >> 5)) * 512 + ((kk & 7) * 32 + (c & 31)) * 2; }
__device__ __forceinline__ int v_rd_base(int lane) { return ((lane & 3) << 3) | (((lane >> 2) & 3) << 6) | (((lane >> 4) & 1) << 5) | (((lane >> 5) & 1) << 8); }
constexpr int v_rd_off(int d0, int ks, int half) { return d0 * 512 + ks * 4096 + half * 2048; }
template <int OFF> __device__ __forceinline__ s16x4 tr_read(int vb) {
  s16x4 r; asm volatile("ds_read_b64_tr_b16 %0, %1 offset:%2" : "=&v"(r) : "v"(vb), "i"(OFF) : "memory"); return r;
}
template <int D0> __device__ __forceinline__ void pv_one(f32x16& od, int vb, bf16x8 pa0, bf16x8 pa1, bf16x8 pa2, bf16x8 pa3) {
  const s16x4 l0 = tr_read<v_rd_off(D0, 0, 0)>(vb), h0 = tr_read<v_rd_off(D0, 0, 1)>(vb), l1 = tr_read<v_rd_off(D0, 1, 0)>(vb), h1 = tr_read<v_rd_off(D0, 1, 1)>(vb);
  const s16x4 l2 = tr_read<v_rd_off(D0, 2, 0)>(vb), h2 = tr_read<v_rd_off(D0, 2, 1)>(vb), l3 = tr_read<v_rd_off(D0, 3, 0)>(vb), h3 = tr_read<v_rd_off(D0, 3, 1)>(vb);
  asm volatile("s_waitcnt lgkmcnt(0)" ::: "memory"); SBAR();
#define PK(L, H) (bf16x8){L[0], L[1], L[2], L[3], H[0], H[1], H[2], H[3]}
  od = __builtin_amdgcn_mfma_f32_32x32x16_bf16(pa0, PK(l0, h0), od, 0, 0, 0);
  od = __builtin_amdgcn_mfma_f32_32x32x16_bf16(pa1, PK(l1, h1), od, 0, 0, 0);
  od = __builtin_amdgcn_mfma_f32_32x32x16_bf16(pa2, PK(l2, h2), od, 0, 0, 0);
  od = __builtin_amdgcn_mfma_f32_32x32x16_bf16(pa3, PK(l3, h3), od, 0, 0, 0);
#undef PK
}
__device__ __forceinline__ void pv_d0(f32x16* o, int vb, bf16x8 pa0, bf16x8 pa1, bf16x8 pa2, bf16x8 pa3) {
  pv_one<0>(o[0], vb, pa0, pa1, pa2, pa3); pv_one<1>(o[1], vb, pa0, pa1, pa2, pa3); pv_one<2>(o[2], vb, pa0, pa1, pa2, pa3); pv_one<3>(o[3], vb, pa0, pa1, pa2, pa3);
}

template <typename TQ>
__device__ __forceinline__ void attn_dense_body(const TQ* __restrict__ Qb, const bf16* __restrict__ Kh, const bf16* __restrict__ Vh,
                                                bf16* __restrict__ Ob, int seq, char* lds) {
  using St = Stage<bf16>; using SQ = Stage<TQ>;
  const int tid = threadIdx.x, wid = tid >> 6, lane = tid & 63, r32 = lane & 31, hi = lane >> 5;
  bf16* V_lds = (bf16*)lds; bf16* K_lds = (bf16*)(lds + 2 * SHM_V);
  float* ws = (float*)(lds + 2 * SHM_V + 2 * SHM_K) + wid * 64; float* li_l = ws; float* al_l = ws + 32;
  float m_reg = -1e30f, l_reg = 0; f32x16 o[4] = {}; bf16x8 qr[8];
  const TQ* Qw = Qb + (long)(wid * QBLK + r32) * LDQ + hi * 8;
#pragma unroll
  for (int d0 = 0; d0 < 8; ++d0) qr[d0] = SQ::tobf(SQ::ld8(Qw + d0 * 16));
  const int sr = tid >> 4, sc = (tid & 15) * 8, vst0 = v_st(sr, sc), vst1 = v_st(32 + sr, sc);
  const int vb0 = (int)(uintptr_t)V_lds + v_rd_base(lane);
  struct { typename St::T vs0, vs1, ks0, ks1; } sr_[SDEPTH];
#define SLOAD(i, k0) do { sr_[i].vs0 = St::ld8(&Vh[(long)((k0) + sr) * LDK + sc]); sr_[i].vs1 = St::ld8(&Vh[(long)((k0) + 32 + sr) * LDK + sc]); \
    sr_[i].ks0 = St::ld8(&Kh[(long)((k0) + sr) * LDK + sc]); sr_[i].ks1 = St::ld8(&Kh[(long)((k0) + 32 + sr) * LDK + sc]); } while (0)
#define SWRITE(b, i) do { *(bf16x8*)((char*)V_lds + (b) * SHM_V + vst0) = St::tobf(sr_[i].vs0);          \
    *(bf16x8*)((char*)V_lds + (b) * SHM_V + vst1) = St::tobf(sr_[i].vs1); int kc = sc * 2;               \
    *(bf16x8*)((char*)K_lds + (b) * SHM_K + KSWZ(sr, kc)) = St::tobf(sr_[i].ks0);                       \
    *(bf16x8*)((char*)K_lds + (b) * SHM_K + KSWZ(32 + sr, kc)) = St::tobf(sr_[i].ks1); } while (0)
#define SWAIT() do { if constexpr (SDEPTH == 2) asm volatile("s_waitcnt vmcnt(4)" ::: "memory"); else asm volatile("s_waitcnt vmcnt(0)" ::: "memory"); } while (0)
#define RESC(a) do { if (__any((a) < 1.f)) { if (hi == 0) al_l[r32] = (a); asm volatile("s_waitcnt lgkmcnt(0)" ::: "memory"); \
    for (int d = 0; d < 4; ++d) for (int r = 0; r < 16; ++r) o[d][r] *= al_l[crow(r, hi)]; } } while (0)
  f32x16 pA0, pA1, pB0, pB1; float mnA, mnB, alA, alB; bf16x8 pa0, pa1, pa2, pa3; const int NT = seq / KVBLK;
  constexpr int SE = 0, SO = SDEPTH - 1;
  SLOAD(SE, 0); asm volatile("s_waitcnt vmcnt(0)" ::: "memory"); SWRITE(0, SE); __syncthreads();
  qkt(pA0, pA1, K_lds, qr, r32, hi); partialSM(pA0, pA1, m_reg, mnA, alA);
  SLOAD(SO, KVBLK); if constexpr (SDEPTH == 2) { if (2 < NT) SLOAD(SE, 2 * KVBLK); }
  SWAIT(); SWRITE(1, SO); __syncthreads();
  for (int j = 1; j + 1 < NT; j += 2) {
    SBAR(); qkt(pB0, pB1, (bf16*)((char*)K_lds + SHM_K), qr, r32, hi);
    finishSM(pA0, pA1, alA, l_reg, pa0, pa1, pa2, pa3); SBAR();
    SLOAD(SO, (j + SDEPTH) * KVBLK); SBAR();
    pv_d0(o, vb0, pa0, pa1, pa2, pa3); partialSM(pB0, pB1, m_reg, mnB, alB);
    __syncthreads(); SWAIT(); SWRITE(0, SE);
    RESC(alB); __syncthreads();
    SBAR(); qkt(pA0, pA1, K_lds, qr, r32, hi);
    finishSM(pB0, pB1, alB, l_reg, pa0, pa1, pa2, pa3); SBAR();
    if (SDEPTH == 1 || j + 3 < NT) SLOAD(SE, (j + 1 + SDEPTH) * KVBLK); SBAR();
    pv_d0(o, vb0 + (int)SHM_V, pa0, pa1, pa2, pa3); partialSM(pA0, pA1, m_reg, mnA, alA);
    __syncthreads(); SWAIT(); SWRITE(1, SO);
    RESC(alA); __syncthreads();
  }
  SBAR(); qkt(pB0, pB1, (bf16*)((char*)K_lds + SHM_K), qr, r32, hi);
  finishSM(pA0, pA1, alA, l_reg, pa0, pa1, pa2, pa3); SBAR();
  pv_d0(o, vb0, pa0, pa1, pa2, pa3); partialSM(pB0, pB1, m_reg, mnB, alB);
  __syncthreads(); RESC(alB);
  finishSM(pB0, pB1, alB, l_reg, pa0, pa1, pa2, pa3); SBAR();
  pv_d0(o, vb0 + (int)SHM_V, pa0, pa1, pa2, pa3);
  if (hi == 0) li_l[r32] = l_reg; asm volatile("s_waitcnt lgkmcnt(0)" ::: "memory");
  float rli[16];
#pragma unroll
  for (int r = 0; r < 16; ++r) rli[r] = __builtin_amdgcn_rcpf(li_l[crow(r, hi)]);
  bf16* Ow = Ob + (long)(wid * QBLK) * LDO;
#pragma unroll
  for (int r = 0; r < 16; ++r) { int orow = crow(r, hi);
    for (int d0 = 0; d0 < 4; ++d0) Ow[(long)orow * LDO + d0 * 32 + r32] = (bf16)(cvtpk(o[d0][r] * rli[r], 0.f) & 0xffffu); }
#undef SLOAD
#undef SWRITE
#undef SWAIT
#undef RESC
}

#define ATT_LAS __attribute__((address_space(3)))
__device__ __forceinline__ void qkt_lean(f32x16& p0, f32x16& p1, const bf16* Ks, const bf16x8* qr, int r32, int hi) {
  p0 = f32x16{}; p1 = f32x16{};
#pragma unroll
  for (int d0 = 0; d0 < 8; ++d0) { const int cb = (d0 * 16 + hi * 8) * 2;
    const bf16x8 b0 = *reinterpret_cast<const bf16x8*>((const char*)Ks + KSWZ(r32, cb));
    const bf16x8 b1 = *reinterpret_cast<const bf16x8*>((const char*)Ks + KSWZ(32 + r32, cb));
    p0 = __builtin_amdgcn_mfma_f32_32x32x16_bf16(b0, qr[d0], p0, 0, 0, 0);
    p1 = __builtin_amdgcn_mfma_f32_32x32x16_bf16(b1, qr[d0], p1, 0, 0, 0);
    if (d0 & 1) SBAR(); }
}
#define A2_WAITL(n) do { asm volatile("s_waitcnt lgkmcnt(" #n ")" ::: "memory"); SBAR(); } while (0)
__device__ __forceinline__ void kq_rd(int a0, bf16x8& b0, bf16x8& b1) {
  asm volatile("ds_read_b128 %0, %1" : "=&v"(b0) : "v"(a0) : "memory");
  asm volatile("ds_read_b128 %0, %1 offset:8192" : "=&v"(b1) : "v"(a0) : "memory");
}
__device__ __forceinline__ void qkt_pipe(f32x16& p0, f32x16& p1, int kaddr, int sw, int hi, const bf16x8* qr) {
  p0 = f32x16{}; p1 = f32x16{};
  bf16x8 a0, a1, b0, b1;
#define KA(d0) (kaddr + (((d0) * 32 + hi * 16) ^ sw))
#define KM(x0, x1, d0) do { p0 = __builtin_amdgcn_mfma_f32_32x32x16_bf16(x0, qr[d0], p0, 0, 0, 0); p1 = __builtin_amdgcn_mfma_f32_32x32x16_bf16(x1, qr[d0], p1, 0, 0, 0); } while (0)
  kq_rd(KA(0), a0, a1); kq_rd(KA(1), b0, b1);
  A2_WAITL(2); KM(a0, a1, 0); SBAR(); kq_rd(KA(2), a0, a1);
  A2_WAITL(2); KM(b0, b1, 1); SBAR(); kq_rd(KA(3), b0, b1);
  A2_WAITL(2); KM(a0, a1, 2); SBAR(); kq_rd(KA(4), a0, a1);
  A2_WAITL(2); KM(b0, b1, 3); SBAR(); kq_rd(KA(5), b0, b1);
  A2_WAITL(2); KM(a0, a1, 4); SBAR(); kq_rd(KA(6), a0, a1);
  A2_WAITL(2); KM(b0, b1, 5); SBAR(); kq_rd(KA(7), b0, b1);
  A2_WAITL(2); KM(a0, a1, 6);
  A2_WAITL(0); KM(b0, b1, 7);
#undef KA
#undef KM
}
template <int HB> __device__ __forceinline__ void pv_rd(int vb, s16x4& la, s16x4& ha, s16x4& lb, s16x4& hb) {
  constexpr int blk = HB >> 1, part = HB & 1, D0 = blk & 3, base = (blk >> 2) * 16384;
  la = tr_read<base + v_rd_off(D0, 2 * part, 0)>(vb); ha = tr_read<base + v_rd_off(D0, 2 * part, 1)>(vb);
  lb = tr_read<base + v_rd_off(D0, 2 * part + 1, 0)>(vb); hb = tr_read<base + v_rd_off(D0, 2 * part + 1, 1)>(vb);
}
template <int HB> __device__ __forceinline__ void pv_mm(f32x16* o, s16x4 la, s16x4 ha, s16x4 lb, s16x4 hb, bf16x8 pa0, bf16x8 pa1, bf16x8 pa2, bf16x8 pa3) {
#define PK(L, H) (bf16x8){L[0], L[1], L[2], L[3], H[0], H[1], H[2], H[3]}
  f32x16& od = o[HB >> 1];
  od = __builtin_amdgcn_mfma_f32_32x32x16_bf16((HB & 1) ? pa2 : pa0, PK(la, ha), od, 0, 0, 0);
  od = __builtin_amdgcn_mfma_f32_32x32x16_bf16((HB & 1) ? pa3 : pa1, PK(lb, hb), od, 0, 0, 0);
#undef PK
}
__device__ __forceinline__ void pv_pipe(f32x16* o, int vb, bf16x8 pa0, bf16x8 pa1, bf16x8 pa2, bf16x8 pa3) {
  s16x4 a0, a1, a2, a3, b0, b1, b2, b3;
  pv_rd<0>(vb, a0, a1, a2, a3); pv_rd<1>(vb, b0, b1, b2, b3);
#define STEP(H) A2_WAITL(4); pv_mm<H>(o, a0, a1, a2, a3, pa0, pa1, pa2, pa3); SBAR(); pv_rd<H + 2>(vb, a0, a1, a2, a3); \
                A2_WAITL(4); pv_mm<H + 1>(o, b0, b1, b2, b3, pa0, pa1, pa2, pa3); SBAR(); pv_rd<H + 3>(vb, b0, b1, b2, b3);
  STEP(0) STEP(2) STEP(4) STEP(6) STEP(8) STEP(10) STEP(12)
#undef STEP
  A2_WAITL(4); pv_mm<14>(o, a0, a1, a2, a3, pa0, pa1, pa2, pa3);
  A2_WAITL(0); pv_mm<15>(o, b0, b1, b2, b3, pa0, pa1, pa2, pa3);
}
__device__ __forceinline__ void qkt_asm(f32x16& p0, f32x16& p1, int kaddr, int sw, int hi, const bf16x8* qr) {
  p0 = f32x16{}; p1 = f32x16{};
#pragma unroll
  for (int d0 = 0; d0 < 8; ++d0) {
    const int a0 = kaddr + ((d0 * 32 + hi * 16) ^ sw);
    bf16x8 b0, b1;
    asm volatile("ds_read_b128 %0, %1" : "=&v"(b0) : "v"(a0) : "memory");
    asm volatile("ds_read_b128 %0, %1 offset:8192" : "=&v"(b1) : "v"(a0) : "memory");
    asm volatile("s_waitcnt lgkmcnt(0)" ::: "memory"); SBAR();
    p0 = __builtin_amdgcn_mfma_f32_32x32x16_bf16(b0, qr[d0], p0, 0, 0, 0);
    p1 = __builtin_amdgcn_mfma_f32_32x32x16_bf16(b1, qr[d0], p1, 0, 0, 0);
  }
}
template <int D0> __device__ __forceinline__ void pv_one_lean(f32x16& od, int vb, bf16x8 pa0, bf16x8 pa1, bf16x8 pa2, bf16x8 pa3) {
#define PK(L, H) (bf16x8){L[0], L[1], L[2], L[3], H[0], H[1], H[2], H[3]}
  { const s16x4 l0 = tr_read<v_rd_off(D0, 0, 0)>(vb), h0 = tr_read<v_rd_off(D0, 0, 1)>(vb), l1 = tr_read<v_rd_off(D0, 1, 0)>(vb), h1 = tr_read<v_rd_off(D0, 1, 1)>(vb);
    asm volatile("s_waitcnt lgkmcnt(0)" ::: "memory"); SBAR();
    od = __builtin_amdgcn_mfma_f32_32x32x16_bf16(pa0, PK(l0, h0), od, 0, 0, 0);
    od = __builtin_amdgcn_mfma_f32_32x32x16_bf16(pa1, PK(l1, h1), od, 0, 0, 0); }
  { const s16x4 l2 = tr_read<v_rd_off(D0, 2, 0)>(vb), h2 = tr_read<v_rd_off(D0, 2, 1)>(vb), l3 = tr_read<v_rd_off(D0, 3, 0)>(vb), h3 = tr_read<v_rd_off(D0, 3, 1)>(vb);
    asm volatile("s_waitcnt lgkmcnt(0)" ::: "memory"); SBAR();
    od = __builtin_amdgcn_mfma_f32_32x32x16_bf16(pa2, PK(l2, h2), od, 0, 0, 0);
    od = __builtin_amdgcn_mfma_f32_32x32x16_bf16(pa3, PK(l3, h3), od, 0, 0, 0); }
#undef PK
}
__device__ __forceinline__ void pv_d0_lean(f32x16* o, int vb, bf16x8 pa0, bf16x8 pa1, bf16x8 pa2, bf16x8 pa3) {
  pv_one_lean<0>(o[0], vb, pa0, pa1, pa2, pa3); pv_one_lean<1>(o[1], vb, pa0, pa1, pa2, pa3); pv_one_lean<2>(o[2], vb, pa0, pa1, pa2, pa3); pv_one_lean<3>(o[3], vb, pa0, pa1, pa2, pa3);
}
constexpr int A2_K = 0, A2_V = 32768, A2_WS = 131072 + 1024;
template <int MODE> __device__ __forceinline__ void attn256_unit(const bf16* __restrict__ Qb, const bf16* __restrict__ Kh, const bf16* __restrict__ V0h, const bf16* __restrict__ V1h,
                                             bf16* Ob, int ntiles, char* lds, ATT_LAS unsigned char* ldsl, bf16* __restrict__ OAb, const float* __restrict__ subw, float lam, float eps, float osc) {
  int tid = threadIdx.x; asm volatile("" : "+v"(tid));
  const int wid = tid >> 6, lane = tid & 63, r32 = lane & 31, hi = lane >> 5;
  float m_reg = -1e30f, l_reg = 0; f32x16 o[8] = {}; bf16x8 qr[8];
  { const bf16* Qw = Qb + (long)(wid * QBLK + r32) * 128 + hi * 8;
#pragma unroll
    for (int d0 = 0; d0 < 8; ++d0) qr[d0] = *reinterpret_cast<const bf16x8*>(Qw + d0 * 16);
#pragma unroll
    for (int d0 = 0; d0 < 8; ++d0) asm volatile("" : "+v"(qr[d0])); }
  unsigned koff, voff;
  { const int L = wid * 1024 + lane * 16;
    { const int row = L >> 8; koff = (unsigned)(row * 256 + ((L & 255) ^ ((row & 7) << 4))); }
    { const int sub = L >> 9, w = L & 511, kk = ((sub >> 2) << 3) | (w >> 6), k = (kk & ~0xC) | ((kk & 4) << 1) | ((kk & 8) >> 1), c = (sub & 3) * 32 + ((w & 63) >> 1); voff = (unsigned)(k * 256 + c * 2); } }
  const unsigned ldsw = (unsigned)__builtin_amdgcn_readfirstlane(wid) * 1024u;
#define A2_DMA(kbuf, vbuf, t) do { const char* kb_ = (const char*)Kh + (size_t)(t) * (64 * 256); const char* v0_ = (const char*)V0h + (size_t)(t) * (64 * 256); const char* v1_ = (const char*)V1h + (size_t)(t) * (64 * 256); \
    _Pragma("unroll") for (int i_ = 0; i_ < 2; ++i_) { \
      __builtin_amdgcn_global_load_lds((const unsigned*)(kb_ + i_ * 8192 + koff), (ATT_LAS unsigned*)(ldsl + A2_K + (kbuf) * 16384 + ldsw + i_ * 8192), 16, 0, 0); \
      __builtin_amdgcn_global_load_lds((const unsigned*)(v0_ + i_ * 8192 + voff), (ATT_LAS unsigned*)(ldsl + A2_V + (vbuf) * 32768 + ldsw + i_ * 8192), 16, 0, 0); \
      __builtin_amdgcn_global_load_lds((const unsigned*)(v1_ + i_ * 8192 + voff), (ATT_LAS unsigned*)(ldsl + A2_V + (vbuf) * 32768 + 16384 + ldsw + i_ * 8192), 16, 0, 0); } } while (0)
#define A2_SYNC() do { asm volatile("s_waitcnt vmcnt(0) lgkmcnt(0)" ::: "memory"); __builtin_amdgcn_s_barrier(); asm volatile("" ::: "memory"); } while (0)
  const int vb0 = (int)(uintptr_t)(lds + A2_V) + v_rd_base(lane);
  const int kad0 = (int)(uintptr_t)(lds + A2_K) + r32 * 256, ksw = (r32 & 7) << 4;
  const bool grpB = __builtin_amdgcn_readfirstlane(wid) >= 4;
  A2_DMA(0, 0, 0); A2_SYNC();
  int vc = 0, vp = 2, vn = 1;
  bf16x8 pa0, pa1, pa2, pa3;
  for (int j = 0; j < ntiles; ++j) {
    if (j + 1 < ntiles) A2_DMA((j + 1) & 1, vn, j + 1);
    SBAR();
    if (grpB && j > 0) { pv_pipe(o, vb0 + vp * 32768, pa0, pa1, pa2, pa3); }
    f32x16 p0, p1; float mn, alpha;
    qkt_pipe(p0, p1, kad0 + (j & 1) * 16384, ksw, hi, qr);
    partialSM(p0, p1, m_reg, mn, alpha);
    finishSM(p0, p1, alpha, l_reg, pa0, pa1, pa2, pa3); SBAR();
    if (__any(alpha < 1.f)) {
#pragma unroll
      for (int r = 0; r < 16; ++r) { const float a0_ = __uint_as_float(__builtin_amdgcn_readlane(__float_as_uint(alpha), crow(r, 0))), a1_ = __uint_as_float(__builtin_amdgcn_readlane(__float_as_uint(alpha), crow(r, 1)));
        const float ar = hi ? a1_ : a0_;
#pragma unroll
        for (int d = 0; d < 8; ++d) o[d][r] *= ar; } }
    if (!grpB) { pv_pipe(o, vb0 + vc * 32768, pa0, pa1, pa2, pa3); }
    A2_SYNC();
    vp = vc; vc = vn; vn = (vn == 2) ? 0 : vn + 1;
  }
  if (grpB) { pv_pipe(o, vb0 + vp * 32768, pa0, pa1, pa2, pa3); }
  { int t2 = threadIdx.x; asm volatile("" : "+v"(t2));
    const int wid2 = t2 >> 6, r32b = t2 & 31, hib = (t2 >> 5) & 1;
    float* li2 = (float*)(lds + A2_WS) + wid2 * 64;
    if (hib == 0) li2[r32b] = l_reg; asm volatile("s_waitcnt lgkmcnt(0)" ::: "memory");
    bf16* Ow = Ob + (long)(wid2 * QBLK) * LDO + r32b;
    if constexpr (MODE == 0) {
#pragma unroll
      for (int r = 0; r < 16; ++r) { const int orow = crow(r, hib); const float rl = __builtin_amdgcn_rcpf(li2[orow]);
#pragma unroll
        for (int d0 = 0; d0 < 8; ++d0) Ow[(long)orow * LDO + d0 * 32] = (bf16)(cvtpk(o[d0][r] * rl, 0.f) & 0xffffu); }
    } else {
      float sw[8];
#pragma unroll
      for (int d0 = 0; d0 < 8; ++d0) sw[d0] = subw[d0 * 32 + r32b] * osc;
      bf16* OAw = OAb + (long)(wid2 * QBLK) * 1024 + r32b;
#pragma unroll
      for (int r = 0; r < 16; ++r) { const int orow = crow(r, hib); const float rl = __builtin_amdgcn_rcpf(li2[orow]) * lam; float dv[8]; float ss = 0.f;
#pragma unroll
        for (int d0 = 0; d0 < 8; ++d0) { const float o0 = __uint_as_float(((unsigned)Ow[(long)orow * LDO + d0 * 32]) << 16); dv[d0] = o0 - o[d0][r] * rl; ss += dv[d0] * dv[d0]; }
#pragma unroll
        for (int sh = 1; sh < 32; sh <<= 1) ss += __shfl_xor(ss, sh);
        const float rs = __builtin_amdgcn_rsqf(ss * (1.0f / 256.0f) + eps);
#pragma unroll
        for (int d0 = 0; d0 < 8; ++d0) OAw[(long)orow * 1024 + d0 * 32] = (bf16)(cvtpk(dv[d0] * rs * sw[d0], 0.f) & 0xffffu); }
    } }
  A2_SYNC();
#undef A2_DMA
#undef A2_SYNC
}

typedef float f32x4a __attribute__((ext_vector_type(4)));
#if defined(ATT_CLUSTER_PRIO)
#define A3_PRIO(p) __builtin_amdgcn_s_setprio(p)
#else
#define A3_PRIO(p) do { } while (0)
#endif
__device__ __forceinline__ float xmax16(float v) { auto r = __builtin_amdgcn_permlane16_swap(__float_as_uint(v), __float_as_uint(v), false, false); return fmaxf(__uint_as_float(r[0]), __uint_as_float(r[1])); }
__device__ __forceinline__ float xmax32(float v) { auto r = __builtin_amdgcn_permlane32_swap(__float_as_uint(v), __float_as_uint(v), false, false); return fmaxf(__uint_as_float(r[0]), __uint_as_float(r[1])); }
__device__ __forceinline__ float xadd16(float v) { auto r = __builtin_amdgcn_permlane16_swap(__float_as_uint(v), __float_as_uint(v), false, false); return __uint_as_float(r[0]) + __uint_as_float(r[1]); }
__device__ __forceinline__ float xadd32(float v) { auto r = __builtin_amdgcn_permlane32_swap(__float_as_uint(v), __float_as_uint(v), false, false); return __uint_as_float(r[0]) + __uint_as_float(r[1]); }
__device__ __forceinline__ unsigned cvtpk_b(float lo, float hi) { typedef __bf16 bf2 __attribute__((ext_vector_type(2))); typedef float f2 __attribute__((ext_vector_type(2))); f2 v = {lo, hi}; bf2 b = __builtin_convertvector(v, bf2); return __builtin_bit_cast(unsigned, b); }
__device__ __forceinline__ void rows4(float x, int g, float (&out)[4]) {
#pragma unroll
  for (int j = 0; j < 4; ++j) { const float a0 = __uint_as_float(__builtin_amdgcn_readlane(__float_as_uint(x), j)), a1 = __uint_as_float(__builtin_amdgcn_readlane(__float_as_uint(x), 4 + j)),
      a2 = __uint_as_float(__builtin_amdgcn_readlane(__float_as_uint(x), 8 + j)), a3 = __uint_as_float(__builtin_amdgcn_readlane(__float_as_uint(x), 12 + j));
    out[j] = g == 0 ? a0 : g == 1 ? a1 : g == 2 ? a2 : a3; }
}
template <int OFF> __device__ __forceinline__ bf16x8 krd(int a) { bf16x8 r; asm volatile("ds_read_b128 %0, %1 offset:%2" : "=&v"(r) : "v"(a), "i"(OFF) : "memory"); return r; }
template <int MODE> __device__ __forceinline__ void attn256_unit16(const bf16* __restrict__ Qb, const bf16* __restrict__ Kh, const bf16* __restrict__ V0h, const bf16* __restrict__ V1h,
                                             bf16* Ob, int ntiles, char* lds, ATT_LAS unsigned char* ldsl, bf16* __restrict__ OAb, const float* __restrict__ subw, float lam, float eps, float osc) {
  constexpr float C = SCALE * 1.4426950408889634f;
  int tid = threadIdx.x; asm volatile("" : "+v"(tid));
  const int wid = tid >> 6, lane = tid & 63, q16 = lane & 15, g = lane >> 4;
  float m_reg[2] = {-1e30f, -1e30f}, l_reg[2] = {0.f, 0.f};
  f32x4a o[2][16];
#pragma unroll
  for (int a_ = 0; a_ < 2; ++a_)
#pragma unroll
    for (int b_ = 0; b_ < 16; ++b_) o[a_][b_] = (f32x4a){0.f, 0.f, 0.f, 0.f};
  bf16x8 qr[2][4];
  { const bf16* Qw = Qb + (long)(wid * 32 + q16) * 128 + g * 8;
#pragma unroll
    for (int qb = 0; qb < 2; ++qb)
#pragma unroll
      for (int s = 0; s < 4; ++s) qr[qb][s] = *reinterpret_cast<const bf16x8*>(Qw + qb * 16 * 128 + s * 32);
#pragma unroll
    for (int qb = 0; qb < 2; ++qb)
#pragma unroll
      for (int s = 0; s < 4; ++s) asm volatile("" : "+v"(qr[qb][s])); }
  unsigned koff, voff;
  { const int L = wid * 1024 + lane * 16;
    { const int row = L >> 8; koff = (unsigned)(row * 256 + ((L & 255) ^ ((row & 15) << 4))); }
    { const int sub = L >> 9, w = L & 511, kk = ((sub >> 2) << 3) | (w >> 6), k = (kk & ~0xC) | ((kk & 4) << 1) | ((kk & 8) >> 1), c = (sub & 3) * 32 + (((w & 63) ^ (((sub >> 2) & 1) << 5)) >> 1); voff = (unsigned)(k * 256 + c * 2); } }
  const unsigned ldsw = (unsigned)__builtin_amdgcn_readfirstlane(wid) * 1024u;
#define B3_DMA(kbuf, vbuf, t) do { const char* kb_ = (const char*)Kh + (size_t)(t) * (64 * 256); const char* v0_ = (const char*)V0h + (size_t)(t) * (64 * 256); const char* v1_ = (const char*)V1h + (size_t)(t) * (64 * 256); \
    _Pragma("unroll") for (int i_ = 0; i_ < 2; ++i_) { \
      __builtin_amdgcn_global_load_lds((const unsigned*)(kb_ + i_ * 8192 + koff), (ATT_LAS unsigned*)(ldsl + A2_K + (kbuf) * 16384 + ldsw + i_ * 8192), 16, 0, 0); \
      __builtin_amdgcn_global_load_lds((const unsigned*)(v0_ + i_ * 8192 + voff), (ATT_LAS unsigned*)(ldsl + A2_V + (vbuf) * 32768 + ldsw + i_ * 8192), 16, 0, 0); \
      __builtin_amdgcn_global_load_lds((const unsigned*)(v1_ + i_ * 8192 + voff), (ATT_LAS unsigned*)(ldsl + A2_V + (vbuf) * 32768 + 16384 + ldsw + i_ * 8192), 16, 0, 0); } } while (0)
#define B3_SYNC() do { asm volatile("s_waitcnt vmcnt(0) lgkmcnt(0)" ::: "memory"); __builtin_amdgcn_s_barrier(); asm volatile("" ::: "memory"); } while (0)
#define B3_WAITL(n) do { asm volatile("s_waitcnt lgkmcnt(" #n ")" ::: "memory"); SBAR(); } while (0)
  int ka[4];
#pragma unroll
  for (int s = 0; s < 4; ++s) ka[s] = (int)(uintptr_t)(lds + A2_K) + q16 * 256 + ((64 * s + 16 * g) ^ (q16 << 4));
  const int gs = ((g & 1) << 1) | (g >> 1);
  const int vbE = (int)(uintptr_t)(lds + A2_V) + (gs >> 1) * 2048 + ((q16 >> 2) + 4 * (gs & 1)) * 64 + 8 * (q16 & 3) + (g & 1) * 32, vbO = vbE + 32 - (g & 1) * 64;
#define VOFF(cb, m, t) ((t) * 4096 + (m) * 8192 + (((cb) & 7) >> 1) * 512 + ((cb) >> 3) * 16384)
  const bool grpB = __builtin_amdgcn_readfirstlane(wid) >= 4;
  B3_DMA(0, 0, 0); B3_SYNC();
#if defined(ATT_PRIO)
  if (grpB) __builtin_amdgcn_s_setprio(1);
#endif
  int vc = 0, vp = 2, vn = 1;
  bf16x8 pa[2][2];
#define PV_RD(cb, x0, x1, x2, x3, vb) do { const int vq_ = (((cb) & 1) ? vbO : vbE) + (vb); x0 = tr_read<VOFF(cb, 0, 0)>(vq_); x1 = tr_read<VOFF(cb, 0, 1)>(vq_); x2 = tr_read<VOFF(cb, 1, 0)>(vq_); x3 = tr_read<VOFF(cb, 1, 1)>(vq_); } while (0)
#define PKB(L, H) (bf16x8){L[0], L[1], L[2], L[3], H[0], H[1], H[2], H[3]}
#define PV_MM(cb, x0, x1, x2, x3) do { const bf16x8 b0_ = PKB(x0, x1), b1_ = PKB(x2, x3); \
    o[0][cb] = __builtin_amdgcn_mfma_f32_16x16x32_bf16(pa[0][0], b0_, o[0][cb], 0, 0, 0); o[1][cb] = __builtin_amdgcn_mfma_f32_16x16x32_bf16(pa[1][0], b0_, o[1][cb], 0, 0, 0); \
    o[0][cb] = __builtin_amdgcn_mfma_f32_16x16x32_bf16(pa[0][1], b1_, o[0][cb], 0, 0, 0); o[1][cb] = __builtin_amdgcn_mfma_f32_16x16x32_bf16(pa[1][1], b1_, o[1][cb], 0, 0, 0); } while (0)
#define PV_STEP(cb) B3_WAITL(4); PV_MM(cb, a0, a1, a2, a3); SBAR(); PV_RD(cb + 2, a0, a1, a2, a3, vb_); B3_WAITL(4); PV_MM(cb + 1, b0, b1, b2, b3); SBAR(); PV_RD(cb + 3, b0, b1, b2, b3, vb_);
#define PV_TILE(vbuf) do { const int vb_ = (vbuf) * 32768; s16x4 a0, a1, a2, a3, b0, b1, b2, b3; A3_PRIO(1); \
    PV_RD(0, a0, a1, a2, a3, vb_); PV_RD(1, b0, b1, b2, b3, vb_); \
    PV_STEP(0) PV_STEP(2) PV_STEP(4) PV_STEP(6) PV_STEP(8) PV_STEP(10) PV_STEP(12) \
    B3_WAITL(4); PV_MM(14, a0, a1, a2, a3); B3_WAITL(0); PV_MM(15, b0, b1, b2, b3); A3_PRIO(0); } while (0)
  for (int j = 0; j < ntiles; ++j) {
    if (j + 1 < ntiles) B3_DMA((j + 1) & 1, vn, j + 1);
    SBAR();
    if (grpB && j > 0) PV_TILE(vp);
    f32x4a sc[4][2];
#pragma unroll
    for (int kb = 0; kb < 4; ++kb) { sc[kb][0] = (f32x4a){0.f, 0.f, 0.f, 0.f}; sc[kb][1] = (f32x4a){0.f, 0.f, 0.f, 0.f}; }
    { const int kofs = (j & 1) * 16384; bf16x8 a0, a1, b0, b1;
#define QK_RD(kb, sp, x0, x1) do { x0 = krd<(kb) * 4096>(ka[2 * (sp)] + kofs); x1 = krd<(kb) * 4096>(ka[2 * (sp) + 1] + kofs); } while (0)
#define QK_MM(kb, sp, x0, x1) do { sc[kb][0] = __builtin_amdgcn_mfma_f32_16x16x32_bf16(x0, qr[0][2 * (sp)], sc[kb][0], 0, 0, 0); sc[kb][1] = __builtin_amdgcn_mfma_f32_16x16x32_bf16(x0, qr[1][2 * (sp)], sc[kb][1], 0, 0, 0); \
      sc[kb][0] = __builtin_amdgcn_mfma_f32_16x16x32_bf16(x1, qr[0][2 * (sp) + 1], sc[kb][0], 0, 0, 0); sc[kb][1] = __builtin_amdgcn_mfma_f32_16x16x32_bf16(x1, qr[1][2 * (sp) + 1], sc[kb][1], 0, 0, 0); } while (0)
      A3_PRIO(1); QK_RD(0, 0, a0, a1); QK_RD(0, 1, b0, b1);
      B3_WAITL(2); QK_MM(0, 0, a0, a1); SBAR(); QK_RD(1, 0, a0, a1);
      B3_WAITL(2); QK_MM(0, 1, b0, b1); SBAR(); QK_RD(1, 1, b0, b1);
      B3_WAITL(2); QK_MM(1, 0, a0, a1); SBAR(); QK_RD(2, 0, a0, a1);
      B3_WAITL(2); QK_MM(1, 1, b0, b1); SBAR(); QK_RD(2, 1, b0, b1);
      B3_WAITL(2); QK_MM(2, 0, a0, a1); SBAR(); QK_RD(3, 0, a0, a1);
      B3_WAITL(2); QK_MM(2, 1, b0, b1); SBAR(); QK_RD(3, 1, b0, b1);
      B3_WAITL(2); QK_MM(3, 0, a0, a1);
      B3_WAITL(0); QK_MM(3, 1, b0, b1); A3_PRIO(0);
#undef QK_RD
#undef QK_MM
    }
    float pm[2], alpha[2];
#pragma unroll
    for (int qb = 0; qb < 2; ++qb) { float v = sc[0][qb][0];
#pragma unroll
      for (int kb = 0; kb < 4; ++kb)
#pragma unroll
        for (int e = 0; e < 4; ++e) v = fmaxf(v, sc[kb][qb][e]);
      pm[qb] = xmax32(xmax16(v)); }
    if (__builtin_expect(__all(pm[0] - m_reg[0] <= THR / SCALE && pm[1] - m_reg[1] <= THR / SCALE), 1)) { alpha[0] = 1.f; alpha[1] = 1.f; }
    else {
#pragma unroll
      for (int qb = 0; qb < 2; ++qb) { const float mn = fmaxf(m_reg[qb], pm[qb]); alpha[qb] = __builtin_amdgcn_exp2f((m_reg[qb] - mn) * C); m_reg[qb] = mn; } }
#pragma unroll
    for (int qb = 0; qb < 2; ++qb) { const float mnC = -m_reg[qb] * C; float ps = 0.f;
#pragma unroll
      for (int kb = 0; kb < 4; ++kb) { sc[kb][qb] = sc[kb][qb] * C + mnC;
#pragma unroll
        for (int e = 0; e < 4; ++e) { sc[kb][qb][e] = __builtin_amdgcn_exp2f(sc[kb][qb][e]); ps += sc[kb][qb][e]; } }
      ps = xadd32(xadd16(ps));
      l_reg[qb] = l_reg[qb] * alpha[qb] + ps;
#pragma unroll
      for (int m = 0; m < 2; ++m) { u32x4 w = {cvtpk_b(sc[2 * m][qb][0], sc[2 * m][qb][1]), cvtpk_b(sc[2 * m][qb][2], sc[2 * m][qb][3]), cvtpk_b(sc[2 * m + 1][qb][0], sc[2 * m + 1][qb][1]), cvtpk_b(sc[2 * m + 1][qb][2], sc[2 * m + 1][qb][3])};
        pa[qb][m] = *reinterpret_cast<bf16x8*>(&w); } }
    SBAR();
    if (__any(alpha[0] < 1.f || alpha[1] < 1.f)) {
#pragma unroll
      for (int qb = 0; qb < 2; ++qb) { float ar[4]; rows4(alpha[qb], g, ar);
#pragma unroll
        for (int cb = 0; cb < 16; ++cb)
#pragma unroll
          for (int e = 0; e < 4; ++e) o[qb][cb][e] *= ar[e]; } }
    if (!grpB) PV_TILE(vc);
    B3_SYNC();
    vp = vc; vc = vn; vn = (vn == 2) ? 0 : vn + 1;
  }
  if (grpB) PV_TILE(vp);
#if defined(ATT_PRIO)
  __builtin_amdgcn_s_setprio(0);
#endif
  { int t2 = threadIdx.x; asm volatile("" : "+v"(t2));
    const int wid2 = t2 >> 6, c16 = t2 & 15, g2 = (t2 >> 4) & 3;
    float inv[2][4];
#pragma unroll
    for (int qb = 0; qb < 2; ++qb) { float lr[4]; rows4(l_reg[qb], g2, lr);
#pragma unroll
      for (int e = 0; e < 4; ++e) inv[qb][e] = __builtin_amdgcn_rcpf(lr[e]); }
    u32x4* Sv = reinterpret_cast<u32x4*>(Ob) + (t2 & 511);
    if constexpr (MODE == 0) {
#pragma unroll
      for (int qb = 0; qb < 2; ++qb)
#pragma unroll
        for (int e = 0; e < 4; ++e)
#pragma unroll
          for (int hh = 0; hh < 2; ++hh) { const float s_ = inv[qb][e]; u32x4 w;
            w.x = cvtpk_b(o[qb][8 * hh + 0][e] * s_, o[qb][8 * hh + 1][e] * s_); w.y = cvtpk_b(o[qb][8 * hh + 2][e] * s_, o[qb][8 * hh + 3][e] * s_);
            w.z = cvtpk_b(o[qb][8 * hh + 4][e] * s_, o[qb][8 * hh + 5][e] * s_); w.w = cvtpk_b(o[qb][8 * hh + 6][e] * s_, o[qb][8 * hh + 7][e] * s_);
            Sv[(qb * 8 + e * 2 + hh) * 512] = w; }
    } else {
      float sw[16];
#pragma unroll
      for (int cb = 0; cb < 16; ++cb) sw[cb] = subw[cb * 16 + c16] * osc;
      bf16* OAw = OAb + (long)(wid2 * 32 + 4 * g2) * 1024 + c16;
#pragma unroll
      for (int qb = 0; qb < 2; ++qb) { u32x4 ov[4][2];
#pragma unroll
        for (int e = 0; e < 4; ++e) { ov[e][0] = Sv[(qb * 8 + e * 2) * 512]; ov[e][1] = Sv[(qb * 8 + e * 2 + 1) * 512]; }
        asm volatile("" ::: "memory");
#pragma unroll
        for (int e = 0; e < 4; ++e) { float of[16];
          of[0] = __uint_as_float(ov[e][0].x << 16); of[1] = __uint_as_float(ov[e][0].x & 0xffff0000u); of[2] = __uint_as_float(ov[e][0].y << 16); of[3] = __uint_as_float(ov[e][0].y & 0xffff0000u);
          of[4] = __uint_as_float(ov[e][0].z << 16); of[5] = __uint_as_float(ov[e][0].z & 0xffff0000u); of[6] = __uint_as_float(ov[e][0].w << 16); of[7] = __uint_as_float(ov[e][0].w & 0xffff0000u);
          of[8] = __uint_as_float(ov[e][1].x << 16); of[9] = __uint_as_float(ov[e][1].x & 0xffff0000u); of[10] = __uint_as_float(ov[e][1].y << 16); of[11] = __uint_as_float(ov[e][1].y & 0xffff0000u);
          of[12] = __uint_as_float(ov[e][1].z << 16); of[13] = __uint_as_float(ov[e][1].z & 0xffff0000u); of[14] = __uint_as_float(ov[e][1].w << 16); of[15] = __uint_as_float(ov[e][1].w & 0xffff0000u);
          float dv[16]; float ss = 0.f; const float rl = inv[qb][e] * lam;
#pragma unroll
          for (int cb = 0; cb < 16; ++cb) { dv[cb] = of[cb] - o[qb][cb][e] * rl; ss += dv[cb] * dv[cb]; }
#pragma unroll
          for (int sh = 1; sh < 16; sh <<= 1) ss += __shfl_xor(ss, sh);
          const float rs = __builtin_amdgcn_rsqf(ss * (1.0f / 256.0f) + eps);
#pragma unroll
          for (int cb = 0; cb < 16; ++cb) OAw[(long)(qb * 16 + e) * 1024 + cb * 16] = (bf16)(cvtpk_b(dv[cb] * rs * sw[cb], 0.f) & 0xffffu); }
        asm volatile("" ::: "memory"); }
    } }
  B3_SYNC();
#undef B3_DMA
#undef B3_SYNC
#undef B3_WAITL
#undef VOFF
#undef PV_RD
#undef PKB
#undef PV_MM
#undef PV_STEP
#undef PV_TILE
}

template <int D0, int SKIP> __device__ __forceinline__ void pv_one_skip(f32x16& od, int vb, bf16x8 pa0, bf16x8 pa1, bf16x8 pa2, bf16x8 pa3) {
  constexpr int K0 = SKIP == 0 ? 1 : 0, K1 = SKIP == 0 ? 2 : 1, K2 = SKIP == 0 ? 3 : 2;
  const s16x4 l0 = tr_read<v_rd_off(D0, K0, 0)>(vb), h0 = tr_read<v_rd_off(D0, K0, 1)>(vb), l1 = tr_read<v_rd_off(D0, K1, 0)>(vb), h1 = tr_read<v_rd_off(D0, K1, 1)>(vb);
  const s16x4 l2 = tr_read<v_rd_off(D0, K2, 0)>(vb), h2 = tr_read<v_rd_off(D0, K2, 1)>(vb);
  asm volatile("s_waitcnt lgkmcnt(0)" ::: "memory"); SBAR();
#define PK(L, H) (bf16x8){L[0], L[1], L[2], L[3], H[0], H[1], H[2], H[3]}
  od = __builtin_amdgcn_mfma_f32_32x32x16_bf16(SKIP == 0 ? pa1 : pa0, PK(l0, h0), od, 0, 0, 0);
  od = __builtin_amdgcn_mfma_f32_32x32x16_bf16(SKIP == 0 ? pa2 : pa1, PK(l1, h1), od, 0, 0, 0);
  od = __builtin_amdgcn_mfma_f32_32x32x16_bf16(SKIP == 0 ? pa3 : pa2, PK(l2, h2), od, 0, 0, 0);
#undef PK
}
template <int SKIP> __device__ __forceinline__ void pv_d0_skip(f32x16* o, int vb, bf16x8 pa0, bf16x8 pa1, bf16x8 pa2, bf16x8 pa3) {
  pv_one_skip<0, SKIP>(o[0], vb, pa0, pa1, pa2, pa3); pv_one_skip<1, SKIP>(o[1], vb, pa0, pa1, pa2, pa3); pv_one_skip<2, SKIP>(o[2], vb, pa0, pa1, pa2, pa3); pv_one_skip<3, SKIP>(o[3], vb, pa0, pa1, pa2, pa3);
}
__device__ __forceinline__ void na_unit(const bf16* __restrict__ QKV, bf16* __restrict__ ON, const float* __restrict__ rpb, int b, int h, int rblk, char* lds) {
  constexpr float C = SCALE * 1.4426950408889634f, L2E = 1.4426950408889634f;
  const int tid = threadIdx.x, wid = tid >> 6, lane = tid & 63, r32 = lane & 31, hi = lane >> 5;
  bf16* V_lds = (bf16*)lds; bf16* K_lds = (bf16*)(lds + 2 * SHM_V);
  float* wsf = (float*)(lds + 2 * SHM_V + 2 * SHM_K) + wid * 64; float* li_l = wsf; float* al_l = wsf + 32;
  float* biasL = (float*)(lds + 2 * SHM_V + 2 * SHM_K + NW * 64 * 4);
  const int r = rblk * 4 + (wid >> 1), c = (wid & 1) * 32 + r32;
  const int rs = min(max(r - 4, 0), 120), cs = min(max(c - 8, 0), 48);
  bf16x8 qr[8];
  const bf16* const hb = QKV + ((long)b * 48 + h) * 8192 * 128;
  { const bf16* Qw = hb + (24L * 8192 + r * 64 + c) * 128 + hi * 8;
#pragma unroll
    for (int d0 = 0; d0 < 8; ++d0) qr[d0] = *reinterpret_cast<const bf16x8*>(Qw + d0 * 16); }
  for (int idx = tid; idx < 15 * 32; idx += 512) { const int dr = idx >> 5, dc = idx & 31; biasL[idx] = dc < 31 ? rpb[(h * 15 + dr) * 31 + dc] * L2E : 0.f; }
  const int kr_lo = min(max(rblk * 4 - 4, 0), 120), kr_hi = min(max(rblk * 4 + 3 - 4, 0), 120) + 7;
  const int sr = tid >> 4, sc = (tid & 15) * 8, vst0 = v_st(sr, sc), vst1 = v_st(32 + sr, sc);
  const int vb0 = (int)(uintptr_t)V_lds + v_rd_base(lane);
  float m_reg = -1e30f, l_reg = 0.f; f32x16 o[4] = {};
  const bf16* kp = hb + (32L * 8192 + kr_lo * 64 + sr) * 128 + sc;
  bf16x8 k0 = *reinterpret_cast<const bf16x8*>(kp), k1 = *reinterpret_cast<const bf16x8*>(kp + 32 * 128);
  bf16x8 v0 = *reinterpret_cast<const bf16x8*>(kp + 8L * 8192 * 128), v1 = *reinterpret_cast<const bf16x8*>(kp + 8L * 8192 * 128 + 32 * 128);
  for (int kr = kr_lo; kr <= kr_hi; ++kr) {
    const int bo = ((kr - kr_lo) & 1) * (int)SHM_V;
    *(bf16x8*)((char*)K_lds + bo + KSWZ(sr, sc * 2)) = k0; *(bf16x8*)((char*)K_lds + bo + KSWZ(32 + sr, sc * 2)) = k1;
    *(bf16x8*)((char*)V_lds + bo + vst0) = v0; *(bf16x8*)((char*)V_lds + bo + vst1) = v1;
    __syncthreads();
    if (kr < kr_hi) { kp += 64 * 128;
      k0 = *reinterpret_cast<const bf16x8*>(kp); k1 = *reinterpret_cast<const bf16x8*>(kp + 32 * 128);
      v0 = *reinterpret_cast<const bf16x8*>(kp + 8L * 8192 * 128); v1 = *reinterpret_cast<const bf16x8*>(kp + 8L * 8192 * 128 + 32 * 128); }
    if (kr >= rs && kr < rs + 8) {
      f32x16 p0, p1; qkt(p0, p1, (const bf16*)((const char*)K_lds + bo), qr, r32, hi);
      const float* bl = biasL + (kr - r + 7) * 32;
      float pmax = -INFINITY;
#pragma unroll
      for (int rr = 0; rr < 16; ++rr) { const int kc0 = crow(rr, hi), kc1 = kc0 + 32;
        const bool ok0 = (unsigned)(kc0 - cs) < 16u, ok1 = (unsigned)(kc1 - cs) < 16u;
        const float b0 = bl[ok0 ? kc0 - c + 15 : 0], b1 = bl[ok1 ? kc1 - c + 15 : 0];
        p0[rr] = ok0 ? fmaf(p0[rr], C, b0) : -INFINITY; p1[rr] = ok1 ? fmaf(p1[rr], C, b1) : -INFINITY;
        pmax = fmaxf(pmax, fmaxf(p0[rr], p1[rr])); }
      { auto t = __builtin_amdgcn_permlane32_swap(__float_as_uint(pmax), __float_as_uint(pmax), false, false);
        pmax = fmaxf(__uint_as_float(t[0]), __uint_as_float(t[1])); }
      const bool grow = !__all(pmax - m_reg <= 11.5f);
      float alpha = 1.f;
      if (grow) { const float mn = fmaxf(m_reg, pmax); alpha = __builtin_amdgcn_exp2f(m_reg - mn); m_reg = mn; }
      float ps = 0.f;
#pragma unroll
      for (int rr = 0; rr < 16; ++rr) { p0[rr] = __builtin_amdgcn_exp2f(p0[rr] - m_reg); p1[rr] = __builtin_amdgcn_exp2f(p1[rr] - m_reg); ps += p0[rr] + p1[rr]; }
      { auto t = __builtin_amdgcn_permlane32_swap(__float_as_uint(ps), __float_as_uint(ps), false, false);
        ps = __uint_as_float(t[0]) + __uint_as_float(t[1]); }
      l_reg = l_reg * alpha + ps;
      if (grow) { if (hi == 0) al_l[r32] = alpha; asm volatile("s_waitcnt lgkmcnt(0)" ::: "memory");
#pragma unroll
        for (int d = 0; d < 4; ++d)
#pragma unroll
          for (int rr = 0; rr < 16; ++rr) o[d][rr] *= al_l[crow(rr, hi)]; }
      bf16x8 pa0, pa1, pa2, pa3;
#define PK4(P, BASE, OUT) do { unsigned a0 = cvtpk(P[BASE + 0], P[BASE + 1]), a1 = cvtpk(P[BASE + 2], P[BASE + 3]);   \
    unsigned b0_ = cvtpk(P[BASE + 4], P[BASE + 5]), b1_ = cvtpk(P[BASE + 6], P[BASE + 7]);                              \
    auto r0 = __builtin_amdgcn_permlane32_swap(a0, b0_, false, false); auto r1 = __builtin_amdgcn_permlane32_swap(a1, b1_, false, false); \
    u32x4 w = {r0[0], r1[0], r0[1], r1[1]}; OUT = *reinterpret_cast<bf16x8*>(&w); } while (0)
      PK4(p0, 0, pa0); PK4(p0, 8, pa1); PK4(p1, 0, pa2); PK4(p1, 8, pa3);
#undef PK4
      { const bool odd = (wid & 1) != 0;
        const bf16x8 qa0 = odd ? pa1 : pa0, qa1 = odd ? pa2 : pa1, qa2 = odd ? pa3 : pa2;
        pv_d0_skip<3>(o, vb0 + bo + (odd ? 4096 : 0), qa0, qa1, qa2, qa2); }
    }
  }
  if (hi == 0) li_l[r32] = l_reg; asm volatile("s_waitcnt lgkmcnt(0)" ::: "memory");
  bf16* Ow = ON + ((long)b * 8192 + r * 64 + (wid & 1) * 32) * 1024 + h * 128;
#pragma unroll
  for (int rr = 0; rr < 16; ++rr) { const int orow = crow(rr, hi); const float rl = __builtin_amdgcn_rcpf(li_l[orow]);
#pragma unroll
    for (int d0 = 0; d0 < 4; ++d0) Ow[(long)orow * 1024 + d0 * 32 + r32] = (bf16)(cvtpk(o[d0][rr] * rl, 0.f) & 0xffffu); }
  __syncthreads();
}
}

constexpr int NWAVES = 8;
constexpr int BATCH = 4, SEQ = 8192, DM = 2048, MTOK = BATCH * SEQ, DFF = 8192, NIN = 10240;
constexpr float EPS = 1e-6f;
constexpr size_t MiB = 1u << 20;
constexpr size_t WS_SS = 0;
constexpr size_t WS_ROPE = 0;
constexpr size_t WS_CTL = 4 * MiB, CTL_ZERO_BYTES = 262144, WS_CNT = WS_CTL + 65536;
constexpr size_t WS_WIN = 8 * MiB, WS_WA = 48 * MiB, WS_WB = 52 * MiB, WS_WOUT = 56 * MiB, WS_WUP = 64 * MiB, WS_WDN = 96 * MiB;
constexpr size_t WS_H1 = 128 * MiB;
constexpr size_t WS_ON = 128 * MiB, WS_OA = 192 * MiB, WS_H2 = 128 * MiB;
constexpr size_t WS_QKV = 256 * MiB;
constexpr size_t WS_T = 256 * MiB, WS_MX = 512 * MiB, WS_U = 256 * MiB;
constexpr size_t WS_G = 640 * MiB;
constexpr size_t WS_OD = 896 * MiB;
constexpr size_t WS_Y = 896 * MiB;
constexpr size_t WS_Y2 = 768 * MiB;
constexpr size_t WS_END = 1024 * MiB;
constexpr int LDS_BYTES = 147456, MISC_OFF = 131072 + 320;

typedef unsigned short bf16;
typedef float f32x4 __attribute__((ext_vector_type(4)));
typedef unsigned u32x4v __attribute__((ext_vector_type(4)));
typedef unsigned u32x2v __attribute__((ext_vector_type(2)));
#define LAS __attribute__((address_space(3)))
#define LDS_WAIT() asm volatile("s_waitcnt lgkmcnt(0)" ::: "memory")

__device__ __forceinline__ unsigned pk2(float lo, float hi) { return pg8::cvt_pk_bf16(lo, hi); }
__device__ __forceinline__ float wave_sum(float v) {
#pragma unroll
    for (int o = 1; o < 64; o <<= 1) v += __shfl_xor(v, o);
    return v;
}
template <bool ROPE> __device__ __forceinline__ void p0_transpose_item(const float* W, int K, int N, bf16* WT, LAS float* scr, int item, int lane) {
    const int nblk = N / 32, kb = item / nblk, nb = item % nblk, k0 = 64 * kb, n0 = 32 * nb;
    f32x4 wv[8];
#pragma unroll
    for (int i = 0; i < 8; ++i) wv[i] = *(const f32x4*)(W + (size_t)(k0 + 8 * i + (lane >> 3)) * N + n0 + (lane & 7) * 4);
#pragma unroll
    for (int i = 0; i < 8; ++i) { LAS float* d = scr + (8 * i + (lane >> 3)) * 33 + (lane & 7) * 4; d[0] = wv[i].x; d[1] = wv[i].y; d[2] = wv[i].z; d[3] = wv[i].w; }
    LDS_WAIT(); asm volatile("" ::: "memory");
    const int c = lane & 7;
#pragma unroll
    for (int j = 0; j < 4; ++j) { const int n = (lane >> 3) + 8 * j; const LAS float* s = scr + (8 * c) * 33 + n;
        u32x4v o; o.x = pk2(s[0 * 33], s[1 * 33]); o.y = pk2(s[2 * 33], s[3 * 33]); o.z = pk2(s[4 * 33], s[5 * 33]); o.w = pk2(s[6 * 33], s[7 * 33]);
        int dn = n0 + n;
        if (ROPE && dn < 2048) { const int jj = dn & 127; dn = (dn & ~127) + (jj < 64 ? 2 * jj : 2 * (jj - 64) + 1); }
        *(u32x4v*)(WT + (size_t)dn * K + k0 + 8 * c) = o; }
    LDS_WAIT(); asm volatile("" ::: "memory");
}

#define XB_TMO      128
#define XB_XCNT(j)  (256  + 64 * (j))
#define XB_XSUB(j)  (1280 + 64 * (j))
#define XB_XGEN(j)  (2304 + 64 * (j))
#define XB_TOP      3328
#define XB_TOPGEN   3392
#define XCD_BAR_WORDS 3456
#define XB_SPIN_CAP (1u << 18)

__device__ __forceinline__ unsigned xb_ld(unsigned* p)              { return __hip_atomic_load(p, __ATOMIC_RELAXED, __HIP_MEMORY_SCOPE_AGENT); }
__device__ __forceinline__ unsigned xb_add(unsigned* p, unsigned v) { return __hip_atomic_fetch_add(p, v, __ATOMIC_RELAXED, __HIP_MEMORY_SCOPE_AGENT); }
__device__ __forceinline__ unsigned xb_xcc_id() { return (unsigned)__builtin_amdgcn_s_getreg((3 << 11) | 20) & 0xFu; }
#define XB_SPIN(cond, bar) do { unsigned _sp = 0; while (cond) { __builtin_amdgcn_s_sleep(1); \
    if ((++_sp & 255u) == 0u) { if (xb_ld(&(bar)[XB_TMO])) break; if (_sp > XB_SPIN_CAP) { atomicAdd(&(bar)[XB_TMO], 1u); break; } } } } while (0)

struct XcdBarrier {
    unsigned* bar; unsigned x;
    volatile LAS unsigned* st;
};

__device__ __forceinline__ XcdBarrier xcd_barrier_post(unsigned* bar, volatile LAS unsigned* st) {
    XcdBarrier b; b.bar = bar; b.x = xb_xcc_id(); b.st = st;
    if (threadIdx.x == 0) (void)xb_add(&bar[XB_XCNT(b.x)], 1u);
    return b;
}
__device__ __forceinline__ void xcd_barrier_complete(unsigned* bar, unsigned x, unsigned& nloc, unsigned& nx) {
    const unsigned G = gridDim.x * gridDim.y * gridDim.z;
    unsigned sum, cnt, mine, sp = 0u;
    for (;;) {
        sum = 0u; cnt = 0u; mine = 0u;
#pragma unroll
        for (unsigned j = 0; j < 16; ++j) { const unsigned c = xb_ld(&bar[XB_XCNT(j)]); sum += c; cnt += (c > 0u) ? 1u : 0u; mine = (j == x) ? c : mine; }
        if (sum == G) break;
        __builtin_amdgcn_s_sleep(1);
        if ((++sp & 255u) == 0u) { if (xb_ld(&bar[XB_TMO])) break; if (sp > XB_SPIN_CAP) { atomicAdd(&bar[XB_TMO], 1u); break; } }
    }
    nloc = mine > 0u ? mine : 1u; nx = cnt > 0u ? cnt : 1u;
}

__device__ __forceinline__ void xcd_barrier(const XcdBarrier& b) {
    asm volatile("s_waitcnt vmcnt(0)" ::: "memory");
    __syncthreads();
    if (threadIdx.x == 0) {
        unsigned* bar = b.bar;
        __builtin_amdgcn_s_waitcnt(0);
        unsigned nloc = b.st[0], nx = b.st[1];
        if (nloc == 0u) { xcd_barrier_complete(bar, b.x, nloc, nx); b.st[0] = nloc; b.st[1] = nx; }
        const unsigned old = xb_add(&bar[XB_XSUB(b.x)], 1u);
        const unsigned gen = old / nloc;
        if (old + 1u == (gen + 1u) * nloc) {
            __builtin_amdgcn_fence(__ATOMIC_RELEASE, "agent");
            asm volatile("s_waitcnt vmcnt(0)" ::: "memory");
            const unsigned og = xb_add(&bar[XB_TOP], 1u);
            const unsigned tg = og / nx;
            if (og + 1u == (tg + 1u) * nx) xb_add(&bar[XB_TOPGEN], 1u);
            else XB_SPIN(xb_ld(&bar[XB_TOPGEN]) == tg, bar);
            __builtin_amdgcn_fence(__ATOMIC_ACQUIRE, "agent");
            xb_add(&bar[XB_XGEN(b.x)], 1u);
            asm volatile("s_waitcnt vmcnt(0)" ::: "memory");
        } else {
            XB_SPIN(xb_ld(&bar[XB_XGEN(b.x)]) == gen, bar);
            __builtin_amdgcn_fence(__ATOMIC_ACQUIRE, "agent");
            asm volatile("s_waitcnt vmcnt(0)" ::: "memory");
        }
    }
    __syncthreads();
}

#ifndef REP_OTHERS
#define REP_OTHERS 1
#endif
#if defined(ATT_MFMA32)
#define ATT_UNIT attn256_unit
#else
#define ATT_UNIT attn256_unit16
#endif
struct Args { const float* in[17]; float* out; unsigned char* ws; int ph_lo, ph_hi; };

__global__ void __launch_bounds__(NWAVES * 64, 2) mk_fwd(Args a) {
    extern __shared__ __attribute__((aligned(16))) unsigned char lds[];
    cg::grid_group grid = cg::this_grid();
#define tid ((int)threadIdx.x)
#define lane (tid & 63)
#define wave (__builtin_amdgcn_readfirstlane(tid >> 6))
#define G ((int)gridDim.x)
#define gw ((int)blockIdx.x * NWAVES + wave)
#define NGW (G * NWAVES)
    unsigned char* const ws = a.ws;
#define x_in (a.in[0])
#define out_p (a.out)
#define SS ((float*)(ws + WS_SS))
#define ropeC ((float*)(ws + WS_ROPE))
#define ropeS (ropeC + 8192 * 64)
#define Win_t ((bf16*)(ws + WS_WIN))
#define Wa_t ((bf16*)(ws + WS_WA))
#define Wb_t ((bf16*)(ws + WS_WB))
#define Wout_t ((bf16*)(ws + WS_WOUT))
#define Wup_t ((bf16*)(ws + WS_WUP))
#define Wdn_t ((bf16*)(ws + WS_WDN))
#define H1 ((bf16*)(ws + WS_H1))
#define ONb ((bf16*)(ws + WS_ON))
#define OAb ((bf16*)(ws + WS_OA))
#define H2 ((bf16*)(ws + WS_H2))
#define QKV ((bf16*)(ws + WS_QKV))
#define Tb ((bf16*)(ws + WS_T))
#define MX ((bf16*)(ws + WS_MX))
#define Ub ((bf16*)(ws + WS_U))
#define Gb ((bf16*)(ws + WS_G))
#define OD ((bf16*)(ws + WS_OD))
#define Yb ((bf16*)(ws + WS_Y))
#define Y2 ((bf16*)(ws + WS_Y2))
    const int lo = a.ph_lo, hi = a.ph_hi;
    for (int u = tid; u < (LDS_BYTES - 131072) / 4; u += NWAVES * 64) ((LAS unsigned*)((LAS unsigned char*)lds + 131072))[u] = 0u;
    __syncthreads();
    XcdBarrier bar = xcd_barrier_post((unsigned*)(ws + WS_CTL), (volatile LAS unsigned*)((LAS unsigned char*)lds + MISC_OFF) + 8);
    grid.sync();
#ifndef PHMASK
#define PHMASK 0x3ff
#endif
#define IN(k) (((PHMASK >> (k)) & 1) && lo <= (k) && (k) < hi)
#define SEAM(k) do { if (lo <= (k) && (k) + 1 < hi) xcd_barrier(bar); } while (0)

    if (IN(0)) {
        LAS float* scr = (LAS float*)((LAS unsigned char*)lds + wave * 16384);
        constexpr int I_IN = (DM / 64) * (NIN / 32), I_A = (1024 / 64) * (DM / 32), I_O = (DM / 64) * (DM / 32), I_UP = (DM / 64) * (DFF / 32), I_DN = (DFF / 64) * (DM / 32);
        constexpr int NITEMS = I_IN + 2 * I_A + I_O + I_UP + I_DN;
        for (int it = gw; it < NITEMS; it += NGW) {
            int r = it;
            if (r < I_IN) { p0_transpose_item<true>(a.in[1], DM, NIN, Win_t, scr, r, lane); continue; } r -= I_IN;
            if (r < I_A) { p0_transpose_item<false>(a.in[2], 1024, DM, Wa_t, scr, r, lane); continue; } r -= I_A;
            if (r < I_A) { p0_transpose_item<false>(a.in[3], 1024, DM, Wb_t, scr, r, lane); continue; } r -= I_A;
            if (r < I_O) { p0_transpose_item<false>(a.in[4], DM, DM, Wout_t, scr, r, lane); continue; } r -= I_O;
            if (r < I_UP) { p0_transpose_item<false>(a.in[15], DM, DFF, Wup_t, scr, r, lane); continue; } r -= I_UP;
            p0_transpose_item<false>(a.in[16], DFF, DM, Wdn_t, scr, r, lane);
        }
        for (int e = blockIdx.x * 512 + tid; e < 8192 * 64; e += G * 512) {
            const int pos = e >> 6, i = e & 63;
            const float inv = (float)exp(-(double)i * (9.210340371976184 / 64.0));
            const float ang = (float)pos * inv;
            const double t = (double)ang * 0.15915494309189535; const float fr = (float)(t - rint(t));
            ropeC[e] = __builtin_amdgcn_cosf(fr); ropeS[e] = __builtin_amdgcn_sinf(fr);
        }
        const float* g0 = a.in[5];
        f32x4 g0v[8];
#pragma unroll
        for (int j = 0; j < 8; ++j) g0v[j] = ((const f32x4*)g0)[lane + 64 * j];
        for (int m0 = gw; m0 < MTOK; m0 += 2 * NGW) {
            f32x4 v[2][8]; float s[2] = {0.f, 0.f};
#pragma unroll
            for (int q = 0; q < 2; ++q) { const f32x4* xr = (const f32x4*)(x_in + (size_t)(m0 + q * NGW) * DM) + lane;
#pragma unroll
                for (int j = 0; j < 8; ++j) v[q][j] = xr[64 * j]; }
#pragma unroll
            for (int q = 0; q < 2; ++q)
#pragma unroll
                for (int j = 0; j < 8; ++j) s[q] += (v[q][j].x * v[q][j].x + v[q][j].y * v[q][j].y) + (v[q][j].z * v[q][j].z + v[q][j].w * v[q][j].w);
#pragma unroll
            for (int q = 0; q < 2; ++q) { const float rstd = __builtin_amdgcn_rsqf(wave_sum(s[q]) * (1.f / DM) + EPS);
                u32x2v* o8 = (u32x2v*)(H1 + (size_t)(m0 + q * NGW) * DM) + lane;
#pragma unroll
                for (int j = 0; j < 8; ++j) { const f32x4 gv = g0v[j]; u32x2v w; w.x = pk2(v[q][j].x * rstd * gv.x, v[q][j].y * rstd * gv.y); w.y = pk2(v[q][j].z * rstd * gv.z, v[q][j].w * rstd * gv.w); o8[64 * j] = w; } }
        }
    }
#if defined(REP_P0)
    __syncthreads();
    if (IN(0)) {
        LAS float* scr = (LAS float*)((LAS unsigned char*)lds + wave * 16384);
        constexpr int I_IN = (DM / 64) * (NIN / 32), I_A = (1024 / 64) * (DM / 32), I_O = (DM / 64) * (DM / 32), I_UP = (DM / 64) * (DFF / 32), I_DN = (DFF / 64) * (DM / 32);
        constexpr int NITEMS = I_IN + 2 * I_A + I_O + I_UP + I_DN;
        for (int it = gw; it < NITEMS; it += NGW) {
            int r = it;
            if (r < I_IN) { p0_transpose_item<true>(a.in[1], DM, NIN, Win_t, scr, r, lane); continue; } r -= I_IN;
            if (r < I_A) { p0_transpose_item<false>(a.in[2], 1024, DM, Wa_t, scr, r, lane); continue; } r -= I_A;
            if (r < I_A) { p0_transpose_item<false>(a.in[3], 1024, DM, Wb_t, scr, r, lane); continue; } r -= I_A;
            if (r < I_O) { p0_transpose_item<false>(a.in[4], DM, DM, Wout_t, scr, r, lane); continue; } r -= I_O;
            if (r < I_UP) { p0_transpose_item<false>(a.in[15], DM, DFF, Wup_t, scr, r, lane); continue; } r -= I_UP;
            p0_transpose_item<false>(a.in[16], DFF, DM, Wdn_t, scr, r, lane);
        }
        for (int e = blockIdx.x * 512 + tid; e < 8192 * 64; e += G * 512) {
            const int pos = e >> 6, i = e & 63;
            const float inv = (float)exp(-(double)i * (9.210340371976184 / 64.0));
            const float ang = (float)pos * inv;
            const double t = (double)ang * 0.15915494309189535; const float fr = (float)(t - rint(t));
            ropeC[e] = __builtin_amdgcn_cosf(fr); ropeS[e] = __builtin_amdgcn_sinf(fr);
        }
        const float* g0 = a.in[5];
        f32x4 g0v[8];
#pragma unroll
        for (int j = 0; j < 8; ++j) g0v[j] = ((const f32x4*)g0)[lane + 64 * j];
        for (int m0 = gw; m0 < MTOK; m0 += 2 * NGW) {
            f32x4 v[2][8]; float s[2] = {0.f, 0.f};
#pragma unroll
            for (int q = 0; q < 2; ++q) { const f32x4* xr = (const f32x4*)(x_in + (size_t)(m0 + q * NGW) * DM) + lane;
#pragma unroll
                for (int j = 0; j < 8; ++j) v[q][j] = xr[64 * j]; }
#pragma unroll
            for (int q = 0; q < 2; ++q)
#pragma unroll
                for (int j = 0; j < 8; ++j) s[q] += (v[q][j].x * v[q][j].x + v[q][j].y * v[q][j].y) + (v[q][j].z * v[q][j].z + v[q][j].w * v[q][j].w);
#pragma unroll
            for (int q = 0; q < 2; ++q) { const float rstd = __builtin_amdgcn_rsqf(wave_sum(s[q]) * (1.f / DM) + EPS);
                u32x2v* o8 = (u32x2v*)(H1 + (size_t)(m0 + q * NGW) * DM) + lane;
#pragma unroll
                for (int j = 0; j < 8; ++j) { const f32x4 gv = g0v[j]; u32x2v w; w.x = pk2(v[q][j].x * rstd * gv.x, v[q][j].y * rstd * gv.y); w.y = pk2(v[q][j].z * rstd * gv.z, v[q][j].w * rstd * gv.w); o8[64 * j] = w; } }
        }
    }
#endif
    SEAM(0);
#if defined(REP_BAR)
    for (int rb = 0; rb < 20; ++rb) xcd_barrier(bar);
#endif
    if (IN(1)) {
#if defined(STAGGER_US)
        { const unsigned long long t0_ = __builtin_amdgcn_s_memrealtime(), dt_ = (unsigned long long)(((blockIdx.x >> 3) & 15) * (STAGGER_US * 100 / 16));
          while (__builtin_amdgcn_s_memrealtime() - t0_ < dt_) __builtin_amdgcn_s_sleep(8); }
#endif
        pg8::Gemm g{H1, Win_t, MTOK, NIN, DM}; pg8::StaticOrder S; S.init(MTOK, NIN, G, (int)blockIdx.x);
        pg8::EpiProj E{QKV, Gb, ropeC, ropeS};
        pg8::gemm_phase<pg8::EpiProj, pg8::StaticOrder, true, true>((LAS unsigned char*)lds, g, S, E);
    }
#if defined(REP_P1)
    __syncthreads();
    if (IN(1)) {
        pg8::Gemm g{H1, Win_t, MTOK, NIN, DM}; pg8::StaticOrder S; S.init(MTOK, NIN, G, (int)blockIdx.x);
        pg8::EpiProj E{QKV, Gb, ropeC, ropeS};
        pg8::gemm_phase<pg8::EpiProj, pg8::StaticOrder, true, true>((LAS unsigned char*)lds, g, S, E);
    }
#endif
    SEAM(1);
#if defined(DBG_STOP)
#define DBG_DUMP(k, off_mib, nseg) do { if (DBG_STOP == (k)) { xcd_barrier(bar); const bf16* rg = (const bf16*)(ws + (size_t)(off_mib) * MiB); \
        for (size_t i = (size_t)blockIdx.x * 512 + tid; i < (size_t)MTOK * DM; i += (size_t)G * 512) { float acc_ = 0.f; for (int sg = 0; sg < (nseg); ++sg) acc_ += __uint_as_float(((unsigned)rg[i + (size_t)sg * MTOK * DM]) << 16); out_p[i] = acc_; } return; } } while (0)
#else
#define DBG_DUMP(k, off_mib, nseg) do { } while (0)
#endif
    DBG_DUMP(1, 256, 5);
    DBG_DUMP(11, 256, 3);
    DBG_DUMP(12, 640, 2);
    if (IN(2)) {
#if !defined(ATT_D128X4)
        { int ntl = SEQ / 64; asm volatile("" : "+s"(ntl));
        const float s1_ = wave_sum(a.in[9][lane] * a.in[10][lane] + a.in[9][lane + 64] * a.in[10][lane + 64]);
        const float s2_ = wave_sum(a.in[11][lane] * a.in[12][lane] + a.in[11][lane + 64] * a.in[12][lane + 64]);
        const float lam_ = __uint_as_float(__builtin_amdgcn_readfirstlane(__float_as_uint(__builtin_amdgcn_exp2f(s1_ * 1.4426950408889634f) - __builtin_amdgcn_exp2f(s2_ * 1.4426950408889634f) + 0.2f)));
        for (int u = blockIdx.x; u < 512; u += G) {
            const int xs = u & 7, qb = (u >> 3) & 31, combo = (u >> 8) * 8 + xs, b = combo >> 2, h = combo & 3;
            const bf16* base = QKV + (size_t)b * 48 * SEQ * 128;
#if defined(ATT_MFMA32)
            bf16* odp = OD + ((size_t)b * SEQ + qb * 256) * 2048 + h * 512;
#else
            bf16* odp = OD + (size_t)blockIdx.x * 65536;
#endif
            bf16* oap = OAb + ((size_t)b * SEQ + qb * 256) * 1024 + h * 256;
            att::ATT_UNIT<0>(base + ((size_t)(2 * h) * SEQ + qb * 256) * 128, base + (size_t)(8 + 2 * h) * SEQ * 128, base + (size_t)(16 + 2 * h) * SEQ * 128, base + (size_t)(17 + 2 * h) * SEQ * 128,
                                 odp, ntl, (char*)lds, (LAS unsigned char*)lds, oap, a.in[13], lam_, EPS, 0.8f);
            att::ATT_UNIT<1>(base + ((size_t)(2 * h + 1) * SEQ + qb * 256) * 128, base + (size_t)(9 + 2 * h) * SEQ * 128, base + (size_t)(16 + 2 * h) * SEQ * 128, base + (size_t)(17 + 2 * h) * SEQ * 128,
                                 odp, ntl, (char*)lds, (LAS unsigned char*)lds, oap, a.in[13], lam_, EPS, 0.8f);
        }
#if defined(REP_ATT)
        for (int u = blockIdx.x; u < 512; u += G) {
            const int xs = u & 7, qb = (u >> 3) & 31, combo = (u >> 8) * 8 + xs, b = combo >> 2, h = combo & 3;
            const bf16* base = QKV + (size_t)b * 48 * SEQ * 128;
#if defined(ATT_MFMA32)
            bf16* odp = OD + ((size_t)b * SEQ + qb * 256) * 2048 + h * 512;
#else
            bf16* odp = OD + (size_t)blockIdx.x * 65536;
#endif
            bf16* oap = OAb + ((size_t)b * SEQ + qb * 256) * 1024 + h * 256;
            att::ATT_UNIT<0>(base + ((size_t)(2 * h) * SEQ + qb * 256) * 128, base + (size_t)(8 + 2 * h) * SEQ * 128, base + (size_t)(16 + 2 * h) * SEQ * 128, base + (size_t)(17 + 2 * h) * SEQ * 128,
                                 odp, ntl, (char*)lds, (LAS unsigned char*)lds, oap, a.in[13], lam_, EPS, 0.8f);
            att::ATT_UNIT<1>(base + ((size_t)(2 * h + 1) * SEQ + qb * 256) * 128, base + (size_t)(9 + 2 * h) * SEQ * 128, base + (size_t)(16 + 2 * h) * SEQ * 128, base + (size_t)(17 + 2 * h) * SEQ * 128,
                                 odp, ntl, (char*)lds, (LAS unsigned char*)lds, oap, a.in[13], lam_, EPS, 0.8f);
        }
#endif
        }
#else
#ifndef NO_DENSE
        int seqv = SEQ; asm volatile("" : "+s"(seqv));
        for (int u = blockIdx.x; u < 2048; u += G) {
            const int xs = u & 7, qb = (u >> 3) & 31, combo = (u >> 8) * 8 + xs, b = combo >> 4, vh = combo & 15, h = vh >> 2, c = (vh >> 1) & 1, hf = vh & 1;
            const bf16* base = QKV + (size_t)b * 48 * SEQ * 128;
            att::attn_dense_body<bf16>(base + ((size_t)(h * 2 + c) * SEQ + qb * 256) * 128, base + (size_t)(8 + h * 2 + c) * SEQ * 128, base + (size_t)(16 + h * 2 + hf) * SEQ * 128,
                                       OD + ((size_t)b * SEQ + qb * 256) * 2048 + vh * 128, seqv, (char*)lds);
            __syncthreads();
        }
#if defined(REP_DENSE)
        int seqv2 = SEQ; asm volatile("" : "+s"(seqv2));
        for (int u = blockIdx.x; u < 2048; u += G) {
            const int xs = u & 7, qb = (u >> 3) & 31, combo = (u >> 8) * 8 + xs, b = combo >> 4, vh = combo & 15, h = vh >> 2, c = (vh >> 1) & 1, hf = vh & 1;
            const bf16* base = QKV + (size_t)b * 48 * SEQ * 128;
            att::attn_dense_body<bf16>(base + ((size_t)(h * 2 + c) * SEQ + qb * 256) * 128, base + (size_t)(8 + h * 2 + c) * SEQ * 128, base + (size_t)(16 + h * 2 + hf) * SEQ * 128,
                                       OD + ((size_t)b * SEQ + qb * 256) * 2048 + vh * 128, seqv2, (char*)lds);
            __syncthreads();
        }
#endif
#endif
#endif
#ifndef NO_NA
            for (int u = blockIdx.x; u < 1024; u += G) {
            const int xs = u & 7, rb = (u >> 3) & 31, combo = (u >> 8) * 8 + xs, b = combo >> 3, h = combo & 7;
            att::na_unit(QKV, ONb, a.in[14], b, h, rb, (char*)lds);
        }
#if defined(REP_NA)
            for (int u = blockIdx.x; u < 1024; u += G) {
            const int xs = u & 7, rb = (u >> 3) & 31, combo = (u >> 8) * 8 + xs, b = combo >> 3, h = combo & 7;
            att::na_unit(QKV, ONb, a.in[14], b, h, rb, (char*)lds);
        }
#endif
#endif
    }
    SEAM(2);
    DBG_DUMP(2, 896, 1);
    DBG_DUMP(22, 128, 1);
#if defined(ATT_D128X4)
    if (IN(3)) {
        const float s1 = wave_sum(a.in[9][lane] * a.in[10][lane] + a.in[9][lane + 64] * a.in[10][lane + 64]);
        const float s2 = wave_sum(a.in[11][lane] * a.in[12][lane] + a.in[11][lane + 64] * a.in[12][lane + 64]);
        const float lam = __builtin_amdgcn_exp2f(s1 * 1.4426950408889634f) - __builtin_amdgcn_exp2f(s2 * 1.4426950408889634f) + 0.2f;
        const f32x4 sw = ((const f32x4*)a.in[13])[lane];
        for (int m = gw; m < MTOK; m += NGW) {
#pragma unroll
            for (int h = 0; h < 4; ++h) {
                const bf16* od = OD + (size_t)m * 2048 + h * 512 + 4 * lane;
                const u32x2v p = *(const u32x2v*)od, q = *(const u32x2v*)(od + 256);
                f32x4 d;
                d.x = __uint_as_float(p.x << 16) - lam * __uint_as_float(q.x << 16); d.y = __uint_as_float(p.x & 0xffff0000u) - lam * __uint_as_float(q.x & 0xffff0000u);
                d.z = __uint_as_float(p.y << 16) - lam * __uint_as_float(q.y << 16); d.w = __uint_as_float(p.y & 0xffff0000u) - lam * __uint_as_float(q.y & 0xffff0000u);
                const float rstd = __builtin_amdgcn_rsqf(wave_sum((d.x * d.x + d.y * d.y) + (d.z * d.z + d.w * d.w)) * (1.f / 256.f) + EPS) * 0.8f;
                u32x2v w; w.x = pk2(d.x * rstd * sw.x, d.y * rstd * sw.y); w.y = pk2(d.z * rstd * sw.z, d.w * rstd * sw.w);
                *(u32x2v*)(OAb + (size_t)m * 1024 + h * 256 + 4 * lane) = w;
            }
        }
    }
#if defined(REP_P3)
    __syncthreads();
    if (IN(3)) {
        const float s1 = wave_sum(a.in[9][lane] * a.in[10][lane] + a.in[9][lane + 64] * a.in[10][lane + 64]);
        const float s2 = wave_sum(a.in[11][lane] * a.in[12][lane] + a.in[11][lane + 64] * a.in[12][lane + 64]);
        const float lam = __builtin_amdgcn_exp2f(s1 * 1.4426950408889634f) - __builtin_amdgcn_exp2f(s2 * 1.4426950408889634f) + 0.2f;
        const f32x4 sw = ((const f32x4*)a.in[13])[lane];
        for (int m = gw; m < MTOK; m += NGW) {
#pragma unroll
            for (int h = 0; h < 4; ++h) {
                const bf16* od = OD + (size_t)m * 2048 + h * 512 + 4 * lane;
                const u32x2v p = *(const u32x2v*)od, q = *(const u32x2v*)(od + 256);
                f32x4 d;
                d.x = __uint_as_float(p.x << 16) - lam * __uint_as_float(q.x << 16); d.y = __uint_as_float(p.x & 0xffff0000u) - lam * __uint_as_float(q.x & 0xffff0000u);
                d.z = __uint_as_float(p.y << 16) - lam * __uint_as_float(q.y << 16); d.w = __uint_as_float(p.y & 0xffff0000u) - lam * __uint_as_float(q.y & 0xffff0000u);
                const float rstd = __builtin_amdgcn_rsqf(wave_sum((d.x * d.x + d.y * d.y) + (d.z * d.z + d.w * d.w)) * (1.f / 256.f) + EPS) * 0.8f;
                u32x2v w; w.x = pk2(d.x * rstd * sw.x, d.y * rstd * sw.y); w.y = pk2(d.z * rstd * sw.z, d.w * rstd * sw.w);
                *(u32x2v*)(OAb + (size_t)m * 1024 + h * 256 + 4 * lane) = w;
            }
        }
    }
#endif
    SEAM(3);
#endif
    DBG_DUMP(3, 128, 1);
    if (IN(4)) {
        { pg8::Gemm g{OAb, Wa_t, MTOK, DM, 1024}; pg8::StaticOrder S; S.init(MTOK, DM, G, (int)blockIdx.x);
          pg8::EpiBranch<0> E{Gb, Tb, MX};
          pg8::gemm_phase<pg8::EpiBranch<0>, pg8::StaticOrder, true, true>((LAS unsigned char*)lds, g, S, E); }
        asm volatile("s_waitcnt vmcnt(0)" ::: "memory"); __syncthreads();
        { pg8::Gemm g{ONb, Wb_t, MTOK, DM, 1024}; pg8::StaticOrder S; S.init(MTOK, DM, G, (int)blockIdx.x);
          pg8::EpiBranch<1> E{Gb, Tb, MX};
          pg8::gemm_phase<pg8::EpiBranch<1>, pg8::StaticOrder, true, true>((LAS unsigned char*)lds, g, S, E); }
    }
#if defined(REP_P4)
    __syncthreads();
    if (IN(4)) {
        { pg8::Gemm g{OAb, Wa_t, MTOK, DM, 1024}; pg8::StaticOrder S; S.init(MTOK, DM, G, (int)blockIdx.x);
          pg8::EpiBranch<0> E{Gb, Tb, MX};
          pg8::gemm_phase<pg8::EpiBranch<0>, pg8::StaticOrder, true, true>((LAS unsigned char*)lds, g, S, E); }
        asm volatile("s_waitcnt vmcnt(0)" ::: "memory"); __syncthreads();
        { pg8::Gemm g{ONb, Wb_t, MTOK, DM, 1024}; pg8::StaticOrder S; S.init(MTOK, DM, G, (int)blockIdx.x);
          pg8::EpiBranch<1> E{Gb, Tb, MX};
          pg8::gemm_phase<pg8::EpiBranch<1>, pg8::StaticOrder, true, true>((LAS unsigned char*)lds, g, S, E); }
    }
#endif
    SEAM(4);
    DBG_DUMP(4, 512, 1);
    DBG_DUMP(41, 256, 2);
    if (IN(5)) {
        pg8::Gemm g{MX, Wout_t, MTOK, DM, DM}; pg8::StaticOrder S; S.init(MTOK, DM, G, (int)blockIdx.x);
        pg8::EpiYss<bf16> E{Yb, SS};
        pg8::gemm_phase<pg8::EpiYss<bf16>, pg8::StaticOrder, true, true>((LAS unsigned char*)lds, g, S, E);
    }
#if defined(REP_P5)
    __syncthreads();
    if (IN(5)) {
        pg8::Gemm g{MX, Wout_t, MTOK, DM, DM}; pg8::StaticOrder S; S.init(MTOK, DM, G, (int)blockIdx.x);
        pg8::EpiYss<bf16> E{Yb, SS};
        pg8::gemm_phase<pg8::EpiYss<bf16>, pg8::StaticOrder, true, true>((LAS unsigned char*)lds, g, S, E);
    }
#endif
    SEAM(5);
    DBG_DUMP(5, 896, 1);
    if (IN(6)) {
        const float* g1 = a.in[6]; const float* g2 = a.in[7];
        f32x4 g1v[8], g2v[8];
#pragma unroll
        for (int j = 0; j < 8; ++j) { g1v[j] = ((const f32x4*)g1)[lane + 64 * j]; g2v[j] = ((const f32x4*)g2)[lane + 64 * j]; }
        for (int m0 = gw; m0 < MTOK; m0 += 2 * NGW) {
            f32x4 v[2][8]; u32x2v yw[2][8]; float ssv[2];
#pragma unroll
            for (int q = 0; q < 2; ++q) { const size_t m = (size_t)(m0 + q * NGW); ssv[q] = lane < 32 ? SS[m * 32 + lane] : 0.f;
                const f32x4* xr = (const f32x4*)(x_in + m * DM) + lane; const u32x2v* yr = (const u32x2v*)(Yb + m * DM) + lane;
#pragma unroll
                for (int j = 0; j < 8; ++j) { v[q][j] = xr[64 * j]; yw[q][j] = yr[64 * j]; } }
#pragma unroll
            for (int q = 0; q < 2; ++q) { const size_t m = (size_t)(m0 + q * NGW);
                const float rstd = __builtin_amdgcn_rsqf(wave_sum(ssv[q]) * (1.f / DM) + EPS); f32x4* orow = (f32x4*)(out_p + m * DM) + lane; float s = 0.f;
#pragma unroll
                for (int j = 0; j < 8; ++j) { const f32x4 gv = g1v[j]; const u32x2v w = yw[q][j];
                    f32x4 y; y.x = __uint_as_float(w.x << 16); y.y = __uint_as_float(w.x & 0xffff0000u); y.z = __uint_as_float(w.y << 16); y.w = __uint_as_float(w.y & 0xffff0000u);
                    v[q][j] = v[q][j] + y * rstd * gv; orow[64 * j] = v[q][j];
                    s += (v[q][j].x * v[q][j].x + v[q][j].y * v[q][j].y) + (v[q][j].z * v[q][j].z + v[q][j].w * v[q][j].w); }
                const float rstd1 = __builtin_amdgcn_rsqf(wave_sum(s) * (1.f / DM) + EPS);
                u32x2v* o8 = (u32x2v*)(H2 + m * DM) + lane;
#pragma unroll
                for (int j = 0; j < 8; ++j) { const f32x4 gv = g2v[j]; u32x2v w; w.x = pk2(v[q][j].x * rstd1 * gv.x, v[q][j].y * rstd1 * gv.y); w.y = pk2(v[q][j].z * rstd1 * gv.z, v[q][j].w * rstd1 * gv.w); o8[64 * j] = w; } }
        }
    }
#if defined(REP_P6)
    __syncthreads();
    if (IN(6)) {
        const float* g1 = a.in[6]; const float* g2 = a.in[7];
        f32x4 g1v[8], g2v[8];
#pragma unroll
        for (int j = 0; j < 8; ++j) { g1v[j] = ((const f32x4*)g1)[lane + 64 * j]; g2v[j] = ((const f32x4*)g2)[lane + 64 * j]; }
        for (int m0 = gw; m0 < MTOK; m0 += 2 * NGW) {
            f32x4 v[2][8]; u32x2v yw[2][8]; float ssv[2];
#pragma unroll
            for (int q = 0; q < 2; ++q) { const size_t m = (size_t)(m0 + q * NGW); ssv[q] = lane < 32 ? SS[m * 32 + lane] : 0.f;
                const f32x4* xr = (const f32x4*)(x_in + m * DM) + lane; const u32x2v* yr = (const u32x2v*)(Yb + m * DM) + lane;
#pragma unroll
                for (int j = 0; j < 8; ++j) { v[q][j] = xr[64 * j]; yw[q][j] = yr[64 * j]; } }
#pragma unroll
            for (int q = 0; q < 2; ++q) { const size_t m = (size_t)(m0 + q * NGW);
                const float rstd = __builtin_amdgcn_rsqf(wave_sum(ssv[q]) * (1.f / DM) + EPS); f32x4* orow = (f32x4*)(out_p + m * DM) + lane; float s = 0.f;
#pragma unroll
                for (int j = 0; j < 8; ++j) { const f32x4 gv = g1v[j]; const u32x2v w = yw[q][j];
                    f32x4 y; y.x = __uint_as_float(w.x << 16); y.y = __uint_as_float(w.x & 0xffff0000u); y.z = __uint_as_float(w.y << 16); y.w = __uint_as_float(w.y & 0xffff0000u);
                    v[q][j] = v[q][j] + y * rstd * gv; orow[64 * j] = v[q][j];
                    s += (v[q][j].x * v[q][j].x + v[q][j].y * v[q][j].y) + (v[q][j].z * v[q][j].z + v[q][j].w * v[q][j].w); }
                const float rstd1 = __builtin_amdgcn_rsqf(wave_sum(s) * (1.f / DM) + EPS);
                u32x2v* o8 = (u32x2v*)(H2 + m * DM) + lane;
#pragma unroll
                for (int j = 0; j < 8; ++j) { const f32x4 gv = g2v[j]; u32x2v w; w.x = pk2(v[q][j].x * rstd1 * gv.x, v[q][j].y * rstd1 * gv.y); w.y = pk2(v[q][j].z * rstd1 * gv.z, v[q][j].w * rstd1 * gv.w); o8[64 * j] = w; } }
        }
    }
#endif
    SEAM(6);
    DBG_DUMP(6, 128, 1);
    if (IN(7)) {
#if defined(STAGGER_US)
        { const unsigned long long t0_ = __builtin_amdgcn_s_memrealtime(), dt_ = (unsigned long long)(((blockIdx.x >> 3) & 15) * (STAGGER_US * 100 / 16));
          while (__builtin_amdgcn_s_memrealtime() - t0_ < dt_) __builtin_amdgcn_s_sleep(8); }
#endif
        pg8::Gemm g{H2, Wup_t, MTOK, DFF, DM}; pg8::StaticOrder S; S.init(MTOK, DFF, G, (int)blockIdx.x);
        pg8::EpiRelu2 E{Ub, DFF};
        pg8::gemm_phase<pg8::EpiRelu2, pg8::StaticOrder, true, true>((LAS unsigned char*)lds, g, S, E);
    }
#if defined(REP_P7)
    __syncthreads();
    if (IN(7)) {
        pg8::Gemm g{H2, Wup_t, MTOK, DFF, DM}; pg8::StaticOrder S; S.init(MTOK, DFF, G, (int)blockIdx.x);
        pg8::EpiRelu2 E{Ub, DFF};
        pg8::gemm_phase<pg8::EpiRelu2, pg8::StaticOrder, true, true>((LAS unsigned char*)lds, g, S, E);
    }
#endif
    SEAM(7);
    DBG_DUMP(7, 256, 4);
    if (IN(8)) {
#if defined(FUSE_P8)
        pg8::Gemm g{Ub, Wdn_t, MTOK, DM, DFF}; pg8::PanelOrder S; S.init((int)blockIdx.x);
        pg8::EpiFinal E{out_p, a.in[8], SS, (unsigned*)(ws + WS_CNT), EPS};
        pg8::gemm_phase<pg8::EpiFinal, pg8::PanelOrder, true, true>((LAS unsigned char*)lds, g, S, E);
#else
        pg8::Gemm g{Ub, Wdn_t, MTOK, DM, DFF}; pg8::StaticOrder S; S.init(MTOK, DM, G, (int)blockIdx.x);
        pg8::EpiYss<bf16> E{Y2, SS};
        pg8::gemm_phase<pg8::EpiYss<bf16>, pg8::StaticOrder, true, true>((LAS unsigned char*)lds, g, S, E);
#endif
    }
#if !defined(FUSE_P8)
    SEAM(8);
    if (IN(9)) {
        const float* g3 = a.in[8];
        f32x4 g3v[8];
#pragma unroll
        for (int j = 0; j < 8; ++j) g3v[j] = ((const f32x4*)g3)[lane + 64 * j];
        for (int m0 = gw; m0 < MTOK; m0 += 2 * NGW) {
            f32x4 v[2][8]; u32x2v yw[2][8]; float ssv[2];
#pragma unroll
            for (int q = 0; q < 2; ++q) { const size_t m = (size_t)(m0 + q * NGW); ssv[q] = lane < 32 ? SS[m * 32 + lane] : 0.f;
                const f32x4* xr = (const f32x4*)(out_p + m * DM) + lane; const u32x2v* yr = (const u32x2v*)(Y2 + m * DM) + lane;
#pragma unroll
                for (int j = 0; j < 8; ++j) { v[q][j] = xr[64 * j]; yw[q][j] = yr[64 * j]; } }
#pragma unroll
            for (int q = 0; q < 2; ++q) { const size_t m = (size_t)(m0 + q * NGW);
                const float rstd = __builtin_amdgcn_rsqf(wave_sum(ssv[q]) * (1.f / DM) + EPS); f32x4* orow = (f32x4*)(out_p + m * DM) + lane;
#pragma unroll
                for (int j = 0; j < 8; ++j) { const f32x4 gv = g3v[j]; const u32x2v w = yw[q][j];
                    f32x4 y; y.x = __uint_as_float(w.x << 16); y.y = __uint_as_float(w.x & 0xffff0000u); y.z = __uint_as_float(w.y << 16); y.w = __uint_as_float(w.y & 0xffff0000u);
                    orow[64 * j] = v[q][j] + y * rstd * gv; } }
        }
    }
#endif
#undef IN
#undef SEAM
#undef tid
#undef lane
#undef wave
#undef G
#undef gw
#undef NGW
}

extern "C" void kernel_launch(void* const* d_in, const int* in_sizes, int n_in, void* d_out, int out_size, void* d_ws, size_t ws_size, hipStream_t stream) {
    static int grid = 0;
    if (grid == 0) {
        if (n_in != 17 || in_sizes[0] != MTOK * DM || out_size != MTOK * DM || ws_size < WS_END) { fprintf(stderr, "kernel_launch: shape/workspace mismatch: n_in %d in0 %d out %d ws %zu (need %zu)\n", n_in, n_in > 0 ? in_sizes[0] : -1, out_size, ws_size, (size_t)WS_END); grid = -1; return; }
        int dev = 0, cus = 0, per_cu = 0;
        (void)hipGetDevice(&dev); (void)hipDeviceGetAttribute(&cus, hipDeviceAttributeMultiprocessorCount, dev);
        if (hipFuncSetAttribute((const void*)mk_fwd, hipFuncAttributeMaxDynamicSharedMemorySize, LDS_BYTES) != hipSuccess) { fprintf(stderr, "kernel_launch: hipFuncSetAttribute failed\n"); grid = -1; return; }
        if (hipOccupancyMaxActiveBlocksPerMultiprocessor(&per_cu, (const void*)mk_fwd, NWAVES * 64, LDS_BYTES) != hipSuccess || per_cu < 1) { fprintf(stderr, "kernel_launch: occupancy query says %d\n", per_cu); per_cu = 1; }
        (void)hipGetLastError();
        grid = cus * per_cu;
        if (grid != 256) fprintf(stderr, "kernel_launch: grid %d != 256: the fused-norm phases need exactly 256 workgroups\n", grid);
        if (grid > 256) grid = 256;
    }
    if (grid < 0) return;
    if (hipMemsetAsync((char*)d_ws + WS_CTL, 0, CTL_ZERO_BYTES, stream) != hipSuccess) { fprintf(stderr, "kernel_launch: hipMemsetAsync failed\n"); return; }
    Args a{};
    for (int i = 0; i < 17; ++i) a.in[i] = (const float*)d_in[i];
    a.out = (float*)d_out; a.ws = (unsigned char*)d_ws; a.ph_lo = 0; a.ph_hi = 10;
    void* args[] = {&a};
    hipError_t e = hipLaunchCooperativeKernel((const void*)mk_fwd, dim3(grid), dim3(NWAVES * 64), args, LDS_BYTES, stream);
    if (e != hipSuccess) fprintf(stderr, "kernel_launch: cooperative launch failed: %s (grid %d)\n", hipGetErrorString(e), grid);
}
```

```cpp
#define INKERNEL_CTL_ZERO
#include <hip/hip_runtime.h>
#include <hip/hip_cooperative_groups.h>
#include <cstdio>
#include <cstdint>
#include <cmath>
namespace cg = cooperative_groups;
namespace pg8 {
#define PG8_LAS __attribute__((address_space(3)))
typedef unsigned short bf16_t;
typedef short bf16x8 __attribute__((ext_vector_type(8)));
typedef float f32x4 __attribute__((ext_vector_type(4)));
typedef unsigned u32x4 __attribute__((ext_vector_type(4)));
constexpr int BM = 256, BK = 64, HALF = 128, HTB = HALF * BK * 2  , STAGE_BYTES = 8 * HTB, NXCD = 8, WGM = 8;

__host__ __device__ __forceinline__ int lds_byte(int r, int c) { const int st = (r >> 4) * 2 + (c >> 5), rr = r & 15, cc = c & 31, ob = rr * 64 + cc * 2; return st * 1024 + (ob ^ (((ob >> 9) & 1) << 5)); }
__host__ __device__ __forceinline__ void stage_rc(int b, int& R, int& C) { const int st = b / 1024, sb = b % 1024, swz = sb ^ (((sb >> 9) & 1) << 5); R = (st >> 1) * 16 + swz / 64; C = (st & 1) * 32 + (swz % 64) / 2; }
__host__ __device__ __forceinline__ int perm32(int rho) { const int n = rho >> 4, i = rho & 15; return 8 * (i >> 2) + 4 * n + (i & 3); }

struct Unit { int pm, pn; };
struct Gemm { const bf16_t* A; const bf16_t* Bt; int M, N, K; };

struct StaticOrder {
    int nM, nN, nwg, G, c;
    __host__ __device__ void init(int M, int N, int G_, int c_) { nM = M / BM; nN = N / BM; nwg = nM * nN; G = G_; c = c_; }
    __host__ __device__ bool next(int i, Unit& u) const {
        const long L = (long)i * G + c; if (L >= nwg) return false;
        int wgid = (int)L; { const int q = nwg / NXCD, r = nwg % NXCD, xcd = wgid % NXCD, off = wgid / NXCD; wgid = (xcd < r ? xcd * (q + 1) : r * (q + 1) + (xcd - r) * q) + off; }
        const int nig = WGM * nN, gid = wgid / nig, fm = gid * WGM, gsz = (nM - fm) < WGM ? (nM - fm) : WGM;
        u.pm = fm + ((wgid % nig) % gsz); u.pn = (wgid % nig) / gsz; return true;
    }
    __device__ __forceinline__ void a_ready(const Unit&) const {}
    __device__ __forceinline__ void done(const Unit&) const {}
};

typedef __bf16 bf16x2_t __attribute__((ext_vector_type(2))); typedef float f32x2_t __attribute__((ext_vector_type(2)));
__device__ __forceinline__ unsigned cvt_pk_bf16(float lo, float hi) { f32x2_t v = {lo, hi}; bf16x2_t b = __builtin_convertvector(v, bf16x2_t); return __builtin_bit_cast(unsigned, b); }
__device__ __forceinline__ float bf2f(unsigned short b) { return __uint_as_float(((unsigned)b) << 16); }
__device__ __forceinline__ void unpack8(const u32x4 w, float (&f)[8]) {
    f[0] = __uint_as_float(w.x << 16); f[1] = __uint_as_float(w.x & 0xffff0000u); f[2] = __uint_as_float(w.y << 16); f[3] = __uint_as_float(w.y & 0xffff0000u);
    f[4] = __uint_as_float(w.z << 16); f[5] = __uint_as_float(w.z & 0xffff0000u); f[6] = __uint_as_float(w.w << 16); f[7] = __uint_as_float(w.w & 0xffff0000u);
}
__device__ __forceinline__ u32x4 pack8(const f32x4 v0, const f32x4 v1) { u32x4 w; w.x = cvt_pk_bf16(v0[0], v0[1]); w.y = cvt_pk_bf16(v0[2], v0[3]); w.z = cvt_pk_bf16(v1[0], v1[1]); w.w = cvt_pk_bf16(v1[2], v1[3]); return w; }
__device__ __forceinline__ float sigmoidf_(float v) { return __builtin_amdgcn_rcpf(1.0f + __builtin_amdgcn_exp2f(-1.4426950408889634f * v)); }

struct EpiProj {
    static constexpr bool PERM = true, AFTER_DRAIN = false;
    bf16_t* QKV; bf16_t* G; const float* ropeC; const float* ropeS;
    __device__ __forceinline__ void operator()(const f32x4 (&acc)[2][2][4][2], const Unit& u, int wr, int wc, int fr, int fq) const {
        const int row0 = u.pm * BM + wr * 64 + fr, colt = u.pn * BM, cl = wc * 32 + 8 * fq;
        if (colt < 2048) {
            const int i0 = 16 * wc + 4 * fq;
            f32x4 cc[2][4], sn[2][4];
#pragma unroll
            for (int ai = 0; ai < 2; ++ai)
#pragma unroll
                for (int m = 0; m < 4; ++m) { const int pos = (row0 + ai * HALF + m * 16) & 8191;
                    cc[ai][m] = *(const f32x4*)(ropeC + (size_t)pos * 64 + i0); sn[ai][m] = *(const f32x4*)(ropeS + (size_t)pos * 64 + i0); }
            asm volatile("" ::: "memory");
#pragma unroll
            for (int ai = 0; ai < 2; ++ai)
#pragma unroll
                for (int m = 0; m < 4; ++m) { const int row = row0 + ai * HALF + m * 16, pos = row & 8191;
                    const f32x4 c = cc[ai][m], s = sn[ai][m];
                    bf16_t* rowp = QKV + (((size_t)(row >> 13) * 48 + (colt >> 7)) * 8192 + pos) * 128 + cl;
#pragma unroll
                    for (int bj = 0; bj < 2; ++bj) { const f32x4 v0 = acc[ai][bj][m][0], v1 = acc[ai][bj][m][1]; f32x4 o0, o1;
                        o0[0] = v0[0] * c[0] - v0[1] * s[0]; o0[1] = v0[1] * c[0] + v0[0] * s[0]; o0[2] = v0[2] * c[1] - v0[3] * s[1]; o0[3] = v0[3] * c[1] + v0[2] * s[1];
                        o1[0] = v1[0] * c[2] - v1[1] * s[2]; o1[1] = v1[1] * c[2] + v1[0] * s[2]; o1[2] = v1[2] * c[3] - v1[3] * s[3]; o1[3] = v1[3] * c[3] + v1[2] * s[3];
                        *(u32x4*)(rowp + (size_t)bj * 8192 * 128) = pack8(o0, o1); } }
        } else if (colt < 6144) {
#pragma unroll
            for (int ai = 0; ai < 2; ++ai)
#pragma unroll
                for (int m = 0; m < 4; ++m) { const int row = row0 + ai * HALF + m * 16; bf16_t* rowp = QKV + (((size_t)(row >> 13) * 48 + (colt >> 7)) * 8192 + (row & 8191)) * 128 + cl;
#pragma unroll
                    for (int bj = 0; bj < 2; ++bj) *(u32x4*)(rowp + (size_t)bj * 8192 * 128) = pack8(acc[ai][bj][m][0], acc[ai][bj][m][1]); }
        } else {
#pragma unroll
            for (int ai = 0; ai < 2; ++ai)
#pragma unroll
                for (int m = 0; m < 4; ++m) { bf16_t* rowp = G + (size_t)(row0 + ai * HALF + m * 16) * 4096 + (colt - 6144) + cl;
#pragma unroll
                    for (int bj = 0; bj < 2; ++bj) { f32x4 v0 = acc[ai][bj][m][0], v1 = acc[ai][bj][m][1];
#pragma unroll
                        for (int j = 0; j < 4; ++j) { v0[j] = sigmoidf_(v0[j]); v1[j] = sigmoidf_(v1[j]); }
                        *(u32x4*)(rowp + bj * HALF) = pack8(v0, v1); } }
        }
    }
};
template <int SECOND> struct EpiBranch {
    static constexpr bool PERM = true, AFTER_DRAIN = false;
    const bf16_t* G; bf16_t* T; bf16_t* MX;
    __device__ __forceinline__ void operator()(const f32x4 (&acc)[2][2][4][2], const Unit& u, int wr, int wc, int fr, int fq) const {
        const int row0 = u.pm * BM + wr * 64 + fr, col0 = u.pn * BM + wc * 32 + 8 * fq;
#pragma unroll
        for (int ai = 0; ai < 2; ++ai) {
            u32x4 gw[4][2], tw[4][2];
#pragma unroll
            for (int m = 0; m < 4; ++m)
#pragma unroll
                for (int bj = 0; bj < 2; ++bj) { const size_t row = (size_t)(row0 + ai * HALF + m * 16); const int col = col0 + bj * HALF;
                    gw[m][bj] = *(const u32x4*)(G + row * 4096 + SECOND * 2048 + col);
                    if (SECOND) tw[m][bj] = *(const u32x4*)(T + row * 2048 + col); }
            asm volatile("" ::: "memory");
#pragma unroll
            for (int m = 0; m < 4; ++m)
#pragma unroll
                for (int bj = 0; bj < 2; ++bj) { const size_t row = (size_t)(row0 + ai * HALF + m * 16); const int col = col0 + bj * HALF;
                    float g[8]; unpack8(gw[m][bj], g);
                    f32x4 v0 = acc[ai][bj][m][0], v1 = acc[ai][bj][m][1];
#pragma unroll
                    for (int jj = 0; jj < 4; ++jj) { v0[jj] *= g[jj]; v1[jj] *= g[4 + jj]; }
                    if (SECOND == 0) { *(u32x4*)(T + row * 2048 + col) = pack8(v0, v1); }
                    else { float t[8]; unpack8(tw[m][bj], t);
#pragma unroll
                        for (int jj = 0; jj < 4; ++jj) { v0[jj] += t[jj]; v1[jj] += t[4 + jj]; }
                        *(u32x4*)(MX + row * 2048 + col) = pack8(v0, v1); } }
            asm volatile("" ::: "memory");
        }
    }
};
template <typename TO> struct EpiYss {
    static constexpr bool PERM = true, AFTER_DRAIN = false;
    TO* Y; float* SS;
    __device__ __forceinline__ void operator()(const f32x4 (&acc)[2][2][4][2], const Unit& u, int wr, int wc, int fr, int fq) const {
        const int row0 = u.pm * BM + wr * 64 + fr, col0 = u.pn * BM + wc * 32 + 8 * fq;
#pragma unroll
        for (int ai = 0; ai < 2; ++ai)
#pragma unroll
            for (int m = 0; m < 4; ++m) { const size_t row = (size_t)(row0 + ai * HALF + m * 16); float s = 0.f;
#pragma unroll
                for (int bj = 0; bj < 2; ++bj) { const f32x4 v0 = acc[ai][bj][m][0], v1 = acc[ai][bj][m][1];
                    s += (v0[0] * v0[0] + v0[1] * v0[1]) + (v0[2] * v0[2] + v0[3] * v0[3]) + (v1[0] * v1[0] + v1[1] * v1[1]) + (v1[2] * v1[2] + v1[3] * v1[3]);
                    if constexpr (sizeof(TO) == 2) *(u32x4*)((bf16_t*)Y + row * 2048 + col0 + bj * HALF) = pack8(v0, v1);
                    else { float* yp = (float*)Y + row * 2048 + col0 + bj * HALF; *(f32x4*)yp = v0; *(f32x4*)(yp + 4) = v1; } }
                s += __shfl_xor(s, 16); s += __shfl_xor(s, 32);
                if (fq == 0) SS[row * 32 + u.pn * 4 + wc] = s; }
    }
};
struct EpiRelu2 {
    static constexpr bool PERM = true, AFTER_DRAIN = false;
    bf16_t* U; int ldc;
    __device__ __forceinline__ void operator()(const f32x4 (&acc)[2][2][4][2], const Unit& u, int wr, int wc, int fr, int fq) const {
        const int row0 = u.pm * BM + wr * 64 + fr, col0 = u.pn * BM + wc * 32 + 8 * fq;
#pragma unroll
        for (int ai = 0; ai < 2; ++ai)
#pragma unroll
            for (int m = 0; m < 4; ++m) { bf16_t* rowp = U + (size_t)(row0 + ai * HALF + m * 16) * ldc + col0;
#pragma unroll
                for (int bj = 0; bj < 2; ++bj) { f32x4 v0 = acc[ai][bj][m][0], v1 = acc[ai][bj][m][1];
#pragma unroll
                    for (int j = 0; j < 4; ++j) { const float a = fmaxf(v0[j], 0.f), b = fmaxf(v1[j], 0.f); v0[j] = a * a; v1[j] = b * b; }
                    *(u32x4*)(rowp + bj * HALF) = pack8(v0, v1); } }
    }
};
struct PanelOrder {
    int c;
    __device__ void init(int c_) { c = c_; }
    __device__ bool next(int i, Unit& u) const { if (i >= 4) return false; const int li = c >> 3; u.pm = 16 * (c & 7) + 4 * i + (li >> 3); u.pn = li & 7; return true; }
    __device__ __forceinline__ void a_ready(const Unit&) const {}
    __device__ __forceinline__ void done(const Unit&) const {}
};
__device__ __forceinline__ void panel_publish(const float (&sq)[2][4], float* slots, unsigned* cnt, const Unit& u, int wr, int wc, int fr, int fq) {
#pragma unroll
    for (int ai = 0; ai < 2; ++ai)
#pragma unroll
        for (int m = 0; m < 4; ++m) { const size_t row = (size_t)(u.pm * BM + ai * HALF + wr * 64 + m * 16 + fr);
            if (fq == 0) __hip_atomic_store(slots + row * 32 + u.pn * 4 + wc, sq[ai][m], __ATOMIC_RELAXED, __HIP_MEMORY_SCOPE_AGENT); }
    asm volatile("s_waitcnt vmcnt(0)" ::: "memory");
    if ((threadIdx.x & 63) == 0) __hip_atomic_fetch_add(cnt + 64 * u.pm, 1u, __ATOMIC_RELAXED, __HIP_MEMORY_SCOPE_AGENT);
}
__device__ __forceinline__ void panel_collect(float (&sq)[2][4], const float* slots, unsigned* cnt, const Unit& u, int wr, int fr, int fq, float eps) {
    unsigned* cw = cnt + 64 * u.pm;
    { unsigned spins = 0;
      while ((unsigned)__builtin_amdgcn_readfirstlane(__hip_atomic_load(cw, __ATOMIC_RELAXED, __HIP_MEMORY_SCOPE_AGENT)) < 64u) { __builtin_amdgcn_s_sleep(2); if (++spins > (1u << 22)) break; } }
    __builtin_amdgcn_fence(__ATOMIC_ACQUIRE, "agent");
#pragma unroll
    for (int ai = 0; ai < 2; ++ai)
#pragma unroll
        for (int m = 0; m < 4; ++m) { const size_t row = (size_t)(u.pm * BM + ai * HALF + wr * 64 + m * 16 + fr);
            const unsigned long long* sp = (const unsigned long long*)(slots + row * 32 + fq * 8); float t = 0.f;
#pragma unroll
            for (int k = 0; k < 4; ++k) { const unsigned long long w = __hip_atomic_load(sp + k, __ATOMIC_RELAXED, __HIP_MEMORY_SCOPE_AGENT); t += __uint_as_float((unsigned)w) + __uint_as_float((unsigned)(w >> 32)); }
            t += __shfl_xor(t, 16); t += __shfl_xor(t, 32);
            sq[ai][m] = __builtin_amdgcn_rsqf(t * (1.0f / 2048.0f) + eps); }
}
struct EpiFinal {
    static constexpr bool PERM = false, AFTER_DRAIN = false;
    float* X; const float* gain; float* slots; unsigned* cnt; float eps;
    __device__ __forceinline__ void operator()(const f32x4 (&acc)[2][2][4][2], const Unit& u, int wr, int wc, int fr, int fq) const {
        float sq[2][4];
#pragma unroll
        for (int ai = 0; ai < 2; ++ai)
#pragma unroll
            for (int m = 0; m < 4; ++m) { float s = 0.f;
#pragma unroll
                for (int bj = 0; bj < 2; ++bj)
#pragma unroll
                    for (int n = 0; n < 2; ++n) { const f32x4 v = acc[ai][bj][m][n]; s += (v[0] * v[0] + v[1] * v[1]) + (v[2] * v[2] + v[3] * v[3]); }
                s += __shfl_xor(s, 16); s += __shfl_xor(s, 32); sq[ai][m] = s; }
        const int col0 = u.pn * BM + wc * 32 + 4 * fq;
        panel_publish(sq, slots, cnt, u, wr, wc, fr, fq);
        f32x4 pre[4][2][2];
#pragma unroll
        for (int m = 0; m < 4; ++m) { const float* rowp = X + (size_t)(u.pm * BM + wr * 64 + m * 16 + fr) * 2048 + col0;
#pragma unroll
            for (int bj = 0; bj < 2; ++bj)
#pragma unroll
                for (int n = 0; n < 2; ++n) pre[m][bj][n] = *(const f32x4*)(rowp + bj * HALF + n * 16); }
        panel_collect(sq, slots, cnt, u, wr, fr, fq, eps);
        f32x4 gv[2][2];
#pragma unroll
        for (int bj = 0; bj < 2; ++bj)
#pragma unroll
            for (int n = 0; n < 2; ++n) gv[bj][n] = *(const f32x4*)(gain + col0 + bj * HALF + n * 16);
#pragma unroll
        for (int ai = 0; ai < 2; ++ai) {
            if (ai == 1) {
#pragma unroll
                for (int m = 0; m < 4; ++m) { const float* rowp = X + (size_t)(u.pm * BM + HALF + wr * 64 + m * 16 + fr) * 2048 + col0;
#pragma unroll
                    for (int bj = 0; bj < 2; ++bj)
#pragma unroll
                        for (int n = 0; n < 2; ++n) pre[m][bj][n] = *(const f32x4*)(rowp + bj * HALF + n * 16); } }
#pragma unroll
            for (int m = 0; m < 4; ++m) { float* rowp = X + (size_t)(u.pm * BM + ai * HALF + wr * 64 + m * 16 + fr) * 2048 + col0; const float rs = sq[ai][m];
#pragma unroll
                for (int bj = 0; bj < 2; ++bj)
#pragma unroll
                    for (int n = 0; n < 2; ++n) *(f32x4*)(rowp + bj * HALF + n * 16) = pre[m][bj][n] + acc[ai][bj][m][n] * rs * gv[bj][n]; }
            asm volatile("" ::: "memory");
        }
    }
};

template <class Epi, class Sched, bool ALIGN_EPI = false, bool SP2 = false>
__device__ __forceinline__ void gemm_phase(PG8_LAS unsigned char* lds, const Gemm g, const Sched& S, const Epi& E) {
    const int tid = threadIdx.x, wid = __builtin_amdgcn_readfirstlane(tid >> 6), lane = tid & 63, wr = wid >> 2, wc = wid & 3, fr = lane & 15, fq = lane >> 4;
    const int K = g.K, nt = K / BK;
    unsigned voffA[2], voffB[2];
#pragma unroll
    for (int i = 0; i < 2; ++i) { int R, C; stage_rc(tid * 16 + i * 8192, R, C); const int Rb = Epi::PERM ? ((R & ~31) + perm32(R & 31)) : R;
        voffA[i] = (unsigned)(R * K + C) * 2u; voffB[i] = (unsigned)(Rb * K + C) * 2u; }
    const size_t kstep = (size_t)(BK * 2);
    const size_t hstep = (size_t)HALF * K * 2;
    const size_t tstep = 2 * hstep;
    const unsigned ldsw = (unsigned)wid * 1024u;
    const int aoff = lds_byte(wr * 64 + fr, fq * 8), boff = lds_byte(wc * 32 + fr, fq * 8);
#define PG8_SA(b, h) (((b) * 2 + (h)) * HTB)
#define PG8_SB(b, h) ((4 + (b) * 2 + (h)) * HTB)
#define PG8_STAGE(bufoff, gbase, voff) do { _Pragma("unroll") for (int _i = 0; _i < 2; ++_i) \
        __builtin_amdgcn_global_load_lds((const unsigned*)((const char*)(gbase) + (voff)[_i]), (PG8_LAS unsigned*)(lds + (bufoff) + ldsw + _i * 8192), 16, 0, 0); } while (0)
#define PG8_LDA(dst, b, h) do { _Pragma("unroll") for (int m = 0; m < 4; ++m) _Pragma("unroll") for (int k = 0; k < 2; ++k) dst[m][k] = *(const PG8_LAS bf16x8*)(lds + PG8_SA(b, h) + aoff + m * 2048 + k * 1024); } while (0)
#define PG8_LDB(dst, b, h) do { _Pragma("unroll") for (int n = 0; n < 2; ++n) _Pragma("unroll") for (int k = 0; k < 2; ++k) dst[n][k] = *(const PG8_LAS bf16x8*)(lds + PG8_SB(b, h) + boff + n * 2048 + k * 1024); } while (0)
#define PG8_MMA(ai, bj, At, Bt) do { __builtin_amdgcn_s_setprio(1); _Pragma("unroll") for (int m = 0; m < 4; ++m) _Pragma("unroll") for (int n = 0; n < 2; ++n) _Pragma("unroll") for (int k = 0; k < 2; ++k) \
        acc[ai][bj][m][n] = __builtin_amdgcn_mfma_f32_16x16x32_bf16(Bt[n][k], At[m][k], acc[ai][bj][m][n], 0, 0, 0); __builtin_amdgcn_s_setprio(0); } while (0)
#define PG8_WAIT_V(n) asm volatile("s_waitcnt vmcnt(" #n ")" ::: "memory")
#define PG8_WAIT_L(n) asm volatile("s_waitcnt lgkmcnt(" #n ")" ::: "memory")
#define PG8_BAR __builtin_amdgcn_s_barrier()
#define PG8_SCHED __builtin_amdgcn_sched_barrier(0)
    Unit cur, nxt; int ui = 0;
    if (!S.next(0, cur)) return;
    f32x4 acc[2][2][4][2];
#pragma unroll
    for (int a = 0; a < 2; ++a)
#pragma unroll
        for (int b = 0; b < 2; ++b)
#pragma unroll
            for (int m = 0; m < 4; ++m)
#pragma unroll
                for (int n = 0; n < 2; ++n) acc[a][b][m][n] = (f32x4){0.f, 0.f, 0.f, 0.f};
    bf16x8 At[4][2], B0[2][2], B1[2][2];
    const char* cA = (const char*)g.A + (size_t)cur.pm * tstep; const char* cB = (const char*)g.Bt + (size_t)cur.pn * tstep;
    S.a_ready(cur);
    if constexpr (SP2) {
        PG8_STAGE(PG8_SB(0, 0), cB, voffB); PG8_STAGE(PG8_SB(0, 1), cB + hstep, voffB); PG8_STAGE(PG8_SA(0, 0), cA, voffA); PG8_STAGE(PG8_SA(0, 1), cA + hstep, voffA);
        if (wr == 1) PG8_BAR;
        PG8_WAIT_V(2); PG8_BAR;
        PG8_STAGE(PG8_SB(1, 0), cB + kstep, voffB); PG8_STAGE(PG8_SA(1, 0), cA + kstep, voffA); PG8_STAGE(PG8_SB(1, 1), cB + hstep + kstep, voffB);
        PG8_WAIT_V(6); PG8_BAR;
    } else {
        PG8_STAGE(PG8_SB(0, 0), cB, voffB); PG8_STAGE(PG8_SA(0, 0), cA, voffA); PG8_STAGE(PG8_SB(0, 1), cB + hstep, voffB); PG8_STAGE(PG8_SA(0, 1), cA + hstep, voffA);
        if (wr == 1) PG8_BAR;
        PG8_WAIT_V(4); PG8_BAR;
        PG8_STAGE(PG8_SB(1, 0), cB + kstep, voffB); PG8_STAGE(PG8_SA(1, 0), cA + kstep, voffA); PG8_STAGE(PG8_SB(1, 1), cB + hstep + kstep, voffB);
        PG8_WAIT_V(6); PG8_BAR;
    }
    for (;;) {
        const bool has_next = S.next(ui + 1, nxt);
        const char* nA = has_next ? (const char*)g.A + (size_t)nxt.pm * tstep : cA; const char* nB = has_next ? (const char*)g.Bt + (size_t)nxt.pn * tstep : cB;
        for (int t = 0; t < nt; t += 2) {
            const bool last = (t == nt - 2);
            const char* a1 = cA + (size_t)(t + 1) * kstep;
            const char* a2 = last ? nA : cA + (size_t)(t + 2) * kstep; const char* b2 = last ? nB : cB + (size_t)(t + 2) * kstep;
            const char* a3 = a2 + kstep; const char* b3 = b2 + kstep;
            if (last && has_next) S.a_ready(nxt);
            if constexpr (SP2) {
            PG8_LDB(B0, 0, 0); PG8_LDB(B1, 0, 1); PG8_SCHED; PG8_LDA(At, 0, 0); PG8_STAGE(PG8_SA(1, 1), a1 + hstep, voffA);
            PG8_WAIT_V(8); PG8_WAIT_L(0); PG8_BAR; PG8_MMA(0, 0, At, B0); PG8_MMA(0, 1, At, B1); PG8_BAR; PG8_SCHED;
            PG8_LDA(At, 0, 1); PG8_STAGE(PG8_SB(0, 0), b2, voffB); PG8_STAGE(PG8_SB(0, 1), b2 + hstep, voffB); PG8_STAGE(PG8_SA(0, 0), a2, voffA);
            PG8_WAIT_V(8); PG8_WAIT_L(0); PG8_BAR; PG8_MMA(1, 0, At, B0); PG8_MMA(1, 1, At, B1); PG8_BAR; PG8_SCHED;
            PG8_LDB(B0, 1, 0); PG8_LDB(B1, 1, 1); PG8_SCHED; PG8_LDA(At, 1, 0); PG8_STAGE(PG8_SA(0, 1), a2 + hstep, voffA);
            PG8_WAIT_V(8); PG8_WAIT_L(0); PG8_BAR; PG8_MMA(0, 0, At, B0); PG8_MMA(0, 1, At, B1); PG8_BAR; PG8_SCHED;
            PG8_LDA(At, 1, 1); PG8_STAGE(PG8_SB(1, 0), b3, voffB); PG8_STAGE(PG8_SB(1, 1), b3 + hstep, voffB); PG8_STAGE(PG8_SA(1, 0), a3, voffA);
            PG8_WAIT_V(8); PG8_WAIT_L(0); PG8_BAR; PG8_MMA(1, 0, At, B0); PG8_MMA(1, 1, At, B1); PG8_BAR; PG8_SCHED;
            } else {
            PG8_LDB(B0, 0, 0); PG8_SCHED; PG8_LDA(At, 0, 0); PG8_STAGE(PG8_SA(1, 1), a1 + hstep, voffA);
            PG8_WAIT_L(8); PG8_BAR; PG8_WAIT_L(0); PG8_MMA(0, 0, At, B0); PG8_BAR; PG8_SCHED;
            PG8_LDB(B1, 0, 1); PG8_STAGE(PG8_SB(0, 0), b2, voffB);
            PG8_BAR; PG8_WAIT_L(0); PG8_MMA(0, 1, At, B1); PG8_BAR;
            PG8_LDA(At, 0, 1); PG8_STAGE(PG8_SA(0, 0), a2, voffA);
            PG8_BAR; PG8_WAIT_L(0); PG8_MMA(1, 0, At, B0); PG8_BAR; PG8_SCHED;
            PG8_STAGE(PG8_SB(0, 1), b2 + hstep, voffB);
            PG8_WAIT_V(6); PG8_BAR; PG8_MMA(1, 1, At, B1); PG8_BAR;
            PG8_LDB(B0, 1, 0); PG8_SCHED; PG8_LDA(At, 1, 0); PG8_STAGE(PG8_SA(0, 1), a2 + hstep, voffA);
            PG8_WAIT_L(8); PG8_BAR; PG8_WAIT_L(0); PG8_MMA(0, 0, At, B0); PG8_BAR; PG8_SCHED;
            PG8_LDB(B1, 1, 1); PG8_STAGE(PG8_SB(1, 0), b3, voffB);
            PG8_BAR; PG8_WAIT_L(0); PG8_MMA(0, 1, At, B1); PG8_BAR;
            PG8_LDA(At, 1, 1); PG8_STAGE(PG8_SA(1, 0), a3, voffA);
            PG8_BAR; PG8_WAIT_L(0); PG8_MMA(1, 0, At, B0); PG8_BAR; PG8_SCHED;
            PG8_STAGE(PG8_SB(1, 1), b3 + hstep, voffB);
            PG8_WAIT_V(6); PG8_BAR; PG8_MMA(1, 1, At, B1); PG8_BAR;
            }
        }
        if constexpr (ALIGN_EPI) { if (wr == 0) PG8_BAR; }
        if constexpr (!Epi::AFTER_DRAIN) { E(acc, cur, wr, wc, fr, fq); S.done(cur); }
        if (!has_next) break;
#pragma unroll
        for (int a = 0; a < 2; ++a)
#pragma unroll
            for (int b = 0; b < 2; ++b)
#pragma unroll
                for (int m = 0; m < 4; ++m)
#pragma unroll
                    for (int n = 0; n < 2; ++n) acc[a][b][m][n] = (f32x4){0.f, 0.f, 0.f, 0.f};
        cur = nxt; cA = nA; cB = nB; ++ui;
        if constexpr (ALIGN_EPI) { if (wr == 1) PG8_BAR; }
    }
    PG8_WAIT_V(0);
    if constexpr (!ALIGN_EPI) { if (wr == 0) PG8_BAR; }
    PG8_BAR;
    if constexpr (Epi::AFTER_DRAIN) { E.fused(acc, cur, wr, wc, fr, fq, lds, wid, lane); S.done(cur); }
#undef PG8_SA
#undef PG8_SB
#undef PG8_STAGE
#undef PG8_LDA
#undef PG8_LDB
#undef PG8_MMA
#undef PG8_WAIT_V
#undef PG8_WAIT_L
#undef PG8_BAR
#undef PG8_SCHED
}
}
namespace att {
using bf16 = unsigned short;
constexpr int   D = 128, NW = 8, QBLK = 32, KVBLK = 64;
constexpr float SCALE = 0.088388347648318440f;
#ifndef ATT_THR
#define ATT_THR 8.f
#endif
constexpr float THR = ATT_THR;
constexpr int SDEPTH = 2;
constexpr int LDQ = 128, LDK = 128, LDO = 2048;
constexpr size_t SHM_V = KVBLK * D * 2, SHM_K = KVBLK * D * 2, SHM_ATTN = 2 * SHM_V + 2 * SHM_K + NW * 64 * 4;
using bf16x8 = __attribute__((ext_vector_type(8))) short;
using s16x4  = __attribute__((ext_vector_type(4))) short;
using f32x16 = __attribute__((ext_vector_type(16))) float;
using f32x8  = __attribute__((ext_vector_type(8))) float;
using u32x4  = __attribute__((ext_vector_type(4))) unsigned;
#define KSWZ(row, colB) ((row) * 256 + ((colB) ^ (((row) & 7) << 4)))
#define SBAR() __builtin_amdgcn_sched_barrier(0)
__device__ __forceinline__ int crow(int r, int hi) { return (r & 3) + 8 * (r >> 2) + 4 * hi; }
__device__ __forceinline__ unsigned cvtpk(float lo, float hi) {
  unsigned r; asm volatile("v_cvt_pk_bf16_f32 %0, %1, %2" : "=v"(r) : "v"(lo), "v"(hi)); return r;
}
template <typename TIn> struct Stage;
template <> struct Stage<bf16>  { using T = bf16x8;
  __device__ static __forceinline__ T ld8(const bf16* p) { return *reinterpret_cast<const bf16x8*>(p); }
  __device__ static __forceinline__ bf16x8 tobf(T x) { return x; } };
template <> struct Stage<float> { using T = f32x8;
  __device__ static __forceinline__ T ld8(const float* p) { return *reinterpret_cast<const f32x8*>(p); }
  __device__ static __forceinline__ bf16x8 tobf(T x) {
    u32x4 w = {cvtpk(x[0], x[1]), cvtpk(x[2], x[3]), cvtpk(x[4], x[5]), cvtpk(x[6], x[7])}; return *reinterpret_cast<bf16x8*>(&w); } };

__device__ __forceinline__ void partialSM(f32x16& p0, f32x16& p1, float& m_reg, float& mn, float& alpha) {
  constexpr float C = SCALE * 1.4426950408889634f;
  float pmax = p0[0]; for (int r = 1; r < 16; ++r) pmax = fmaxf(pmax, p0[r]); for (int r = 0; r < 16; ++r) pmax = fmaxf(pmax, p1[r]);
  { auto rr = __builtin_amdgcn_permlane32_swap(__float_as_uint(pmax), __float_as_uint(pmax), false, false);
    pmax = fmaxf(__uint_as_float(rr[0]), __uint_as_float(rr[1])); }
  if (__builtin_expect(__all(pmax - m_reg <= THR / SCALE), 1)) { mn = m_reg; alpha = 1.f; }
  else { mn = fmaxf(m_reg, pmax); alpha = __builtin_amdgcn_exp2f((m_reg - mn) * C); m_reg = mn; }
  float mnC = -mn * C;
  for (int r = 0; r < 16; ++r) p0[r] = fmaf(p0[r], C, mnC); for (int r = 0; r < 16; ++r) p1[r] = fmaf(p1[r], C, mnC);
  for (int r = 0; r < 16; ++r) p0[r] = __builtin_amdgcn_exp2f(p0[r]);
}
__device__ __forceinline__ void finishSM(f32x16& p0, f32x16& p1, float alpha, float& l_reg, bf16x8& pa0, bf16x8& pa1, bf16x8& pa2, bf16x8& pa3) {
  for (int r = 0; r < 16; ++r) p1[r] = __builtin_amdgcn_exp2f(p1[r]);
  float ps = 0; for (int r = 0; r < 16; ++r) ps += p0[r]; for (int r = 0; r < 16; ++r) ps += p1[r];
  { auto rr = __builtin_amdgcn_permlane32_swap(__float_as_uint(ps), __float_as_uint(ps), false, false);
    ps = __uint_as_float(rr[0]) + __uint_as_float(rr[1]); }
  l_reg = l_reg * alpha + ps;
#define PK4(P, BASE, OUT) do { unsigned a0 = cvtpk(P[BASE + 0], P[BASE + 1]), a1 = cvtpk(P[BASE + 2], P[BASE + 3]);   \
    unsigned b0 = cvtpk(P[BASE + 4], P[BASE + 5]), b1 = cvtpk(P[BASE + 6], P[BASE + 7]);                              \
    auto r0 = __builtin_amdgcn_permlane32_swap(a0, b0, false, false); auto r1 = __builtin_amdgcn_permlane32_swap(a1, b1, false, false); \
    u32x4 w = {r0[0], r1[0], r0[1], r1[1]}; OUT = *reinterpret_cast<bf16x8*>(&w); } while (0)
  PK4(p0, 0, pa0); PK4(p0, 8, pa1); PK4(p1, 0, pa2); PK4(p1, 8, pa3);
#undef PK4
}
__device__ __forceinline__ void qkt(f32x16& p0, f32x16& p1, const bf16* Ks, const bf16x8* qr, int r32, int hi) {
  p0 = f32x16{}; p1 = f32x16{};
  for (int d0 = 0; d0 < 8; ++d0) { int cb = (d0 * 16 + hi * 8) * 2;
    bf16x8 b0 = *reinterpret_cast<const bf16x8*>((const char*)Ks + KSWZ(r32, cb));
    bf16x8 b1 = *reinterpret_cast<const bf16x8*>((const char*)Ks + KSWZ(32 + r32, cb));
    p0 = __builtin_amdgcn_mfma_f32_32x32x16_bf16(b0, qr[d0], p0, 0, 0, 0);
    p1 = __builtin_amdgcn_mfma_f32_32x32x16_bf16(b1, qr[d0], p1, 0, 0, 0); }
}
__device__ __forceinline__ int v_st(int k, int c) { const int kk = (k & ~0xC) | ((k & 4) << 1) | ((k & 8) >> 1); return ((kk >> 3) * 4 + (c >> 5)) * 512 + ((kk & 7) * 32 + (c & 31)) * 2; }
__device__ __forceinline__ int v_rd_base(int lane) { return ((lane & 3) << 3) | (((lane >> 2) & 3) << 6) | (((lane >> 4) & 1) << 5) | (((lane >> 5) & 1) << 8); }
constexpr int v_rd_off(int d0, int ks, int half) { return d0 * 512 + ks * 4096 + half * 2048; }
template <int OFF> __device__ __forceinline__ s16x4 tr_read(int vb) {
  s16x4 r; asm volatile("ds_read_b64_tr_b16 %0, %1 offset:%2" : "=&v"(r) : "v"(vb), "i"(OFF) : "memory"); return r;
}
template <int D0> __device__ __forceinline__ void pv_one(f32x16& od, int vb, bf16x8 pa0, bf16x8 pa1, bf16x8 pa2, bf16x8 pa3) {
  const s16x4 l0 = tr_read<v_rd_off(D0, 0, 0)>(vb), h0 = tr_read<v_rd_off(D0, 0, 1)>(vb), l1 = tr_read<v_rd_off(D0, 1, 0)>(vb), h1 = tr_read<v_rd_off(D0, 1, 1)>(vb);
  const s16x4 l2 = tr_read<v_rd_off(D0, 2, 0)>(vb), h2 = tr_read<v_rd_off(D0, 2, 1)>(vb), l3 = tr_read<v_rd_off(D0, 3, 0)>(vb), h3 = tr_read<v_rd_off(D0, 3, 1)>(vb);
  asm volatile("s_waitcnt lgkmcnt(0)" ::: "memory"); SBAR();
#define PK(L, H) (bf16x8){L[0], L[1], L[2], L[3], H[0], H[1], H[2], H[3]}
  od = __builtin_amdgcn_mfma_f32_32x32x16_bf16(pa0, PK(l0, h0), od, 0, 0, 0);
  od = __builtin_amdgcn_mfma_f32_32x32x16_bf16(pa1, PK(l1, h1), od, 0, 0, 0);
  od = __builtin_amdgcn_mfma_f32_32x32x16_bf16(pa2, PK(l2, h2), od, 0, 0, 0);
  od = __builtin_amdgcn_mfma_f32_32x32x16_bf16(pa3, PK(l3, h3), od, 0, 0, 0);
#undef PK
}
__device__ __forceinline__ void pv_d0(f32x16* o, int vb, bf16x8 pa0, bf16x8 pa1, bf16x8 pa2, bf16x8 pa3) {
  pv_one<0>(o[0], vb, pa0, pa1, pa2, pa3); pv_one<1>(o[1], vb, pa0, pa1, pa2, pa3); pv_one<2>(o[2], vb, pa0, pa1, pa2, pa3); pv_one<3>(o[3], vb, pa0, pa1, pa2, pa3);
}

template <typename TQ>
__device__ __forceinline__ void attn_dense_body(const TQ* __restrict__ Qb, const bf16* __restrict__ Kh, const bf16* __restrict__ Vh,
                                                bf16* __restrict__ Ob, int seq, char* lds) {
  using St = Stage<bf16>; using SQ = Stage<TQ>;
  const int tid = threadIdx.x, wid = tid >> 6, lane = tid & 63, r32 = lane & 31, hi = lane >> 5;
  bf16* V_lds = (bf16*)lds; bf16* K_lds = (bf16*)(lds + 2 * SHM_V);
  float* ws = (float*)(lds + 2 * SHM_V + 2 * SHM_K) + wid * 64; float* li_l = ws; float* al_l = ws + 32;
  float m_reg = -1e30f, l_reg = 0; f32x16 o[4] = {}; bf16x8 qr[8];
  const TQ* Qw = Qb + (long)(wid * QBLK + r32) * LDQ + hi * 8;
#pragma unroll
  for (int d0 = 0; d0 < 8; ++d0) qr[d0] = SQ::tobf(SQ::ld8(Qw + d0 * 16));
  const int sr = tid >> 4, sc = (tid & 15) * 8, vst0 = v_st(sr, sc), vst1 = v_st(32 + sr, sc);
  const int vb0 = (int)(uintptr_t)V_lds + v_rd_base(lane);
  struct { typename St::T vs0, vs1, ks0, ks1; } sr_[SDEPTH];
#define SLOAD(i, k0) do { sr_[i].vs0 = St::ld8(&Vh[(long)((k0) + sr) * LDK + sc]); sr_[i].vs1 = St::ld8(&Vh[(long)((k0) + 32 + sr) * LDK + sc]); \
    sr_[i].ks0 = St::ld8(&Kh[(long)((k0) + sr) * LDK + sc]); sr_[i].ks1 = St::ld8(&Kh[(long)((k0) + 32 + sr) * LDK + sc]); } while (0)
#define SWRITE(b, i) do { *(bf16x8*)((char*)V_lds + (b) * SHM_V + vst0) = St::tobf(sr_[i].vs0);          \
    *(bf16x8*)((char*)V_lds + (b) * SHM_V + vst1) = St::tobf(sr_[i].vs1); int kc = sc * 2;               \
    *(bf16x8*)((char*)K_lds + (b) * SHM_K + KSWZ(sr, kc)) = St::tobf(sr_[i].ks0);                       \
    *(bf16x8*)((char*)K_lds + (b) * SHM_K + KSWZ(32 + sr, kc)) = St::tobf(sr_[i].ks1); } while (0)
#define SWAIT() do { if constexpr (SDEPTH == 2) asm volatile("s_waitcnt vmcnt(4)" ::: "memory"); else asm volatile("s_waitcnt vmcnt(0)" ::: "memory"); } while (0)
#define RESC(a) do { if (__any((a) < 1.f)) { if (hi == 0) al_l[r32] = (a); asm volatile("s_waitcnt lgkmcnt(0)" ::: "memory"); \
    for (int d = 0; d < 4; ++d) for (int r = 0; r < 16; ++r) o[d][r] *= al_l[crow(r, hi)]; } } while (0)
  f32x16 pA0, pA1, pB0, pB1; float mnA, mnB, alA, alB; bf16x8 pa0, pa1, pa2, pa3; const int NT = seq / KVBLK;
  constexpr int SE = 0, SO = SDEPTH - 1;
  SLOAD(SE, 0); asm volatile("s_waitcnt vmcnt(0)" ::: "memory"); SWRITE(0, SE); __syncthreads();
  qkt(pA0, pA1, K_lds, qr, r32, hi); partialSM(pA0, pA1, m_reg, mnA, alA);
  SLOAD(SO, KVBLK); if constexpr (SDEPTH == 2) { if (2 < NT) SLOAD(SE, 2 * KVBLK); }
  SWAIT(); SWRITE(1, SO); __syncthreads();
  for (int j = 1; j + 1 < NT; j += 2) {
    SBAR(); qkt(pB0, pB1, (bf16*)((char*)K_lds + SHM_K), qr, r32, hi);
    finishSM(pA0, pA1, alA, l_reg, pa0, pa1, pa2, pa3); SBAR();
    SLOAD(SO, (j + SDEPTH) * KVBLK); SBAR();
    pv_d0(o, vb0, pa0, pa1, pa2, pa3); partialSM(pB0, pB1, m_reg, mnB, alB);
    __syncthreads(); SWAIT(); SWRITE(0, SE);
    RESC(alB); __syncthreads();
    SBAR(); qkt(pA0, pA1, K_lds, qr, r32, hi);
    finishSM(pB0, pB1, alB, l_reg, pa0, pa1, pa2, pa3); SBAR();
    if (SDEPTH == 1 || j + 3 < NT) SLOAD(SE, (j + 1 + SDEPTH) * KVBLK); SBAR();
    pv_d0(o, vb0 + (int)SHM_V, pa0, pa1, pa2, pa3); partialSM(pA0, pA1, m_reg, mnA, alA);
    __syncthreads(); SWAIT(); SWRITE(1, SO);
    RESC(alA); __syncthreads();
  }
  SBAR(); qkt(pB0, pB1, (bf16*)((char*)K_lds + SHM_K), qr, r32, hi);
  finishSM(pA0, pA1, alA, l_reg, pa0, pa1, pa2, pa3); SBAR();
  pv_d0(o, vb0, pa0, pa1, pa2, pa3); partialSM(pB0, pB1, m_reg, mnB, alB);
  __syncthreads(); RESC(alB);
  finishSM(pB0, pB1, alB, l_reg, pa0, pa1, pa2, pa3); SBAR();
  pv_d0(o, vb0 + (int)SHM_V, pa0, pa1, pa2, pa3);
  if (hi == 0) li_l[r32] = l_reg; asm volatile("s_waitcnt lgkmcnt(0)" ::: "memory");
  float rli[16];
#pragma unroll
  for (int r = 0; r < 16; ++r) rli[r] = __builtin_amdgcn_rcpf(li_l[crow(r, hi)]);
  bf16* Ow = Ob + (long)(wid * QBLK) * LDO;
#pragma unroll
  for (int r = 0; r < 16; ++r) { int orow = crow(r, hi);
    for (int d0 = 0; d0 < 4; ++d0) Ow[(long)orow * LDO + d0 * 32 + r32] = (bf16)(cvtpk(o[d0][r] * rli[r], 0.f) & 0xffffu); }
#undef SLOAD
#undef SWRITE
#undef SWAIT
#undef RESC
}

#define ATT_LAS __attribute__((address_space(3)))
__device__ __forceinline__ void qkt_lean(f32x16& p0, f32x16& p1, const bf16* Ks, const bf16x8* qr, int r32, int hi) {
  p0 = f32x16{}; p1 = f32x16{};
#pragma unroll
  for (int d0 = 0; d0 < 8; ++d0) { const int cb = (d0 * 16 + hi * 8) * 2;
    const bf16x8 b0 = *reinterpret_cast<const bf16x8*>((const char*)Ks + KSWZ(r32, cb));
    const bf16x8 b1 = *reinterpret_cast<const bf16x8*>((const char*)Ks + KSWZ(32 + r32, cb));
    p0 = __builtin_amdgcn_mfma_f32_32x32x16_bf16(b0, qr[d0], p0, 0, 0, 0);
    p1 = __builtin_amdgcn_mfma_f32_32x32x16_bf16(b1, qr[d0], p1, 0, 0, 0);
    if (d0 & 1) SBAR(); }
}
#define A2_WAITL(n) do { asm volatile("s_waitcnt lgkmcnt(" #n ")" ::: "memory"); SBAR(); } while (0)
__device__ __forceinline__ void kq_rd(int a0, bf16x8& b0, bf16x8& b1) {
  asm volatile("ds_read_b128 %0, %1" : "=&v"(b0) : "v"(a0) : "memory");
  asm volatile("ds_read_b128 %0, %1 offset:8192" : "=&v"(b1) : "v"(a0) : "memory");
}
__device__ __forceinline__ void qkt_pipe(f32x16& p0, f32x16& p1, int kaddr, int sw, int hi, const bf16x8* qr) {
  p0 = f32x16{}; p1 = f32x16{};
  bf16x8 a0, a1, b0, b1;
#define KA(d0) (kaddr + (((d0) * 32 + hi * 16) ^ sw))
#define KM(x0, x1, d0) do { p0 = __builtin_amdgcn_mfma_f32_32x32x16_bf16(x0, qr[d0], p0, 0, 0, 0); p1 = __builtin_amdgcn_mfma_f32_32x32x16_bf16(x1, qr[d0], p1, 0, 0, 0); } while (0)
  kq_rd(KA(0), a0, a1); kq_rd(KA(1), b0, b1);
  A2_WAITL(2); KM(a0, a1, 0); SBAR(); kq_rd(KA(2), a0, a1);
  A2_WAITL(2); KM(b0, b1, 1); SBAR(); kq_rd(KA(3), b0, b1);
  A2_WAITL(2); KM(a0, a1, 2); SBAR(); kq_rd(KA(4), a0, a1);
  A2_WAITL(2); KM(b0, b1, 3); SBAR(); kq_rd(KA(5), b0, b1);
  A2_WAITL(2); KM(a0, a1, 4); SBAR(); kq_rd(KA(6), a0, a1);
  A2_WAITL(2); KM(b0, b1, 5); SBAR(); kq_rd(KA(7), b0, b1);
  A2_WAITL(2); KM(a0, a1, 6);
  A2_WAITL(0); KM(b0, b1, 7);
#undef KA
#undef KM
}
template <int HB> __device__ __forceinline__ void pv_rd(int vb, s16x4& la, s16x4& ha, s16x4& lb, s16x4& hb) {
  constexpr int blk = HB >> 1, part = HB & 1, D0 = blk & 3, base = (blk >> 2) * 16384;
  la = tr_read<base + v_rd_off(D0, 2 * part, 0)>(vb); ha = tr_read<base + v_rd_off(D0, 2 * part, 1)>(vb);
  lb = tr_read<base + v_rd_off(D0, 2 * part + 1, 0)>(vb); hb = tr_read<base + v_rd_off(D0, 2 * part + 1, 1)>(vb);
}
template <int HB> __device__ __forceinline__ void pv_mm(f32x16* o, s16x4 la, s16x4 ha, s16x4 lb, s16x4 hb, bf16x8 pa0, bf16x8 pa1, bf16x8 pa2, bf16x8 pa3) {
#define PK(L, H) (bf16x8){L[0], L[1], L[2], L[3], H[0], H[1], H[2], H[3]}
  f32x16& od = o[HB >> 1];
  od = __builtin_amdgcn_mfma_f32_32x32x16_bf16((HB & 1) ? pa2 : pa0, PK(la, ha), od, 0, 0, 0);
  od = __builtin_amdgcn_mfma_f32_32x32x16_bf16((HB & 1) ? pa3 : pa1, PK(lb, hb), od, 0, 0, 0);
#undef PK
}
__device__ __forceinline__ void pv_pipe(f32x16* o, int vb, bf16x8 pa0, bf16x8 pa1, bf16x8 pa2, bf16x8 pa3) {
  s16x4 a0, a1, a2, a3, b0, b1, b2, b3;
  pv_rd<0>(vb, a0, a1, a2, a3); pv_rd<1>(vb, b0, b1, b2, b3);
#define STEP(H) A2_WAITL(4); pv_mm<H>(o, a0, a1, a2, a3, pa0, pa1, pa2, pa3); SBAR(); pv_rd<H + 2>(vb, a0, a1, a2, a3); \
                A2_WAITL(4); pv_mm<H + 1>(o, b0, b1, b2, b3, pa0, pa1, pa2, pa3); SBAR(); pv_rd<H + 3>(vb, b0, b1, b2, b3);
  STEP(0) STEP(2) STEP(4) STEP(6) STEP(8) STEP(10) STEP(12)
#undef STEP
  A2_WAITL(4); pv_mm<14>(o, a0, a1, a2, a3, pa0, pa1, pa2, pa3);
  A2_WAITL(0); pv_mm<15>(o, b0, b1, b2, b3, pa0, pa1, pa2, pa3);
}
__device__ __forceinline__ void qkt_asm(f32x16& p0, f32x16& p1, int kaddr, int sw, int hi, const bf16x8* qr) {
  p0 = f32x16{}; p1 = f32x16{};
#pragma unroll
  for (int d0 = 0; d0 < 8; ++d0) {
    const int a0 = kaddr + ((d0 * 32 + hi * 16) ^ sw);
    bf16x8 b0, b1;
    asm volatile("ds_read_b128 %0, %1" : "=&v"(b0) : "v"(a0) : "memory");
    asm volatile("ds_read_b128 %0, %1 offset:8192" : "=&v"(b1) : "v"(a0) : "memory");
    asm volatile("s_waitcnt lgkmcnt(0)" ::: "memory"); SBAR();
    p0 = __builtin_amdgcn_mfma_f32_32x32x16_bf16(b0, qr[d0], p0, 0, 0, 0);
    p1 = __builtin_amdgcn_mfma_f32_32x32x16_bf16(b1, qr[d0], p1, 0, 0, 0);
  }
}
template <int D0> __device__ __forceinline__ void pv_one_lean(f32x16& od, int vb, bf16x8 pa0, bf16x8 pa1, bf16x8 pa2, bf16x8 pa3) {
#define PK(L, H) (bf16x8){L[0], L[1], L[2], L[3], H[0], H[1], H[2], H[3]}
  { const s16x4 l0 = tr_read<v_rd_off(D0, 0, 0)>(vb), h0 = tr_read<v_rd_off(D0, 0, 1)>(vb), l1 = tr_read<v_rd_off(D0, 1, 0)>(vb), h1 = tr_read<v_rd_off(D0, 1, 1)>(vb);
    asm volatile("s_waitcnt lgkmcnt(0)" ::: "memory"); SBAR();
    od = __builtin_amdgcn_mfma_f32_32x32x16_bf16(pa0, PK(l0, h0), od, 0, 0, 0);
    od = __builtin_amdgcn_mfma_f32_32x32x16_bf16(pa1, PK(l1, h1), od, 0, 0, 0); }
  { const s16x4 l2 = tr_read<v_rd_off(D0, 2, 0)>(vb), h2 = tr_read<v_rd_off(D0, 2, 1)>(vb), l3 = tr_read<v_rd_off(D0, 3, 0)>(vb), h3 = tr_read<v_rd_off(D0, 3, 1)>(vb);
    asm volatile("s_waitcnt lgkmcnt(0)" ::: "memory"); SBAR();
    od = __builtin_amdgcn_mfma_f32_32x32x16_bf16(pa2, PK(l2, h2), od, 0, 0, 0);
    od = __builtin_amdgcn_mfma_f32_32x32x16_bf16(pa3, PK(l3, h3), od, 0, 0, 0); }
#undef PK
}
__device__ __forceinline__ void pv_d0_lean(f32x16* o, int vb, bf16x8 pa0, bf16x8 pa1, bf16x8 pa2, bf16x8 pa3) {
  pv_one_lean<0>(o[0], vb, pa0, pa1, pa2, pa3); pv_one_lean<1>(o[1], vb, pa0, pa1, pa2, pa3); pv_one_lean<2>(o[2], vb, pa0, pa1, pa2, pa3); pv_one_lean<3>(o[3], vb, pa0, pa1, pa2, pa3);
}
constexpr int A2_K = 0, A2_V = 32768, A2_WS = 131072 + 1024;
template <int MODE> __device__ __forceinline__ void attn256_unit(const bf16* __restrict__ Qb, const bf16* __restrict__ Kh, const bf16* __restrict__ V0h, const bf16* __restrict__ V1h,
                                             bf16* Ob, int ntiles, char* lds, ATT_LAS unsigned char* ldsl, bf16* __restrict__ OAb, const float* __restrict__ subw, float lam, float eps, float osc) {
  int tid = threadIdx.x; asm volatile("" : "+v"(tid));
  const int wid = tid >> 6, lane = tid & 63, r32 = lane & 31, hi = lane >> 5;
  float m_reg = -1e30f, l_reg = 0; f32x16 o[8] = {}; bf16x8 qr[8];
  { const bf16* Qw = Qb + (long)(wid * QBLK + r32) * 128 + hi * 8;
#pragma unroll
    for (int d0 = 0; d0 < 8; ++d0) qr[d0] = *reinterpret_cast<const bf16x8*>(Qw + d0 * 16);
#pragma unroll
    for (int d0 = 0; d0 < 8; ++d0) asm volatile("" : "+v"(qr[d0])); }
  unsigned koff, voff;
  { const int L = wid * 1024 + lane * 16;
    { const int row = L >> 8; koff = (unsigned)(row * 256 + ((L & 255) ^ ((row & 7) << 4))); }
    { const int sub = L >> 9, w = L & 511, kk = ((sub >> 2) << 3) | (w >> 6), k = (kk & ~0xC) | ((kk & 4) << 1) | ((kk & 8) >> 1), c = (sub & 3) * 32 + ((w & 63) >> 1); voff = (unsigned)(k * 256 + c * 2); } }
  const unsigned ldsw = (unsigned)__builtin_amdgcn_readfirstlane(wid) * 1024u;
#define A2_DMA(kbuf, vbuf, t) do { const char* kb_ = (const char*)Kh + (size_t)(t) * (64 * 256); const char* v0_ = (const char*)V0h + (size_t)(t) * (64 * 256); const char* v1_ = (const char*)V1h + (size_t)(t) * (64 * 256); \
    _Pragma("unroll") for (int i_ = 0; i_ < 2; ++i_) { \
      __builtin_amdgcn_global_load_lds((const unsigned*)(kb_ + i_ * 8192 + koff), (ATT_LAS unsigned*)(ldsl + A2_K + (kbuf) * 16384 + ldsw + i_ * 8192), 16, 0, 0); \
      __builtin_amdgcn_global_load_lds((const unsigned*)(v0_ + i_ * 8192 + voff), (ATT_LAS unsigned*)(ldsl + A2_V + (vbuf) * 32768 + ldsw + i_ * 8192), 16, 0, 0); \
      __builtin_amdgcn_global_load_lds((const unsigned*)(v1_ + i_ * 8192 + voff), (ATT_LAS unsigned*)(ldsl + A2_V + (vbuf) * 32768 + 16384 + ldsw + i_ * 8192), 16, 0, 0); } } while (0)
#define A2_SYNC() do { asm volatile("s_waitcnt vmcnt(0) lgkmcnt(0)" ::: "memory"); __builtin_amdgcn_s_barrier(); asm volatile("" ::: "memory"); } while (0)
  const int vb0 = (int)(uintptr_t)(lds + A2_V) + v_rd_base(lane);
  const int kad0 = (int)(uintptr_t)(lds + A2_K) + r32 * 256, ksw = (r32 & 7) << 4;
  const bool grpB = __builtin_amdgcn_readfirstlane(wid) >= 4;
  A2_DMA(0, 0, 0); A2_SYNC();
  int vc = 0, vp = 2, vn = 1;
  bf16x8 pa0, pa1, pa2, pa3;
  for (int j = 0; j < ntiles; ++j) {
    if (j + 1 < ntiles) A2_DMA((j + 1) & 1, vn, j + 1);
    SBAR();
    if (grpB && j > 0) { pv_pipe(o, vb0 + vp * 32768, pa0, pa1, pa2, pa3); }
    f32x16 p0, p1; float mn, alpha;
    qkt_pipe(p0, p1, kad0 + (j & 1) * 16384, ksw, hi, qr);
    partialSM(p0, p1, m_reg, mn, alpha);
    finishSM(p0, p1, alpha, l_reg, pa0, pa1, pa2, pa3); SBAR();
    if (__any(alpha < 1.f)) {
#pragma unroll
      for (int r = 0; r < 16; ++r) { const float a0_ = __uint_as_float(__builtin_amdgcn_readlane(__float_as_uint(alpha), crow(r, 0))), a1_ = __uint_as_float(__builtin_amdgcn_readlane(__float_as_uint(alpha), crow(r, 1)));
        const float ar = hi ? a1_ : a0_;
#pragma unroll
        for (int d = 0; d < 8; ++d) o[d][r] *= ar; } }
    if (!grpB) { pv_pipe(o, vb0 + vc * 32768, pa0, pa1, pa2, pa3); }
    A2_SYNC();
    vp = vc; vc = vn; vn = (vn == 2) ? 0 : vn + 1;
  }
  if (grpB) { pv_pipe(o, vb0 + vp * 32768, pa0, pa1, pa2, pa3); }
  { int t2 = threadIdx.x; asm volatile("" : "+v"(t2));
    const int wid2 = t2 >> 6, r32b = t2 & 31, hib = (t2 >> 5) & 1;
    float* li2 = (float*)(lds + A2_WS) + wid2 * 64;
    if (hib == 0) li2[r32b] = l_reg; asm volatile("s_waitcnt lgkmcnt(0)" ::: "memory");
    bf16* Ow = Ob + (long)(wid2 * QBLK) * LDO + r32b;
    if constexpr (MODE == 0) {
#pragma unroll
      for (int r = 0; r < 16; ++r) { const int orow = crow(r, hib); const float rl = __builtin_amdgcn_rcpf(li2[orow]);
#pragma unroll
        for (int d0 = 0; d0 < 8; ++d0) Ow[(long)orow * LDO + d0 * 32] = (bf16)(cvtpk(o[d0][r] * rl, 0.f) & 0xffffu); }
    } else {
      float sw[8];
#pragma unroll
      for (int d0 = 0; d0 < 8; ++d0) sw[d0] = subw[d0 * 32 + r32b] * osc;
      bf16* OAw = OAb + (long)(wid2 * QBLK) * 1024 + r32b;
#pragma unroll
      for (int r = 0; r < 16; ++r) { const int orow = crow(r, hib); const float rl = __builtin_amdgcn_rcpf(li2[orow]) * lam; float dv[8]; float ss = 0.f;
#pragma unroll
        for (int d0 = 0; d0 < 8; ++d0) { const float o0 = __uint_as_float(((unsigned)Ow[(long)orow * LDO + d0 * 32]) << 16); dv[d0] = o0 - o[d0][r] * rl; ss += dv[d0] * dv[d0]; }
#pragma unroll
        for (int sh = 1; sh < 32; sh <<= 1) ss += __shfl_xor(ss, sh);
        const float rs = __builtin_amdgcn_rsqf(ss * (1.0f / 256.0f) + eps);
#pragma unroll
        for (int d0 = 0; d0 < 8; ++d0) OAw[(long)orow * 1024 + d0 * 32] = (bf16)(cvtpk(dv[d0] * rs * sw[d0], 0.f) & 0xffffu); }
    } }
  A2_SYNC();
#undef A2_DMA
#undef A2_SYNC
}

typedef float f32x4a __attribute__((ext_vector_type(4)));
#if defined(ATT_CLUSTER_PRIO)
#define A3_PRIO(p) __builtin_amdgcn_s_setprio(p)
#else
#define A3_PRIO(p) do { } while (0)
#endif
__device__ __forceinline__ float xmax16(float v) { auto r = __builtin_amdgcn_permlane16_swap(__float_as_uint(v), __float_as_uint(v), false, false); return fmaxf(__uint_as_float(r[0]), __uint_as_float(r[1])); }
__device__ __forceinline__ float xmax32(float v) { auto r = __builtin_amdgcn_permlane32_swap(__float_as_uint(v), __float_as_uint(v), false, false); return fmaxf(__uint_as_float(r[0]), __uint_as_float(r[1])); }
__device__ __forceinline__ float xadd16(float v) { auto r = __builtin_amdgcn_permlane16_swap(__float_as_uint(v), __float_as_uint(v), false, false); return __uint_as_float(r[0]) + __uint_as_float(r[1]); }
__device__ __forceinline__ float xadd32(float v) { auto r = __builtin_amdgcn_permlane32_swap(__float_as_uint(v), __float_as_uint(v), false, false); return __uint_as_float(r[0]) + __uint_as_float(r[1]); }
__device__ __forceinline__ unsigned cvtpk_b(float lo, float hi) { typedef __bf16 bf2 __attribute__((ext_vector_type(2))); typedef float f2 __attribute__((ext_vector_type(2))); f2 v = {lo, hi}; bf2 b = __builtin_convertvector(v, bf2); return __builtin_bit_cast(unsigned, b); }
__device__ __forceinline__ void rows4(float x, int g, float (&out)[4]) {
#pragma unroll
  for (int j = 0; j < 4; ++j) { const float a0 = __uint_as_float(__builtin_amdgcn_readlane(__float_as_uint(x), j)), a1 = __uint_as_float(__builtin_amdgcn_readlane(__float_as_uint(x), 4 + j)),
      a2 = __uint_as_float(__builtin_amdgcn_readlane(__float_as_uint(x), 8 + j)), a3 = __uint_as_float(__builtin_amdgcn_readlane(__float_as_uint(x), 12 + j));
    out[j] = g == 0 ? a0 : g == 1 ? a1 : g == 2 ? a2 : a3; }
}
template <int OFF> __device__ __forceinline__ bf16x8 krd(int a) { bf16x8 r; asm volatile("ds_read_b128 %0, %1 offset:%2" : "=&v"(r) : "v"(a), "i"(OFF) : "memory"); return r; }
template <int MODE> __device__ __forceinline__ void attn256_unit16(const bf16* __restrict__ Qb, const bf16* __restrict__ Kh, const bf16* __restrict__ V0h, const bf16* __restrict__ V1h,
                                             bf16* Ob, int ntiles, char* lds, ATT_LAS unsigned char* ldsl, bf16* __restrict__ OAb, const float* __restrict__ subw, float lam, float eps, float osc) {
  constexpr float C = SCALE * 1.4426950408889634f;
  int tid = threadIdx.x; asm volatile("" : "+v"(tid));
  const int wid = tid >> 6, lane = tid & 63, q16 = lane & 15, g = lane >> 4;
  float m_reg[2] = {-1e30f, -1e30f}, l_reg[2] = {0.f, 0.f};
  f32x4a o[2][16];
#pragma unroll
  for (int a_ = 0; a_ < 2; ++a_)
#pragma unroll
    for (int b_ = 0; b_ < 16; ++b_) o[a_][b_] = (f32x4a){0.f, 0.f, 0.f, 0.f};
  bf16x8 qr[2][4];
  { const bf16* Qw = Qb + (long)(wid * 32 + q16) * 128 + g * 8;
#pragma unroll
    for (int qb = 0; qb < 2; ++qb)
#pragma unroll
      for (int s = 0; s < 4; ++s) qr[qb][s] = *reinterpret_cast<const bf16x8*>(Qw + qb * 16 * 128 + s * 32);
#pragma unroll
    for (int qb = 0; qb < 2; ++qb)
#pragma unroll
      for (int s = 0; s < 4; ++s) asm volatile("" : "+v"(qr[qb][s])); }
  unsigned koff, voff;
  { const int L = wid * 1024 + lane * 16;
    { const int row = L >> 8; koff = (unsigned)(row * 256 + ((L & 255) ^ ((row & 15) << 4))); }
    { const int sub = L >> 9, w = L & 511, kk = ((sub >> 2) << 3) | (w >> 6), k = (kk & ~0xC) | ((kk & 4) << 1) | ((kk & 8) >> 1), c = (sub & 3) * 32 + (((w & 63) ^ (((sub >> 2) & 1) << 5)) >> 1); voff = (unsigned)(k * 256 + c * 2); } }
  const unsigned ldsw = (unsigned)__builtin_amdgcn_readfirstlane(wid) * 1024u;
#define B3_DMA(kbuf, vbuf, t) do { const char* kb_ = (const char*)Kh + (size_t)(t) * (64 * 256); const char* v0_ = (const char*)V0h + (size_t)(t) * (64 * 256); const char* v1_ = (const char*)V1h + (size_t)(t) * (64 * 256); \
    _Pragma("unroll") for (int i_ = 0; i_ < 2; ++i_) { \
      __builtin_amdgcn_global_load_lds((const unsigned*)(kb_ + i_ * 8192 + koff), (ATT_LAS unsigned*)(ldsl + A2_K + (kbuf) * 16384 + ldsw + i_ * 8192), 16, 0, 0); \
      __builtin_amdgcn_global_load_lds((const unsigned*)(v0_ + i_ * 8192 + voff), (ATT_LAS unsigned*)(ldsl + A2_V + (vbuf) * 32768 + ldsw + i_ * 8192), 16, 0, 0); \
      __builtin_amdgcn_global_load_lds((const unsigned*)(v1_ + i_ * 8192 + voff), (ATT_LAS unsigned*)(ldsl + A2_V + (vbuf) * 32768 + 16384 + ldsw + i_ * 8192), 16, 0, 0); } } while (0)
#define B3_SYNC() do { asm volatile("s_waitcnt vmcnt(0) lgkmcnt(0)" ::: "memory"); __builtin_amdgcn_s_barrier(); asm volatile("" ::: "memory"); } while (0)
#define B3_WAITL(n) do { asm volatile("s_waitcnt lgkmcnt(" #n ")" ::: "memory"); SBAR(); } while (0)
  int ka[4];
#pragma unroll
  for (int s = 0; s < 4; ++s) ka[s] = (int)(uintptr_t)(lds + A2_K) + q16 * 256 + ((64 * s + 16 * g) ^ (q16 << 4));
  const int gs = ((g & 1) << 1) | (g >> 1);
  const int vbE = (int)(uintptr_t)(lds + A2_V) + (gs >> 1) * 2048 + ((q16 >> 2) + 4 * (gs & 1)) * 64 + 8 * (q16 & 3) + (g & 1) * 32, vbO = vbE + 32 - (g & 1) * 64;
#define VOFF(cb, m, t) ((t) * 4096 + (m) * 8192 + (((cb) & 7) >> 1) * 512 + ((cb) >> 3) * 16384)
  const bool grpB = __builtin_amdgcn_readfirstlane(wid) >= 4;
  B3_DMA(0, 0, 0); B3_SYNC();
#if defined(ATT_PRIO)
  if (grpB) __builtin_amdgcn_s_setprio(1);
#endif
  int vc = 0, vp = 2, vn = 1;
  bf16x8 pa[2][2];
#define PV_RD(cb, x0, x1, x2, x3, vb) do { const int vq_ = (((cb) & 1) ? vbO : vbE) + (vb); x0 = tr_read<VOFF(cb, 0, 0)>(vq_); x1 = tr_read<VOFF(cb, 0, 1)>(vq_); x2 = tr_read<VOFF(cb, 1, 0)>(vq_); x3 = tr_read<VOFF(cb, 1, 1)>(vq_); } while (0)
#define PKB(L, H) (bf16x8){L[0], L[1], L[2], L[3], H[0], H[1], H[2], H[3]}
#define PV_MM(cb, x0, x1, x2, x3) do { const bf16x8 b0_ = PKB(x0, x1), b1_ = PKB(x2, x3); \
    o[0][cb] = __builtin_amdgcn_mfma_f32_16x16x32_bf16(pa[0][0], b0_, o[0][cb], 0, 0, 0); o[1][cb] = __builtin_amdgcn_mfma_f32_16x16x32_bf16(pa[1][0], b0_, o[1][cb], 0, 0, 0); \
    o[0][cb] = __builtin_amdgcn_mfma_f32_16x16x32_bf16(pa[0][1], b1_, o[0][cb], 0, 0, 0); o[1][cb] = __builtin_amdgcn_mfma_f32_16x16x32_bf16(pa[1][1], b1_, o[1][cb], 0, 0, 0); } while (0)
#define PV_STEP(cb) B3_WAITL(4); PV_MM(cb, a0, a1, a2, a3); SBAR(); PV_RD(cb + 2, a0, a1, a2, a3, vb_); B3_WAITL(4); PV_MM(cb + 1, b0, b1, b2, b3); SBAR(); PV_RD(cb + 3, b0, b1, b2, b3, vb_);
#define PV_TILE(vbuf) do { const int vb_ = (vbuf) * 32768; s16x4 a0, a1, a2, a3, b0, b1, b2, b3; A3_PRIO(1); \
    PV_RD(0, a0, a1, a2, a3, vb_); PV_RD(1, b0, b1, b2, b3, vb_); \
    PV_STEP(0) PV_STEP(2) PV_STEP(4) PV_STEP(6) PV_STEP(8) PV_STEP(10) PV_STEP(12) \
    B3_WAITL(4); PV_MM(14, a0, a1, a2, a3); B3_WAITL(0); PV_MM(15, b0, b1, b2, b3); A3_PRIO(0); } while (0)
  for (int j = 0; j < ntiles; ++j) {
    if (j + 1 < ntiles) B3_DMA((j + 1) & 1, vn, j + 1);
    SBAR();
    if (grpB && j > 0) PV_TILE(vp);
    f32x4a sc[4][2];
#pragma unroll
    for (int kb = 0; kb < 4; ++kb) { sc[kb][0] = (f32x4a){0.f, 0.f, 0.f, 0.f}; sc[kb][1] = (f32x4a){0.f, 0.f, 0.f, 0.f}; }
    { const int kofs = (j & 1) * 16384; bf16x8 a0, a1, b0, b1;
#define QK_RD(kb, sp, x0, x1) do { x0 = krd<(kb) * 4096>(ka[2 * (sp)] + kofs); x1 = krd<(kb) * 4096>(ka[2 * (sp) + 1] + kofs); } while (0)
#define QK_MM(kb, sp, x0, x1) do { sc[kb][0] = __builtin_amdgcn_mfma_f32_16x16x32_bf16(x0, qr[0][2 * (sp)], sc[kb][0], 0, 0, 0); sc[kb][1] = __builtin_amdgcn_mfma_f32_16x16x32_bf16(x0, qr[1][2 * (sp)], sc[kb][1], 0, 0, 0); \
      sc[kb][0] = __builtin_amdgcn_mfma_f32_16x16x32_bf16(x1, qr[0][2 * (sp) + 1], sc[kb][0], 0, 0, 0); sc[kb][1] = __builtin_amdgcn_mfma_f32_16x16x32_bf16(x1, qr[1][2 * (sp) + 1], sc[kb][1], 0, 0, 0); } while (0)
      A3_PRIO(1); QK_RD(0, 0, a0, a1); QK_RD(0, 1, b0, b1);
      B3_WAITL(2); QK_MM(0, 0, a0, a1); SBAR(); QK_RD(1, 0, a0, a1);
      B3_WAITL(2); QK_MM(0, 1, b0, b1); SBAR(); QK_RD(1, 1, b0, b1);
      B3_WAITL(2); QK_MM(1, 0, a0, a1); SBAR(); QK_RD(2, 0, a0, a1);
      B3_WAITL(2); QK_MM(1, 1, b0, b1); SBAR(); QK_RD(2, 1, b0, b1);
      B3_WAITL(2); QK_MM(2, 0, a0, a1); SBAR(); QK_RD(3, 0, a0, a1);
      B3_WAITL(2); QK_MM(2, 1, b0, b1); SBAR(); QK_RD(3, 1, b0, b1);
      B3_WAITL(2); QK_MM(3, 0, a0, a1);
      B3_WAITL(0); QK_MM(3, 1, b0, b1); A3_PRIO(0);
#undef QK_RD
#undef QK_MM
    }
    float pm[2], alpha[2];
#pragma unroll
    for (int qb = 0; qb < 2; ++qb) { float v = sc[0][qb][0];
#pragma unroll
      for (int kb = 0; kb < 4; ++kb)
#pragma unroll
        for (int e = 0; e < 4; ++e) v = fmaxf(v, sc[kb][qb][e]);
      pm[qb] = xmax32(xmax16(v)); }
    if (__builtin_expect(__all(pm[0] - m_reg[0] <= THR / SCALE && pm[1] - m_reg[1] <= THR / SCALE), 1)) { alpha[0] = 1.f; alpha[1] = 1.f; }
    else {
#pragma unroll
      for (int qb = 0; qb < 2; ++qb) { const float mn = fmaxf(m_reg[qb], pm[qb]); alpha[qb] = __builtin_amdgcn_exp2f((m_reg[qb] - mn) * C); m_reg[qb] = mn; } }
#pragma unroll
    for (int qb = 0; qb < 2; ++qb) { const float mnC = -m_reg[qb] * C; float ps = 0.f;
#pragma unroll
      for (int kb = 0; kb < 4; ++kb) { sc[kb][qb] = sc[kb][qb] * C + mnC;
#pragma unroll
        for (int e = 0; e < 4; ++e) { sc[kb][qb][e] = __builtin_amdgcn_exp2f(sc[kb][qb][e]); ps += sc[kb][qb][e]; } }
      ps = xadd32(xadd16(ps));
      l_reg[qb] = l_reg[qb] * alpha[qb] + ps;
#pragma unroll
      for (int m = 0; m < 2; ++m) { u32x4 w = {cvtpk_b(sc[2 * m][qb][0], sc[2 * m][qb][1]), cvtpk_b(sc[2 * m][qb][2], sc[2 * m][qb][3]), cvtpk_b(sc[2 * m + 1][qb][0], sc[2 * m + 1][qb][1]), cvtpk_b(sc[2 * m + 1][qb][2], sc[2 * m + 1][qb][3])};
        pa[qb][m] = *reinterpret_cast<bf16x8*>(&w); } }
    SBAR();
    if (__any(alpha[0] < 1.f || alpha[1] < 1.f)) {
#pragma unroll
      for (int qb = 0; qb < 2; ++qb) { float ar[4]; rows4(alpha[qb], g, ar);
#pragma unroll
        for (int cb = 0; cb < 16; ++cb)
#pragma unroll
          for (int e = 0; e < 4; ++e) o[qb][cb][e] *= ar[e]; } }
    if (!grpB) PV_TILE(vc);
    B3_SYNC();
    vp = vc; vc = vn; vn = (vn == 2) ? 0 : vn + 1;
  }
  if (grpB) PV_TILE(vp);
#if defined(ATT_PRIO)
  __builtin_amdgcn_s_setprio(0);
#endif
  { int t2 = threadIdx.x; asm volatile("" : "+v"(t2));
    const int wid2 = t2 >> 6, c16 = t2 & 15, g2 = (t2 >> 4) & 3;
    bf16* Ow = Ob + (long)(wid2 * 32 + 4 * g2) * LDO + c16;
    float inv[2][4];
#pragma unroll
    for (int qb = 0; qb < 2; ++qb) { float lr[4]; rows4(l_reg[qb], g2, lr);
#pragma unroll
      for (int e = 0; e < 4; ++e) inv[qb][e] = __builtin_amdgcn_rcpf(lr[e]); }
    if constexpr (MODE == 0) {
#pragma unroll
      for (int qb = 0; qb < 2; ++qb)
#pragma unroll
        for (int e = 0; e < 4; ++e)
#pragma unroll
          for (int cb = 0; cb < 16; ++cb) Ow[(long)(qb * 16 + e) * LDO + cb * 16] = (bf16)(cvtpk_b(o[qb][cb][e] * inv[qb][e], 0.f) & 0xffffu);
    } else {
      float sw[16];
#pragma unroll
      for (int cb = 0; cb < 16; ++cb) sw[cb] = subw[cb * 16 + c16] * osc;
      bf16* OAw = OAb + (long)(wid2 * 32 + 4 * g2) * 1024 + c16;
#pragma unroll
      for (int qb = 0; qb < 2; ++qb)
#pragma unroll
        for (int e = 0; e < 4; ++e) { unsigned short of[16];
#pragma unroll
          for (int cb = 0; cb < 16; ++cb) of[cb] = Ow[(long)(qb * 16 + e) * LDO + cb * 16];
          asm volatile("" ::: "memory");
          float dv[16]; float ss = 0.f; const float rl = inv[qb][e] * lam;
#pragma unroll
          for (int cb = 0; cb < 16; ++cb) { dv[cb] = __uint_as_float(((unsigned)of[cb]) << 16) - o[qb][cb][e] * rl; ss += dv[cb] * dv[cb]; }
#pragma unroll
          for (int sh = 1; sh < 16; sh <<= 1) ss += __shfl_xor(ss, sh);
          const float rs = __builtin_amdgcn_rsqf(ss * (1.0f / 256.0f) + eps);
#pragma unroll
          for (int cb = 0; cb < 16; ++cb) OAw[(long)(qb * 16 + e) * 1024 + cb * 16] = (bf16)(cvtpk_b(dv[cb] * rs * sw[cb], 0.f) & 0xffffu);
          asm volatile("" ::: "memory"); }
    } }
  B3_SYNC();
#undef B3_DMA
#undef B3_SYNC
#undef B3_WAITL
#undef VOFF
#undef PV_RD
#undef PKB
#undef PV_MM
#undef PV_STEP
#undef PV_TILE
}

__device__ __forceinline__ void na_unit(const bf16* __restrict__ QKV, bf16* __restrict__ ON, const float* __restrict__ rpb, int b, int h, int rblk, char* lds) {
  constexpr float C = SCALE * 1.4426950408889634f, L2E = 1.4426950408889634f;
  const int tid = threadIdx.x, wid = tid >> 6, lane = tid & 63, r32 = lane & 31, hi = lane >> 5;
  bf16* V_lds = (bf16*)lds; bf16* K_lds = (bf16*)(lds + 2 * SHM_V);
  float* wsf = (float*)(lds + 2 * SHM_V + 2 * SHM_K) + wid * 64; float* li_l = wsf; float* al_l = wsf + 32;
  float* biasL = (float*)(lds + 2 * SHM_V + 2 * SHM_K + NW * 64 * 4);
  const int r = rblk * 4 + (wid >> 1), c = (wid & 1) * 32 + r32;
  const int rs = min(max(r - 4, 0), 120), cs = min(max(c - 8, 0), 48);
  bf16x8 qr[8];
  const bf16* const hb = QKV + ((long)b * 48 + h) * 8192 * 128;
  { const bf16* Qw = hb + (24L * 8192 + r * 64 + c) * 128 + hi * 8;
#pragma unroll
    for (int d0 = 0; d0 < 8; ++d0) qr[d0] = *reinterpret_cast<const bf16x8*>(Qw + d0 * 16); }
  for (int idx = tid; idx < 15 * 32; idx += 512) { const int dr = idx >> 5, dc = idx & 31; biasL[idx] = dc < 31 ? rpb[(h * 15 + dr) * 31 + dc] * L2E : 0.f; }
  const int kr_lo = min(max(rblk * 4 - 4, 0), 120), kr_hi = min(max(rblk * 4 + 3 - 4, 0), 120) + 7;
  const int sr = tid >> 4, sc = (tid & 15) * 8, vst0 = v_st(sr, sc), vst1 = v_st(32 + sr, sc);
  const int vb0 = (int)(uintptr_t)V_lds + v_rd_base(lane);
  float m_reg = -1e30f, l_reg = 0.f; f32x16 o[4] = {};
  const bf16* kp = hb + (32L * 8192 + kr_lo * 64 + sr) * 128 + sc;
  bf16x8 k0 = *reinterpret_cast<const bf16x8*>(kp), k1 = *reinterpret_cast<const bf16x8*>(kp + 32 * 128);
  bf16x8 v0 = *reinterpret_cast<const bf16x8*>(kp + 8L * 8192 * 128), v1 = *reinterpret_cast<const bf16x8*>(kp + 8L * 8192 * 128 + 32 * 128);
  for (int kr = kr_lo; kr <= kr_hi; ++kr) {
    const int bo = ((kr - kr_lo) & 1) * (int)SHM_V;
    *(bf16x8*)((char*)K_lds + bo + KSWZ(sr, sc * 2)) = k0; *(bf16x8*)((char*)K_lds + bo + KSWZ(32 + sr, sc * 2)) = k1;
    *(bf16x8*)((char*)V_lds + bo + vst0) = v0; *(bf16x8*)((char*)V_lds + bo + vst1) = v1;
    __syncthreads();
    if (kr < kr_hi) { kp += 64 * 128;
      k0 = *reinterpret_cast<const bf16x8*>(kp); k1 = *reinterpret_cast<const bf16x8*>(kp + 32 * 128);
      v0 = *reinterpret_cast<const bf16x8*>(kp + 8L * 8192 * 128); v1 = *reinterpret_cast<const bf16x8*>(kp + 8L * 8192 * 128 + 32 * 128); }
    if (kr >= rs && kr < rs + 8) {
      f32x16 p0, p1; qkt(p0, p1, (const bf16*)((const char*)K_lds + bo), qr, r32, hi);
      const float* bl = biasL + (kr - r + 7) * 32;
      float pmax = -INFINITY;
#pragma unroll
      for (int rr = 0; rr < 16; ++rr) { const int kc0 = crow(rr, hi), kc1 = kc0 + 32;
        const bool ok0 = (unsigned)(kc0 - cs) < 16u, ok1 = (unsigned)(kc1 - cs) < 16u;
        const float b0 = bl[ok0 ? kc0 - c + 15 : 0], b1 = bl[ok1 ? kc1 - c + 15 : 0];
        p0[rr] = ok0 ? fmaf(p0[rr], C, b0) : -INFINITY; p1[rr] = ok1 ? fmaf(p1[rr], C, b1) : -INFINITY;
        pmax = fmaxf(pmax, fmaxf(p0[rr], p1[rr])); }
      { auto t = __builtin_amdgcn_permlane32_swap(__float_as_uint(pmax), __float_as_uint(pmax), false, false);
        pmax = fmaxf(__uint_as_float(t[0]), __uint_as_float(t[1])); }
      const bool grow = !__all(pmax - m_reg <= 11.5f);
      float alpha = 1.f;
      if (grow) { const float mn = fmaxf(m_reg, pmax); alpha = __builtin_amdgcn_exp2f(m_reg - mn); m_reg = mn; }
      float ps = 0.f;
#pragma unroll
      for (int rr = 0; rr < 16; ++rr) { p0[rr] = __builtin_amdgcn_exp2f(p0[rr] - m_reg); p1[rr] = __builtin_amdgcn_exp2f(p1[rr] - m_reg); ps += p0[rr] + p1[rr]; }
      { auto t = __builtin_amdgcn_permlane32_swap(__float_as_uint(ps), __float_as_uint(ps), false, false);
        ps = __uint_as_float(t[0]) + __uint_as_float(t[1]); }
      l_reg = l_reg * alpha + ps;
      if (grow) { if (hi == 0) al_l[r32] = alpha; asm volatile("s_waitcnt lgkmcnt(0)" ::: "memory");
#pragma unroll
        for (int d = 0; d < 4; ++d)
#pragma unroll
          for (int rr = 0; rr < 16; ++rr) o[d][rr] *= al_l[crow(rr, hi)]; }
      bf16x8 pa0, pa1, pa2, pa3;
#define PK4(P, BASE, OUT) do { unsigned a0 = cvtpk(P[BASE + 0], P[BASE + 1]), a1 = cvtpk(P[BASE + 2], P[BASE + 3]);   \
    unsigned b0_ = cvtpk(P[BASE + 4], P[BASE + 5]), b1_ = cvtpk(P[BASE + 6], P[BASE + 7]);                              \
    auto r0 = __builtin_amdgcn_permlane32_swap(a0, b0_, false, false); auto r1 = __builtin_amdgcn_permlane32_swap(a1, b1_, false, false); \
    u32x4 w = {r0[0], r1[0], r0[1], r1[1]}; OUT = *reinterpret_cast<bf16x8*>(&w); } while (0)
      PK4(p0, 0, pa0); PK4(p0, 8, pa1); PK4(p1, 0, pa2); PK4(p1, 8, pa3);
#undef PK4
      pv_d0(o, vb0 + bo, pa0, pa1, pa2, pa3);
    }
  }
  if (hi == 0) li_l[r32] = l_reg; asm volatile("s_waitcnt lgkmcnt(0)" ::: "memory");
  bf16* Ow = ON + ((long)b * 8192 + r * 64 + (wid & 1) * 32) * 1024 + h * 128;
#pragma unroll
  for (int rr = 0; rr < 16; ++rr) { const int orow = crow(rr, hi); const float rl = __builtin_amdgcn_rcpf(li_l[orow]);
#pragma unroll
    for (int d0 = 0; d0 < 4; ++d0) Ow[(long)orow * 1024 + d0 * 32 + r32] = (bf16)(cvtpk(o[d0][rr] * rl, 0.f) & 0xffffu); }
  __syncthreads();
}
}

constexpr int NWAVES = 8;
constexpr int BATCH = 4, SEQ = 8192, DM = 2048, MTOK = BATCH * SEQ, DFF = 8192, NIN = 10240;
constexpr float EPS = 1e-6f;
constexpr size_t MiB = 1u << 20;
constexpr size_t WS_SS = 0;
constexpr size_t WS_ROPE = 0;
constexpr size_t WS_CTL = 4 * MiB, CTL_ZERO_BYTES = 262144, WS_CNT = WS_CTL + 65536;
constexpr size_t WS_WIN = 8 * MiB, WS_WA = 48 * MiB, WS_WB = 52 * MiB, WS_WOUT = 56 * MiB, WS_WUP = 64 * MiB, WS_WDN = 96 * MiB;
constexpr size_t WS_H1 = 128 * MiB;
constexpr size_t WS_ON = 128 * MiB, WS_OA = 192 * MiB, WS_H2 = 128 * MiB;
constexpr size_t WS_QKV = 256 * MiB;
constexpr size_t WS_T = 256 * MiB, WS_MX = 512 * MiB, WS_U = 256 * MiB;
constexpr size_t WS_G = 640 * MiB;
constexpr size_t WS_OD = 896 * MiB;
constexpr size_t WS_Y = 896 * MiB;
constexpr size_t WS_Y2 = 768 * MiB;
constexpr size_t WS_END = 1024 * MiB;
constexpr int LDS_BYTES = 147456, MISC_OFF = 131072 + 320;

typedef unsigned short bf16;
typedef float f32x4 __attribute__((ext_vector_type(4)));
typedef unsigned u32x4v __attribute__((ext_vector_type(4)));
typedef unsigned u32x2v __attribute__((ext_vector_type(2)));
#define LAS __attribute__((address_space(3)))
#define LDS_WAIT() asm volatile("s_waitcnt lgkmcnt(0)" ::: "memory")

__device__ __forceinline__ unsigned pk2(float lo, float hi) { return pg8::cvt_pk_bf16(lo, hi); }
__device__ __forceinline__ float wave_sum(float v) {
#pragma unroll
    for (int o = 1; o < 64; o <<= 1) v += __shfl_xor(v, o);
    return v;
}
template <bool ROPE> __device__ __forceinline__ void p0_transpose_item(const float* W, int K, int N, bf16* WT, LAS float* scr, int item, int lane) {
    const int nblk = N / 32, kb = item / nblk, nb = item % nblk, k0 = 64 * kb, n0 = 32 * nb;
    f32x4 wv[8];
#pragma unroll
    for (int i = 0; i < 8; ++i) wv[i] = *(const f32x4*)(W + (size_t)(k0 + 8 * i + (lane >> 3)) * N + n0 + (lane & 7) * 4);
#pragma unroll
    for (int i = 0; i < 8; ++i) { LAS float* d = scr + (8 * i + (lane >> 3)) * 33 + (lane & 7) * 4; d[0] = wv[i].x; d[1] = wv[i].y; d[2] = wv[i].z; d[3] = wv[i].w; }
    LDS_WAIT(); asm volatile("" ::: "memory");
    const int c = lane & 7;
#pragma unroll
    for (int j = 0; j < 4; ++j) { const int n = (lane >> 3) + 8 * j; const LAS float* s = scr + (8 * c) * 33 + n;
        u32x4v o; o.x = pk2(s[0 * 33], s[1 * 33]); o.y = pk2(s[2 * 33], s[3 * 33]); o.z = pk2(s[4 * 33], s[5 * 33]); o.w = pk2(s[6 * 33], s[7 * 33]);
        int dn = n0 + n;
        if (ROPE && dn < 2048) { const int jj = dn & 127; dn = (dn & ~127) + (jj < 64 ? 2 * jj : 2 * (jj - 64) + 1); }
        *(u32x4v*)(WT + (size_t)dn * K + k0 + 8 * c) = o; }
    LDS_WAIT(); asm volatile("" ::: "memory");
}

#define XB_TMO      128
#define XB_XCNT(j)  (256  + 64 * (j))
#define XB_XSUB(j)  (1280 + 64 * (j))
#define XB_XGEN(j)  (2304 + 64 * (j))
#define XB_TOP      3328
#define XB_TOPGEN   3392
#define XCD_BAR_WORDS 3456
#define XB_SPIN_CAP (1u << 18)

__device__ __forceinline__ unsigned xb_ld(unsigned* p)              { return __hip_atomic_load(p, __ATOMIC_RELAXED, __HIP_MEMORY_SCOPE_AGENT); }
__device__ __forceinline__ unsigned xb_add(unsigned* p, unsigned v) { return __hip_atomic_fetch_add(p, v, __ATOMIC_RELAXED, __HIP_MEMORY_SCOPE_AGENT); }
__device__ __forceinline__ unsigned xb_xcc_id() { return (unsigned)__builtin_amdgcn_s_getreg((3 << 11) | 20) & 0xFu; }
#define XB_SPIN(cond, bar) do { unsigned _sp = 0; while (cond) { __builtin_amdgcn_s_sleep(1); \
    if ((++_sp & 255u) == 0u) { if (xb_ld(&(bar)[XB_TMO])) break; if (_sp > XB_SPIN_CAP) { atomicAdd(&(bar)[XB_TMO], 1u); break; } } } } while (0)

struct XcdBarrier {
    unsigned* bar; unsigned x;
    volatile LAS unsigned* st;
};

__device__ __forceinline__ XcdBarrier xcd_barrier_post(unsigned* bar, volatile LAS unsigned* st) {
    XcdBarrier b; b.bar = bar; b.x = xb_xcc_id(); b.st = st;
    if (threadIdx.x == 0) (void)xb_add(&bar[XB_XCNT(b.x)], 1u);
    return b;
}
__device__ __forceinline__ void xcd_barrier_complete(unsigned* bar, unsigned x, unsigned& nloc, unsigned& nx) {
    const unsigned G = gridDim.x * gridDim.y * gridDim.z;
    unsigned sum, cnt, mine, sp = 0u;
    for (;;) {
        sum = 0u; cnt = 0u; mine = 0u;
#pragma unroll
        for (unsigned j = 0; j < 16; ++j) { const unsigned c = xb_ld(&bar[XB_XCNT(j)]); sum += c; cnt += (c > 0u) ? 1u : 0u; mine = (j == x) ? c : mine; }
        if (sum == G) break;
        __builtin_amdgcn_s_sleep(1);
        if ((++sp & 255u) == 0u) { if (xb_ld(&bar[XB_TMO])) break; if (sp > XB_SPIN_CAP) { atomicAdd(&bar[XB_TMO], 1u); break; } }
    }
    nloc = mine > 0u ? mine : 1u; nx = cnt > 0u ? cnt : 1u;
}

__device__ __forceinline__ void xcd_barrier(const XcdBarrier& b) {
    asm volatile("s_waitcnt vmcnt(0)" ::: "memory");
    __syncthreads();
    if (threadIdx.x == 0) {
        unsigned* bar = b.bar;
        __builtin_amdgcn_s_waitcnt(0);
        unsigned nloc = b.st[0], nx = b.st[1];
        if (nloc == 0u) { xcd_barrier_complete(bar, b.x, nloc, nx); b.st[0] = nloc; b.st[1] = nx; }
        const unsigned old = xb_add(&bar[XB_XSUB(b.x)], 1u);
        const unsigned gen = old / nloc;
        if (old + 1u == (gen + 1u) * nloc) {
            __builtin_amdgcn_fence(__ATOMIC_RELEASE, "agent");
            asm volatile("s_waitcnt vmcnt(0)" ::: "memory");
            const unsigned og = xb_add(&bar[XB_TOP], 1u);
            const unsigned tg = og / nx;
            if (og + 1u == (tg + 1u) * nx) xb_add(&bar[XB_TOPGEN], 1u);
            else XB_SPIN(xb_ld(&bar[XB_TOPGEN]) == tg, bar);
            __builtin_amdgcn_fence(__ATOMIC_ACQUIRE, "agent");
            xb_add(&bar[XB_XGEN(b.x)], 1u);
            asm volatile("s_waitcnt vmcnt(0)" ::: "memory");
        } else {
            XB_SPIN(xb_ld(&bar[XB_XGEN(b.x)]) == gen, bar);
            __builtin_amdgcn_fence(__ATOMIC_ACQUIRE, "agent");
            asm volatile("s_waitcnt vmcnt(0)" ::: "memory");
        }
    }
    __syncthreads();
}

#ifndef REP_OTHERS
#define REP_OTHERS 1
#endif
#if defined(ATT_MFMA32)
#define ATT_UNIT attn256_unit
#else
#define ATT_UNIT attn256_unit16
#endif
struct Args { const float* in[17]; float* out; unsigned char* ws; int ph_lo, ph_hi; };

__global__ void __launch_bounds__(NWAVES * 64, 2) mk_fwd(Args a) {
    extern __shared__ __attribute__((aligned(16))) unsigned char lds[];
    cg::grid_group grid = cg::this_grid();
#define tid ((int)threadIdx.x)
#define lane (tid & 63)
#define wave (__builtin_amdgcn_readfirstlane(tid >> 6))
#define G ((int)gridDim.x)
#define gw ((int)blockIdx.x * NWAVES + wave)
#define NGW (G * NWAVES)
    unsigned char* const ws = a.ws;
#define x_in (a.in[0])
#define out_p (a.out)
#define SS ((float*)(ws + WS_SS))
#define ropeC ((float*)(ws + WS_ROPE))
#define ropeS (ropeC + 8192 * 64)
#define Win_t ((bf16*)(ws + WS_WIN))
#define Wa_t ((bf16*)(ws + WS_WA))
#define Wb_t ((bf16*)(ws + WS_WB))
#define Wout_t ((bf16*)(ws + WS_WOUT))
#define Wup_t ((bf16*)(ws + WS_WUP))
#define Wdn_t ((bf16*)(ws + WS_WDN))
#define H1 ((bf16*)(ws + WS_H1))
#define ONb ((bf16*)(ws + WS_ON))
#define OAb ((bf16*)(ws + WS_OA))
#define H2 ((bf16*)(ws + WS_H2))
#define QKV ((bf16*)(ws + WS_QKV))
#define Tb ((bf16*)(ws + WS_T))
#define MX ((bf16*)(ws + WS_MX))
#define Ub ((bf16*)(ws + WS_U))
#define Gb ((bf16*)(ws + WS_G))
#define OD ((bf16*)(ws + WS_OD))
#define Yb ((bf16*)(ws + WS_Y))
#define Y2 ((bf16*)(ws + WS_Y2))
    const int lo = a.ph_lo, hi = a.ph_hi;
    for (int u = tid; u < (LDS_BYTES - 131072) / 4; u += NWAVES * 64) ((LAS unsigned*)((LAS unsigned char*)lds + 131072))[u] = 0u;
    __syncthreads();
#if defined(INKERNEL_CTL_ZERO)
    if (blockIdx.x == 0) { for (int u = tid; u < XCD_BAR_WORDS; u += NWAVES * 64) __hip_atomic_store((unsigned*)(ws + WS_CTL) + u, 0u, __ATOMIC_RELAXED, __HIP_MEMORY_SCOPE_AGENT); }
    asm volatile("s_waitcnt vmcnt(0)" ::: "memory"); __syncthreads();
    grid.sync();
    XcdBarrier bar = xcd_barrier_post((unsigned*)(ws + WS_CTL), (volatile LAS unsigned*)((LAS unsigned char*)lds + MISC_OFF) + 8);
#else
    XcdBarrier bar = xcd_barrier_post((unsigned*)(ws + WS_CTL), (volatile LAS unsigned*)((LAS unsigned char*)lds + MISC_OFF) + 8);
    grid.sync();
#endif
#ifndef PHMASK
#define PHMASK 0x3ff
#endif
#define IN(k) (((PHMASK >> (k)) & 1) && lo <= (k) && (k) < hi)
#define SEAM(k) do { if (lo <= (k) && (k) + 1 < hi) xcd_barrier(bar); } while (0)

    if (IN(0)) {
        LAS float* scr = (LAS float*)((LAS unsigned char*)lds + wave * 16384);
        constexpr int I_IN = (DM / 64) * (NIN / 32), I_A = (1024 / 64) * (DM / 32), I_O = (DM / 64) * (DM / 32), I_UP = (DM / 64) * (DFF / 32), I_DN = (DFF / 64) * (DM / 32);
        constexpr int NITEMS = I_IN + 2 * I_A + I_O + I_UP + I_DN;
        for (int it = gw; it < NITEMS; it += NGW) {
            int r = it;
            if (r < I_IN) { p0_transpose_item<true>(a.in[1], DM, NIN, Win_t, scr, r, lane); continue; } r -= I_IN;
            if (r < I_A) { p0_transpose_item<false>(a.in[2], 1024, DM, Wa_t, scr, r, lane); continue; } r -= I_A;
            if (r < I_A) { p0_transpose_item<false>(a.in[3], 1024, DM, Wb_t, scr, r, lane); continue; } r -= I_A;
            if (r < I_O) { p0_transpose_item<false>(a.in[4], DM, DM, Wout_t, scr, r, lane); continue; } r -= I_O;
            if (r < I_UP) { p0_transpose_item<false>(a.in[15], DM, DFF, Wup_t, scr, r, lane); continue; } r -= I_UP;
            p0_transpose_item<false>(a.in[16], DFF, DM, Wdn_t, scr, r, lane);
        }
        for (int e = blockIdx.x * 512 + tid; e < 8192 * 64; e += G * 512) {
            const int pos = e >> 6, i = e & 63;
            const float inv = (float)exp(-(double)i * (9.210340371976184 / 64.0));
            const float ang = (float)pos * inv;
            const double t = (double)ang * 0.15915494309189535; const float fr = (float)(t - rint(t));
            ropeC[e] = __builtin_amdgcn_cosf(fr); ropeS[e] = __builtin_amdgcn_sinf(fr);
        }
        const float* g0 = a.in[5];
        f32x4 g0v[8];
#pragma unroll
        for (int j = 0; j < 8; ++j) g0v[j] = ((const f32x4*)g0)[lane + 64 * j];
        for (int m0 = gw; m0 < MTOK; m0 += 2 * NGW) {
            f32x4 v[2][8]; float s[2] = {0.f, 0.f};
#pragma unroll
            for (int q = 0; q < 2; ++q) { const f32x4* xr = (const f32x4*)(x_in + (size_t)(m0 + q * NGW) * DM) + lane;
#pragma unroll
                for (int j = 0; j < 8; ++j) v[q][j] = xr[64 * j]; }
#pragma unroll
            for (int q = 0; q < 2; ++q)
#pragma unroll
                for (int j = 0; j < 8; ++j) s[q] += (v[q][j].x * v[q][j].x + v[q][j].y * v[q][j].y) + (v[q][j].z * v[q][j].z + v[q][j].w * v[q][j].w);
#pragma unroll
            for (int q = 0; q < 2; ++q) { const float rstd = __builtin_amdgcn_rsqf(wave_sum(s[q]) * (1.f / DM) + EPS);
                u32x2v* o8 = (u32x2v*)(H1 + (size_t)(m0 + q * NGW) * DM) + lane;
#pragma unroll
                for (int j = 0; j < 8; ++j) { const f32x4 gv = g0v[j]; u32x2v w; w.x = pk2(v[q][j].x * rstd * gv.x, v[q][j].y * rstd * gv.y); w.y = pk2(v[q][j].z * rstd * gv.z, v[q][j].w * rstd * gv.w); o8[64 * j] = w; } }
        }
    }
#if defined(REP_P0)
    __syncthreads();
    if (IN(0)) {
        LAS float* scr = (LAS float*)((LAS unsigned char*)lds + wave * 16384);
        constexpr int I_IN = (DM / 64) * (NIN / 32), I_A = (1024 / 64) * (DM / 32), I_O = (DM / 64) * (DM / 32), I_UP = (DM / 64) * (DFF / 32), I_DN = (DFF / 64) * (DM / 32);
        constexpr int NITEMS = I_IN + 2 * I_A + I_O + I_UP + I_DN;
        for (int it = gw; it < NITEMS; it += NGW) {
            int r = it;
            if (r < I_IN) { p0_transpose_item<true>(a.in[1], DM, NIN, Win_t, scr, r, lane); continue; } r -= I_IN;
            if (r < I_A) { p0_transpose_item<false>(a.in[2], 1024, DM, Wa_t, scr, r, lane); continue; } r -= I_A;
            if (r < I_A) { p0_transpose_item<false>(a.in[3], 1024, DM, Wb_t, scr, r, lane); continue; } r -= I_A;
            if (r < I_O) { p0_transpose_item<false>(a.in[4], DM, DM, Wout_t, scr, r, lane); continue; } r -= I_O;
            if (r < I_UP) { p0_transpose_item<false>(a.in[15], DM, DFF, Wup_t, scr, r, lane); continue; } r -= I_UP;
            p0_transpose_item<false>(a.in[16], DFF, DM, Wdn_t, scr, r, lane);
        }
        for (int e = blockIdx.x * 512 + tid; e < 8192 * 64; e += G * 512) {
            const int pos = e >> 6, i = e & 63;
            const float inv = (float)exp(-(double)i * (9.210340371976184 / 64.0));
            const float ang = (float)pos * inv;
            const double t = (double)ang * 0.15915494309189535; const float fr = (float)(t - rint(t));
            ropeC[e] = __builtin_amdgcn_cosf(fr); ropeS[e] = __builtin_amdgcn_sinf(fr);
        }
        const float* g0 = a.in[5];
        f32x4 g0v[8];
#pragma unroll
        for (int j = 0; j < 8; ++j) g0v[j] = ((const f32x4*)g0)[lane + 64 * j];
        for (int m0 = gw; m0 < MTOK; m0 += 2 * NGW) {
            f32x4 v[2][8]; float s[2] = {0.f, 0.f};
#pragma unroll
            for (int q = 0; q < 2; ++q) { const f32x4* xr = (const f32x4*)(x_in + (size_t)(m0 + q * NGW) * DM) + lane;
#pragma unroll
                for (int j = 0; j < 8; ++j) v[q][j] = xr[64 * j]; }
#pragma unroll
            for (int q = 0; q < 2; ++q)
#pragma unroll
                for (int j = 0; j < 8; ++j) s[q] += (v[q][j].x * v[q][j].x + v[q][j].y * v[q][j].y) + (v[q][j].z * v[q][j].z + v[q][j].w * v[q][j].w);
#pragma unroll
            for (int q = 0; q < 2; ++q) { const float rstd = __builtin_amdgcn_rsqf(wave_sum(s[q]) * (1.f / DM) + EPS);
                u32x2v* o8 = (u32x2v*)(H1 + (size_t)(m0 + q * NGW) * DM) + lane;
#pragma unroll
                for (int j = 0; j < 8; ++j) { const f32x4 gv = g0v[j]; u32x2v w; w.x = pk2(v[q][j].x * rstd * gv.x, v[q][j].y * rstd * gv.y); w.y = pk2(v[q][j].z * rstd * gv.z, v[q][j].w * rstd * gv.w); o8[64 * j] = w; } }
        }
    }
#endif
    SEAM(0);
#if defined(REP_BAR)
    for (int rb = 0; rb < 20; ++rb) xcd_barrier(bar);
#endif
    if (IN(1)) {
#if defined(STAGGER_US)
        { const unsigned long long t0_ = __builtin_amdgcn_s_memrealtime(), dt_ = (unsigned long long)(((blockIdx.x >> 3) & 15) * (STAGGER_US * 100 / 16));
          while (__builtin_amdgcn_s_memrealtime() - t0_ < dt_) __builtin_amdgcn_s_sleep(8); }
#endif
        pg8::Gemm g{H1, Win_t, MTOK, NIN, DM}; pg8::StaticOrder S; S.init(MTOK, NIN, G, (int)blockIdx.x);
        pg8::EpiProj E{QKV, Gb, ropeC, ropeS};
        pg8::gemm_phase<pg8::EpiProj, pg8::StaticOrder, true, true>((LAS unsigned char*)lds, g, S, E);
    }
#if defined(REP_P1)
    __syncthreads();
    if (IN(1)) {
        pg8::Gemm g{H1, Win_t, MTOK, NIN, DM}; pg8::StaticOrder S; S.init(MTOK, NIN, G, (int)blockIdx.x);
        pg8::EpiProj E{QKV, Gb, ropeC, ropeS};
        pg8::gemm_phase<pg8::EpiProj, pg8::StaticOrder, true, true>((LAS unsigned char*)lds, g, S, E);
    }
#endif
    SEAM(1);
#if defined(DBG_STOP)
#define DBG_DUMP(k, off_mib, nseg) do { if (DBG_STOP == (k)) { xcd_barrier(bar); const bf16* rg = (const bf16*)(ws + (size_t)(off_mib) * MiB); \
        for (size_t i = (size_t)blockIdx.x * 512 + tid; i < (size_t)MTOK * DM; i += (size_t)G * 512) { float acc_ = 0.f; for (int sg = 0; sg < (nseg); ++sg) acc_ += __uint_as_float(((unsigned)rg[i + (size_t)sg * MTOK * DM]) << 16); out_p[i] = acc_; } return; } } while (0)
#else
#define DBG_DUMP(k, off_mib, nseg) do { } while (0)
#endif
    DBG_DUMP(1, 256, 5);
    DBG_DUMP(11, 256, 3);
    DBG_DUMP(12, 640, 2);
    if (IN(2)) {
#if !defined(ATT_D128X4)
        { int ntl = SEQ / 64; asm volatile("" : "+s"(ntl));
        const float s1_ = wave_sum(a.in[9][lane] * a.in[10][lane] + a.in[9][lane + 64] * a.in[10][lane + 64]);
        const float s2_ = wave_sum(a.in[11][lane] * a.in[12][lane] + a.in[11][lane + 64] * a.in[12][lane + 64]);
        const float lam_ = __uint_as_float(__builtin_amdgcn_readfirstlane(__float_as_uint(__builtin_amdgcn_exp2f(s1_ * 1.4426950408889634f) - __builtin_amdgcn_exp2f(s2_ * 1.4426950408889634f) + 0.2f)));
        for (int u = blockIdx.x; u < 512; u += G) {
            const int xs = u & 7, qb = (u >> 3) & 31, combo = (u >> 8) * 8 + xs, b = combo >> 2, h = combo & 3;
            const bf16* base = QKV + (size_t)b * 48 * SEQ * 128; bf16* odp = OD + ((size_t)b * SEQ + qb * 256) * 2048 + h * 512; bf16* oap = OAb + ((size_t)b * SEQ + qb * 256) * 1024 + h * 256;
            att::ATT_UNIT<0>(base + ((size_t)(2 * h) * SEQ + qb * 256) * 128, base + (size_t)(8 + 2 * h) * SEQ * 128, base + (size_t)(16 + 2 * h) * SEQ * 128, base + (size_t)(17 + 2 * h) * SEQ * 128,
                                 odp, ntl, (char*)lds, (LAS unsigned char*)lds, oap, a.in[13], lam_, EPS, 0.8f);
            att::ATT_UNIT<1>(base + ((size_t)(2 * h + 1) * SEQ + qb * 256) * 128, base + (size_t)(9 + 2 * h) * SEQ * 128, base + (size_t)(16 + 2 * h) * SEQ * 128, base + (size_t)(17 + 2 * h) * SEQ * 128,
                                 odp, ntl, (char*)lds, (LAS unsigned char*)lds, oap, a.in[13], lam_, EPS, 0.8f);
        }
#if defined(REP_ATT)
        for (int u = blockIdx.x; u < 512; u += G) {
            const int xs = u & 7, qb = (u >> 3) & 31, combo = (u >> 8) * 8 + xs, b = combo >> 2, h = combo & 3;
            const bf16* base = QKV + (size_t)b * 48 * SEQ * 128; bf16* odp = OD + ((size_t)b * SEQ + qb * 256) * 2048 + h * 512; bf16* oap = OAb + ((size_t)b * SEQ + qb * 256) * 1024 + h * 256;
            att::ATT_UNIT<0>(base + ((size_t)(2 * h) * SEQ + qb * 256) * 128, base + (size_t)(8 + 2 * h) * SEQ * 128, base + (size_t)(16 + 2 * h) * SEQ * 128, base + (size_t)(17 + 2 * h) * SEQ * 128,
                                 odp, ntl, (char*)lds, (LAS unsigned char*)lds, oap, a.in[13], lam_, EPS, 0.8f);
            att::ATT_UNIT<1>(base + ((size_t)(2 * h + 1) * SEQ + qb * 256) * 128, base + (size_t)(9 + 2 * h) * SEQ * 128, base + (size_t)(16 + 2 * h) * SEQ * 128, base + (size_t)(17 + 2 * h) * SEQ * 128,
                                 odp, ntl, (char*)lds, (LAS unsigned char*)lds, oap, a.in[13], lam_, EPS, 0.8f);
        }
#endif
        }
#else
#ifndef NO_DENSE
        int seqv = SEQ; asm volatile("" : "+s"(seqv));
        for (int u = blockIdx.x; u < 2048; u += G) {
            const int xs = u & 7, qb = (u >> 3) & 31, combo = (u >> 8) * 8 + xs, b = combo >> 4, vh = combo & 15, h = vh >> 2, c = (vh >> 1) & 1, hf = vh & 1;
            const bf16* base = QKV + (size_t)b * 48 * SEQ * 128;
            att::attn_dense_body<bf16>(base + ((size_t)(h * 2 + c) * SEQ + qb * 256) * 128, base + (size_t)(8 + h * 2 + c) * SEQ * 128, base + (size_t)(16 + h * 2 + hf) * SEQ * 128,
                                       OD + ((size_t)b * SEQ + qb * 256) * 2048 + vh * 128, seqv, (char*)lds);
            __syncthreads();
        }
#if defined(REP_DENSE)
        int seqv2 = SEQ; asm volatile("" : "+s"(seqv2));
        for (int u = blockIdx.x; u < 2048; u += G) {
            const int xs = u & 7, qb = (u >> 3) & 31, combo = (u >> 8) * 8 + xs, b = combo >> 4, vh = combo & 15, h = vh >> 2, c = (vh >> 1) & 1, hf = vh & 1;
            const bf16* base = QKV + (size_t)b * 48 * SEQ * 128;
            att::attn_dense_body<bf16>(base + ((size_t)(h * 2 + c) * SEQ + qb * 256) * 128, base + (size_t)(8 + h * 2 + c) * SEQ * 128, base + (size_t)(16 + h * 2 + hf) * SEQ * 128,
                                       OD + ((size_t)b * SEQ + qb * 256) * 2048 + vh * 128, seqv2, (char*)lds);
            __syncthreads();
        }
#endif
#endif
#endif
#ifndef NO_NA
            for (int u = blockIdx.x; u < 1024; u += G) {
            const int xs = u & 7, rb = (u >> 3) & 31, combo = (u >> 8) * 8 + xs, b = combo >> 3, h = combo & 7;
            att::na_unit(QKV, ONb, a.in[14], b, h, rb, (char*)lds);
        }
#if defined(REP_NA)
            for (int u = blockIdx.x; u < 1024; u += G) {
            const int xs = u & 7, rb = (u >> 3) & 31, combo = (u >> 8) * 8 + xs, b = combo >> 3, h = combo & 7;
            att::na_unit(QKV, ONb, a.in[14], b, h, rb, (char*)lds);
        }
#endif
#endif
    }
    SEAM(2);
    DBG_DUMP(2, 896, 1);
    DBG_DUMP(22, 128, 1);
#if defined(ATT_D128X4)
    if (IN(3)) {
        const float s1 = wave_sum(a.in[9][lane] * a.in[10][lane] + a.in[9][lane + 64] * a.in[10][lane + 64]);
        const float s2 = wave_sum(a.in[11][lane] * a.in[12][lane] + a.in[11][lane + 64] * a.in[12][lane + 64]);
        const float lam = __builtin_amdgcn_exp2f(s1 * 1.4426950408889634f) - __builtin_amdgcn_exp2f(s2 * 1.4426950408889634f) + 0.2f;
        const f32x4 sw = ((const f32x4*)a.in[13])[lane];
        for (int m = gw; m < MTOK; m += NGW) {
#pragma unroll
            for (int h = 0; h < 4; ++h) {
                const bf16* od = OD + (size_t)m * 2048 + h * 512 + 4 * lane;
                const u32x2v p = *(const u32x2v*)od, q = *(const u32x2v*)(od + 256);
                f32x4 d;
                d.x = __uint_as_float(p.x << 16) - lam * __uint_as_float(q.x << 16); d.y = __uint_as_float(p.x & 0xffff0000u) - lam * __uint_as_float(q.x & 0xffff0000u);
                d.z = __uint_as_float(p.y << 16) - lam * __uint_as_float(q.y << 16); d.w = __uint_as_float(p.y & 0xffff0000u) - lam * __uint_as_float(q.y & 0xffff0000u);
                const float rstd = __builtin_amdgcn_rsqf(wave_sum((d.x * d.x + d.y * d.y) + (d.z * d.z + d.w * d.w)) * (1.f / 256.f) + EPS) * 0.8f;
                u32x2v w; w.x = pk2(d.x * rstd * sw.x, d.y * rstd * sw.y); w.y = pk2(d.z * rstd * sw.z, d.w * rstd * sw.w);
                *(u32x2v*)(OAb + (size_t)m * 1024 + h * 256 + 4 * lane) = w;
            }
        }
    }
#if defined(REP_P3)
    __syncthreads();
    if (IN(3)) {
        const float s1 = wave_sum(a.in[9][lane] * a.in[10][lane] + a.in[9][lane + 64] * a.in[10][lane + 64]);
        const float s2 = wave_sum(a.in[11][lane] * a.in[12][lane] + a.in[11][lane + 64] * a.in[12][lane + 64]);
        const float lam = __builtin_amdgcn_exp2f(s1 * 1.4426950408889634f) - __builtin_amdgcn_exp2f(s2 * 1.4426950408889634f) + 0.2f;
        const f32x4 sw = ((const f32x4*)a.in[13])[lane];
        for (int m = gw; m < MTOK; m += NGW) {
#pragma unroll
            for (int h = 0; h < 4; ++h) {
                const bf16* od = OD + (size_t)m * 2048 + h * 512 + 4 * lane;
                const u32x2v p = *(const u32x2v*)od, q = *(const u32x2v*)(od + 256);
                f32x4 d;
                d.x = __uint_as_float(p.x << 16) - lam * __uint_as_float(q.x << 16); d.y = __uint_as_float(p.x & 0xffff0000u) - lam * __uint_as_float(q.x & 0xffff0000u);
                d.z = __uint_as_float(p.y << 16) - lam * __uint_as_float(q.y << 16); d.w = __uint_as_float(p.y & 0xffff0000u) - lam * __uint_as_float(q.y & 0xffff0000u);
                const float rstd = __builtin_amdgcn_rsqf(wave_sum((d.x * d.x + d.y * d.y) + (d.z * d.z + d.w * d.w)) * (1.f / 256.f) + EPS) * 0.8f;
                u32x2v w; w.x = pk2(d.x * rstd * sw.x, d.y * rstd * sw.y); w.y = pk2(d.z * rstd * sw.z, d.w * rstd * sw.w);
                *(u32x2v*)(OAb + (size_t)m * 1024 + h * 256 + 4 * lane) = w;
            }
        }
    }
#endif
    SEAM(3);
#endif
    DBG_DUMP(3, 128, 1);
    if (IN(4)) {
        { pg8::Gemm g{OAb, Wa_t, MTOK, DM, 1024}; pg8::StaticOrder S; S.init(MTOK, DM, G, (int)blockIdx.x);
          pg8::EpiBranch<0> E{Gb, Tb, MX};
          pg8::gemm_phase<pg8::EpiBranch<0>, pg8::StaticOrder, true, true>((LAS unsigned char*)lds, g, S, E); }
        asm volatile("s_waitcnt vmcnt(0)" ::: "memory"); __syncthreads();
        { pg8::Gemm g{ONb, Wb_t, MTOK, DM, 1024}; pg8::StaticOrder S; S.init(MTOK, DM, G, (int)blockIdx.x);
          pg8::EpiBranch<1> E{Gb, Tb, MX};
          pg8::gemm_phase<pg8::EpiBranch<1>, pg8::StaticOrder, true, true>((LAS unsigned char*)lds, g, S, E); }
    }
#if defined(REP_P4)
    __syncthreads();
    if (IN(4)) {
        { pg8::Gemm g{OAb, Wa_t, MTOK, DM, 1024}; pg8::StaticOrder S; S.init(MTOK, DM, G, (int)blockIdx.x);
          pg8::EpiBranch<0> E{Gb, Tb, MX};
          pg8::gemm_phase<pg8::EpiBranch<0>, pg8::StaticOrder, true, true>((LAS unsigned char*)lds, g, S, E); }
        asm volatile("s_waitcnt vmcnt(0)" ::: "memory"); __syncthreads();
        { pg8::Gemm g{ONb, Wb_t, MTOK, DM, 1024}; pg8::StaticOrder S; S.init(MTOK, DM, G, (int)blockIdx.x);
          pg8::EpiBranch<1> E{Gb, Tb, MX};
          pg8::gemm_phase<pg8::EpiBranch<1>, pg8::StaticOrder, true, true>((LAS unsigned char*)lds, g, S, E); }
    }
#endif
    SEAM(4);
    DBG_DUMP(4, 512, 1);
    DBG_DUMP(41, 256, 2);
    if (IN(5)) {
        pg8::Gemm g{MX, Wout_t, MTOK, DM, DM}; pg8::StaticOrder S; S.init(MTOK, DM, G, (int)blockIdx.x);
        pg8::EpiYss<bf16> E{Yb, SS};
        pg8::gemm_phase<pg8::EpiYss<bf16>, pg8::StaticOrder, true, true>((LAS unsigned char*)lds, g, S, E);
    }
#if defined(REP_P5)
    __syncthreads();
    if (IN(5)) {
        pg8::Gemm g{MX, Wout_t, MTOK, DM, DM}; pg8::StaticOrder S; S.init(MTOK, DM, G, (int)blockIdx.x);
        pg8::EpiYss<bf16> E{Yb, SS};
        pg8::gemm_phase<pg8::EpiYss<bf16>, pg8::StaticOrder, true, true>((LAS unsigned char*)lds, g, S, E);
    }
#endif
    SEAM(5);
    DBG_DUMP(5, 896, 1);
    if (IN(6)) {
        const float* g1 = a.in[6]; const float* g2 = a.in[7];
        f32x4 g1v[8], g2v[8];
#pragma unroll
        for (int j = 0; j < 8; ++j) { g1v[j] = ((const f32x4*)g1)[lane + 64 * j]; g2v[j] = ((const f32x4*)g2)[lane + 64 * j]; }
        for (int m0 = gw; m0 < MTOK; m0 += 2 * NGW) {
            f32x4 v[2][8]; u32x2v yw[2][8]; float ssv[2];
#pragma unroll
            for (int q = 0; q < 2; ++q) { const size_t m = (size_t)(m0 + q * NGW); ssv[q] = lane < 32 ? SS[m * 32 + lane] : 0.f;
                const f32x4* xr = (const f32x4*)(x_in + m * DM) + lane; const u32x2v* yr = (const u32x2v*)(Yb + m * DM) + lane;
#pragma unroll
                for (int j = 0; j < 8; ++j) { v[q][j] = xr[64 * j]; yw[q][j] = yr[64 * j]; } }
#pragma unroll
            for (int q = 0; q < 2; ++q) { const size_t m = (size_t)(m0 + q * NGW);
                const float rstd = __builtin_amdgcn_rsqf(wave_sum(ssv[q]) * (1.f / DM) + EPS); f32x4* orow = (f32x4*)(out_p + m * DM) + lane; float s = 0.f;
#pragma unroll
                for (int j = 0; j < 8; ++j) { const f32x4 gv = g1v[j]; const u32x2v w = yw[q][j];
                    f32x4 y; y.x = __uint_as_float(w.x << 16); y.y = __uint_as_float(w.x & 0xffff0000u); y.z = __uint_as_float(w.y << 16); y.w = __uint_as_float(w.y & 0xffff0000u);
                    v[q][j] = v[q][j] + y * rstd * gv; orow[64 * j] = v[q][j];
                    s += (v[q][j].x * v[q][j].x + v[q][j].y * v[q][j].y) + (v[q][j].z * v[q][j].z + v[q][j].w * v[q][j].w); }
                const float rstd1 = __builtin_amdgcn_rsqf(wave_sum(s) * (1.f / DM) + EPS);
                u32x2v* o8 = (u32x2v*)(H2 + m * DM) + lane;
#pragma unroll
                for (int j = 0; j < 8; ++j) { const f32x4 gv = g2v[j]; u32x2v w; w.x = pk2(v[q][j].x * rstd1 * gv.x, v[q][j].y * rstd1 * gv.y); w.y = pk2(v[q][j].z * rstd1 * gv.z, v[q][j].w * rstd1 * gv.w); o8[64 * j] = w; } }
        }
    }
#if defined(REP_P6)
    __syncthreads();
    if (IN(6)) {
        const float* g1 = a.in[6]; const float* g2 = a.in[7];
        f32x4 g1v[8], g2v[8];
#pragma unroll
        for (int j = 0; j < 8; ++j) { g1v[j] = ((const f32x4*)g1)[lane + 64 * j]; g2v[j] = ((const f32x4*)g2)[lane + 64 * j]; }
        for (int m0 = gw; m0 < MTOK; m0 += 2 * NGW) {
            f32x4 v[2][8]; u32x2v yw[2][8]; float ssv[2];
#pragma unroll
            for (int q = 0; q < 2; ++q) { const size_t m = (size_t)(m0 + q * NGW); ssv[q] = lane < 32 ? SS[m * 32 + lane] : 0.f;
                const f32x4* xr = (const f32x4*)(x_in + m * DM) + lane; const u32x2v* yr = (const u32x2v*)(Yb + m * DM) + lane;
#pragma unroll
                for (int j = 0; j < 8; ++j) { v[q][j] = xr[64 * j]; yw[q][j] = yr[64 * j]; } }
#pragma unroll
            for (int q = 0; q < 2; ++q) { const size_t m = (size_t)(m0 + q * NGW);
                const float rstd = __builtin_amdgcn_rsqf(wave_sum(ssv[q]) * (1.f / DM) + EPS); f32x4* orow = (f32x4*)(out_p + m * DM) + lane; float s = 0.f;
#pragma unroll
                for (int j = 0; j < 8; ++j) { const f32x4 gv = g1v[j]; const u32x2v w = yw[q][j];
                    f32x4 y; y.x = __uint_as_float(w.x << 16); y.y = __uint_as_float(w.x & 0xffff0000u); y.z = __uint_as_float(w.y << 16); y.w = __uint_as_float(w.y & 0xffff0000u);
                    v[q][j] = v[q][j] + y * rstd * gv; orow[64 * j] = v[q][j];
                    s += (v[q][j].x * v[q][j].x + v[q][j].y * v[q][j].y) + (v[q][j].z * v[q][j].z + v[q][j].w * v[q][j].w); }
                const float rstd1 = __builtin_amdgcn_rsqf(wave_sum(s) * (1.f / DM) + EPS);
                u32x2v* o8 = (u32x2v*)(H2 + m * DM) + lane;
#pragma unroll
                for (int j = 0; j < 8; ++j) { const f32x4 gv = g2v[j]; u32x2v w; w.x = pk2(v[q][j].x * rstd1 * gv.x, v[q][j].y * rstd1 * gv.y); w.y = pk2(v[q][j].z * rstd1 * gv.z, v[q][j].w * rstd1 * gv.w); o8[64 * j] = w; } }
        }
    }
#endif
    SEAM(6);
    DBG_DUMP(6, 128, 1);
    if (IN(7)) {
#if defined(STAGGER_US)
        { const unsigned long long t0_ = __builtin_amdgcn_s_memrealtime(), dt_ = (unsigned long long)(((blockIdx.x >> 3) & 15) * (STAGGER_US * 100 / 16));
          while (__builtin_amdgcn_s_memrealtime() - t0_ < dt_) __builtin_amdgcn_s_sleep(8); }
#endif
        pg8::Gemm g{H2, Wup_t, MTOK, DFF, DM}; pg8::StaticOrder S; S.init(MTOK, DFF, G, (int)blockIdx.x);
        pg8::EpiRelu2 E{Ub, DFF};
        pg8::gemm_phase<pg8::EpiRelu2, pg8::StaticOrder, true, true>((LAS unsigned char*)lds, g, S, E);
    }
#if defined(REP_P7)
    __syncthreads();
    if (IN(7)) {
        pg8::Gemm g{H2, Wup_t, MTOK, DFF, DM}; pg8::StaticOrder S; S.init(MTOK, DFF, G, (int)blockIdx.x);
        pg8::EpiRelu2 E{Ub, DFF};
        pg8::gemm_phase<pg8::EpiRelu2, pg8::StaticOrder, true, true>((LAS unsigned char*)lds, g, S, E);
    }
#endif
    SEAM(7);
    DBG_DUMP(7, 256, 4);
    if (IN(8)) {
#if defined(FUSE_P8)
        pg8::Gemm g{Ub, Wdn_t, MTOK, DM, DFF}; pg8::PanelOrder S; S.init((int)blockIdx.x);
        pg8::EpiFinal E{out_p, a.in[8], SS, (unsigned*)(ws + WS_CNT), EPS};
        pg8::gemm_phase<pg8::EpiFinal, pg8::PanelOrder, true, true>((LAS unsigned char*)lds, g, S, E);
#else
        pg8::Gemm g{Ub, Wdn_t, MTOK, DM, DFF}; pg8::StaticOrder S; S.init(MTOK, DM, G, (int)blockIdx.x);
        pg8::EpiYss<bf16> E{Y2, SS};
        pg8::gemm_phase<pg8::EpiYss<bf16>, pg8::StaticOrder, true, true>((LAS unsigned char*)lds, g, S, E);
#endif
    }
#if !defined(FUSE_P8)
    SEAM(8);
    if (IN(9)) {
        const float* g3 = a.in[8];
        f32x4 g3v[8];
#pragma unroll
        for (int j = 0; j < 8; ++j) g3v[j] = ((const f32x4*)g3)[lane + 64 * j];
        for (int m0 = gw; m0 < MTOK; m0 += 2 * NGW) {
            f32x4 v[2][8]; u32x2v yw[2][8]; float ssv[2];
#pragma unroll
            for (int q = 0; q < 2; ++q) { const size_t m = (size_t)(m0 + q * NGW); ssv[q] = lane < 32 ? SS[m * 32 + lane] : 0.f;
                const f32x4* xr = (const f32x4*)(out_p + m * DM) + lane; const u32x2v* yr = (const u32x2v*)(Y2 + m * DM) + lane;
#pragma unroll
                for (int j = 0; j < 8; ++j) { v[q][j] = xr[64 * j]; yw[q][j] = yr[64 * j]; } }
#pragma unroll
            for (int q = 0; q < 2; ++q) { const size_t m = (size_t)(m0 + q * NGW);
                const float rstd = __builtin_amdgcn_rsqf(wave_sum(ssv[q]) * (1.f / DM) + EPS); f32x4* orow = (f32x4*)(out_p + m * DM) + lane;
#pragma unroll
                for (int j = 0; j < 8; ++j) { const f32x4 gv = g3v[j]; const u32x2v w = yw[q][j];
                    f32x4 y; y.x = __uint_as_float(w.x << 16); y.y = __uint_as_float(w.x & 0xffff0000u); y.z = __uint_as_float(w.y << 16); y.w = __uint_as_float(w.y & 0xffff0000u);
                    orow[64 * j] = v[q][j] + y * rstd * gv; } }
        }
    }
#endif
#undef IN
#undef SEAM
#undef tid
#undef lane
#undef wave
#undef G
#undef gw
#undef NGW
}

extern "C" void kernel_launch(void* const* d_in, const int* in_sizes, int n_in, void* d_out, int out_size, void* d_ws, size_t ws_size, hipStream_t stream) {
    static int grid = 0;
    if (grid == 0) {
        if (n_in != 17 || in_sizes[0] != MTOK * DM || out_size != MTOK * DM || ws_size < WS_END) { fprintf(stderr, "kernel_launch: shape/workspace mismatch: n_in %d in0 %d out %d ws %zu (need %zu)\n", n_in, n_in > 0 ? in_sizes[0] : -1, out_size, ws_size, (size_t)WS_END); grid = -1; return; }
        int dev = 0, cus = 0, per_cu = 0;
        (void)hipGetDevice(&dev); (void)hipDeviceGetAttribute(&cus, hipDeviceAttributeMultiprocessorCount, dev);
        if (hipFuncSetAttribute((const void*)mk_fwd, hipFuncAttributeMaxDynamicSharedMemorySize, LDS_BYTES) != hipSuccess) { fprintf(stderr, "kernel_launch: hipFuncSetAttribute failed\n"); grid = -1; return; }
        if (hipOccupancyMaxActiveBlocksPerMultiprocessor(&per_cu, (const void*)mk_fwd, NWAVES * 64, LDS_BYTES) != hipSuccess || per_cu < 1) { fprintf(stderr, "kernel_launch: occupancy query says %d\n", per_cu); per_cu = 1; }
        (void)hipGetLastError();
        grid = cus * per_cu;
        if (grid != 256) fprintf(stderr, "kernel_launch: grid %d != 256: the fused-norm phases need exactly 256 workgroups\n", grid);
        if (grid > 256) grid = 256;
    }
    if (grid < 0) return;
#if !defined(INKERNEL_CTL_ZERO)
    if (hipMemsetAsync((char*)d_ws + WS_CTL, 0, CTL_ZERO_BYTES, stream) != hipSuccess) { fprintf(stderr, "kernel_launch: hipMemsetAsync failed\n"); return; }
#endif
    Args a{};
    for (int i = 0; i < 17; ++i) a.in[i] = (const float*)d_in[i];
    a.out = (float*)d_out; a.ws = (unsigned char*)d_ws; a.ph_lo = 0; a.ph_hi = 10;
    void* args[] = {&a};
    hipError_t e = hipLaunchCooperativeKernel((const void*)mk_fwd, dim3(grid), dim3(NWAVES * 64), args, LDS_BYTES, stream);
    if (e != hipSuccess) fprintf(stderr, "kernel_launch: cooperative launch failed: %s (grid %d)\n", hipGetErrorString(e), grid);
}
```

```cpp
#define EPI_NT
#include <hip/hip_runtime.h>
#include <hip/hip_cooperative_groups.h>
#include <cstdio>
#include <cstdint>
#include <cmath>
namespace cg = cooperative_groups;
namespace pg8 {
#define PG8_LAS __attribute__((address_space(3)))
typedef unsigned short bf16_t;
typedef short bf16x8 __attribute__((ext_vector_type(8)));
typedef float f32x4 __attribute__((ext_vector_type(4)));
typedef unsigned u32x4 __attribute__((ext_vector_type(4)));
constexpr int BM = 256, BK = 64, HALF = 128, HTB = HALF * BK * 2  , STAGE_BYTES = 8 * HTB, NXCD = 8, WGM = 8;

__host__ __device__ __forceinline__ int lds_byte(int r, int c) { const int st = (r >> 4) * 2 + (c >> 5), rr = r & 15, cc = c & 31, ob = rr * 64 + cc * 2; return st * 1024 + (ob ^ (((ob >> 9) & 1) << 5)); }
__host__ __device__ __forceinline__ void stage_rc(int b, int& R, int& C) { const int st = b / 1024, sb = b % 1024, swz = sb ^ (((sb >> 9) & 1) << 5); R = (st >> 1) * 16 + swz / 64; C = (st & 1) * 32 + (swz % 64) / 2; }
__host__ __device__ __forceinline__ int perm32(int rho) { const int n = rho >> 4, i = rho & 15; return 8 * (i >> 2) + 4 * n + (i & 3); }

struct Unit { int pm, pn; };
struct Gemm { const bf16_t* A; const bf16_t* Bt; int M, N, K; };

struct StaticOrder {
    int nM, nN, nwg, G, c;
    __host__ __device__ void init(int M, int N, int G_, int c_) { nM = M / BM; nN = N / BM; nwg = nM * nN; G = G_; c = c_; }
    __host__ __device__ bool next(int i, Unit& u) const {
        const long L = (long)i * G + c; if (L >= nwg) return false;
        int wgid = (int)L; { const int q = nwg / NXCD, r = nwg % NXCD, xcd = wgid % NXCD, off = wgid / NXCD; wgid = (xcd < r ? xcd * (q + 1) : r * (q + 1) + (xcd - r) * q) + off; }
        const int nig = WGM * nN, gid = wgid / nig, fm = gid * WGM, gsz = (nM - fm) < WGM ? (nM - fm) : WGM;
        u.pm = fm + ((wgid % nig) % gsz); u.pn = (wgid % nig) / gsz; return true;
    }
    __device__ __forceinline__ void a_ready(const Unit&) const {}
    __device__ __forceinline__ void done(const Unit&) const {}
};

typedef __bf16 bf16x2_t __attribute__((ext_vector_type(2))); typedef float f32x2_t __attribute__((ext_vector_type(2)));
__device__ __forceinline__ unsigned cvt_pk_bf16(float lo, float hi) { f32x2_t v = {lo, hi}; bf16x2_t b = __builtin_convertvector(v, bf16x2_t); return __builtin_bit_cast(unsigned, b); }
__device__ __forceinline__ float bf2f(unsigned short b) { return __uint_as_float(((unsigned)b) << 16); }
__device__ __forceinline__ void unpack8(const u32x4 w, float (&f)[8]) {
    f[0] = __uint_as_float(w.x << 16); f[1] = __uint_as_float(w.x & 0xffff0000u); f[2] = __uint_as_float(w.y << 16); f[3] = __uint_as_float(w.y & 0xffff0000u);
    f[4] = __uint_as_float(w.z << 16); f[5] = __uint_as_float(w.z & 0xffff0000u); f[6] = __uint_as_float(w.w << 16); f[7] = __uint_as_float(w.w & 0xffff0000u);
}
__device__ __forceinline__ u32x4 pack8(const f32x4 v0, const f32x4 v1) { u32x4 w; w.x = cvt_pk_bf16(v0[0], v0[1]); w.y = cvt_pk_bf16(v0[2], v0[3]); w.z = cvt_pk_bf16(v1[0], v1[1]); w.w = cvt_pk_bf16(v1[2], v1[3]); return w; }
__device__ __forceinline__ float sigmoidf_(float v) { return __builtin_amdgcn_rcpf(1.0f + __builtin_amdgcn_exp2f(-1.4426950408889634f * v)); }

#if defined(EPI_NT)
#define EPI_ST(p, v) __builtin_nontemporal_store((v), (p))
#else
#define EPI_ST(p, v) (*(p) = (v))
#endif
struct EpiProj {
    static constexpr bool PERM = true, AFTER_DRAIN = false;
    bf16_t* QKV; bf16_t* G; const float* ropeC; const float* ropeS;
    __device__ __forceinline__ void operator()(const f32x4 (&acc)[2][2][4][2], const Unit& u, int wr, int wc, int fr, int fq) const {
        const int row0 = u.pm * BM + wr * 64 + fr, colt = u.pn * BM, cl = wc * 32 + 8 * fq;
        if (colt < 2048) {
            const int i0 = 16 * wc + 4 * fq;
            f32x4 cc[2][4], sn[2][4];
#pragma unroll
            for (int ai = 0; ai < 2; ++ai)
#pragma unroll
                for (int m = 0; m < 4; ++m) { const int pos = (row0 + ai * HALF + m * 16) & 8191;
                    cc[ai][m] = *(const f32x4*)(ropeC + (size_t)pos * 64 + i0); sn[ai][m] = *(const f32x4*)(ropeS + (size_t)pos * 64 + i0); }
            asm volatile("" ::: "memory");
#pragma unroll
            for (int ai = 0; ai < 2; ++ai)
#pragma unroll
                for (int m = 0; m < 4; ++m) { const int row = row0 + ai * HALF + m * 16, pos = row & 8191;
                    const f32x4 c = cc[ai][m], s = sn[ai][m];
                    bf16_t* rowp = QKV + (((size_t)(row >> 13) * 48 + (colt >> 7)) * 8192 + pos) * 128 + cl;
#pragma unroll
                    for (int bj = 0; bj < 2; ++bj) { const f32x4 v0 = acc[ai][bj][m][0], v1 = acc[ai][bj][m][1]; f32x4 o0, o1;
                        o0[0] = v0[0] * c[0] - v0[1] * s[0]; o0[1] = v0[1] * c[0] + v0[0] * s[0]; o0[2] = v0[2] * c[1] - v0[3] * s[1]; o0[3] = v0[3] * c[1] + v0[2] * s[1];
                        o1[0] = v1[0] * c[2] - v1[1] * s[2]; o1[1] = v1[1] * c[2] + v1[0] * s[2]; o1[2] = v1[2] * c[3] - v1[3] * s[3]; o1[3] = v1[3] * c[3] + v1[2] * s[3];
                        EPI_ST((u32x4*)(rowp + (size_t)bj * 8192 * 128), pack8(o0, o1)); } }
        } else if (colt < 6144) {
#pragma unroll
            for (int ai = 0; ai < 2; ++ai)
#pragma unroll
                for (int m = 0; m < 4; ++m) { const int row = row0 + ai * HALF + m * 16; bf16_t* rowp = QKV + (((size_t)(row >> 13) * 48 + (colt >> 7)) * 8192 + (row & 8191)) * 128 + cl;
#pragma unroll
                    for (int bj = 0; bj < 2; ++bj) EPI_ST((u32x4*)(rowp + (size_t)bj * 8192 * 128), pack8(acc[ai][bj][m][0], acc[ai][bj][m][1])); }
        } else {
#pragma unroll
            for (int ai = 0; ai < 2; ++ai)
#pragma unroll
                for (int m = 0; m < 4; ++m) { bf16_t* rowp = G + (size_t)(row0 + ai * HALF + m * 16) * 4096 + (colt - 6144) + cl;
#pragma unroll
                    for (int bj = 0; bj < 2; ++bj) { f32x4 v0 = acc[ai][bj][m][0], v1 = acc[ai][bj][m][1];
#pragma unroll
                        for (int j = 0; j < 4; ++j) { v0[j] = sigmoidf_(v0[j]); v1[j] = sigmoidf_(v1[j]); }
                        EPI_ST((u32x4*)(rowp + bj * HALF), pack8(v0, v1)); } }
        }
    }
};
template <int SECOND> struct EpiBranch {
    static constexpr bool PERM = true, AFTER_DRAIN = false;
    const bf16_t* G; bf16_t* T; bf16_t* MX;
    __device__ __forceinline__ void operator()(const f32x4 (&acc)[2][2][4][2], const Unit& u, int wr, int wc, int fr, int fq) const {
        const int row0 = u.pm * BM + wr * 64 + fr, col0 = u.pn * BM + wc * 32 + 8 * fq;
#pragma unroll
        for (int ai = 0; ai < 2; ++ai) {
            u32x4 gw[4][2], tw[4][2];
#pragma unroll
            for (int m = 0; m < 4; ++m)
#pragma unroll
                for (int bj = 0; bj < 2; ++bj) { const size_t row = (size_t)(row0 + ai * HALF + m * 16); const int col = col0 + bj * HALF;
                    gw[m][bj] = *(const u32x4*)(G + row * 4096 + SECOND * 2048 + col);
                    if (SECOND) tw[m][bj] = *(const u32x4*)(T + row * 2048 + col); }
            asm volatile("" ::: "memory");
#pragma unroll
            for (int m = 0; m < 4; ++m)
#pragma unroll
                for (int bj = 0; bj < 2; ++bj) { const size_t row = (size_t)(row0 + ai * HALF + m * 16); const int col = col0 + bj * HALF;
                    float g[8]; unpack8(gw[m][bj], g);
                    f32x4 v0 = acc[ai][bj][m][0], v1 = acc[ai][bj][m][1];
#pragma unroll
                    for (int jj = 0; jj < 4; ++jj) { v0[jj] *= g[jj]; v1[jj] *= g[4 + jj]; }
                    if (SECOND == 0) { *(u32x4*)(T + row * 2048 + col) = pack8(v0, v1); }
                    else { float t[8]; unpack8(tw[m][bj], t);
#pragma unroll
                        for (int jj = 0; jj < 4; ++jj) { v0[jj] += t[jj]; v1[jj] += t[4 + jj]; }
                        *(u32x4*)(MX + row * 2048 + col) = pack8(v0, v1); } }
            asm volatile("" ::: "memory");
        }
    }
};
template <typename TO> struct EpiYss {
    static constexpr bool PERM = true, AFTER_DRAIN = false;
    TO* Y; float* SS;
    __device__ __forceinline__ void operator()(const f32x4 (&acc)[2][2][4][2], const Unit& u, int wr, int wc, int fr, int fq) const {
        const int row0 = u.pm * BM + wr * 64 + fr, col0 = u.pn * BM + wc * 32 + 8 * fq;
#pragma unroll
        for (int ai = 0; ai < 2; ++ai)
#pragma unroll
            for (int m = 0; m < 4; ++m) { const size_t row = (size_t)(row0 + ai * HALF + m * 16); float s = 0.f;
#pragma unroll
                for (int bj = 0; bj < 2; ++bj) { const f32x4 v0 = acc[ai][bj][m][0], v1 = acc[ai][bj][m][1];
                    s += (v0[0] * v0[0] + v0[1] * v0[1]) + (v0[2] * v0[2] + v0[3] * v0[3]) + (v1[0] * v1[0] + v1[1] * v1[1]) + (v1[2] * v1[2] + v1[3] * v1[3]);
                    if constexpr (sizeof(TO) == 2) *(u32x4*)((bf16_t*)Y + row * 2048 + col0 + bj * HALF) = pack8(v0, v1);
                    else { float* yp = (float*)Y + row * 2048 + col0 + bj * HALF; *(f32x4*)yp = v0; *(f32x4*)(yp + 4) = v1; } }
                s += __shfl_xor(s, 16); s += __shfl_xor(s, 32);
                if (fq == 0) SS[row * 32 + u.pn * 4 + wc] = s; }
    }
};
struct EpiRelu2 {
    static constexpr bool PERM = true, AFTER_DRAIN = false;
    bf16_t* U; int ldc;
    __device__ __forceinline__ void operator()(const f32x4 (&acc)[2][2][4][2], const Unit& u, int wr, int wc, int fr, int fq) const {
        const int row0 = u.pm * BM + wr * 64 + fr, col0 = u.pn * BM + wc * 32 + 8 * fq;
#pragma unroll
        for (int ai = 0; ai < 2; ++ai)
#pragma unroll
            for (int m = 0; m < 4; ++m) { bf16_t* rowp = U + (size_t)(row0 + ai * HALF + m * 16) * ldc + col0;
#pragma unroll
                for (int bj = 0; bj < 2; ++bj) { f32x4 v0 = acc[ai][bj][m][0], v1 = acc[ai][bj][m][1];
#pragma unroll
                    for (int j = 0; j < 4; ++j) { const float a = fmaxf(v0[j], 0.f), b = fmaxf(v1[j], 0.f); v0[j] = a * a; v1[j] = b * b; }
                    EPI_ST((u32x4*)(rowp + bj * HALF), pack8(v0, v1)); } }
    }
};
struct PanelOrder {
    int c;
    __device__ void init(int c_) { c = c_; }
    __device__ bool next(int i, Unit& u) const { if (i >= 4) return false; const int li = c >> 3; u.pm = 16 * (c & 7) + 4 * i + (li >> 3); u.pn = li & 7; return true; }
    __device__ __forceinline__ void a_ready(const Unit&) const {}
    __device__ __forceinline__ void done(const Unit&) const {}
};
__device__ __forceinline__ void panel_publish(const float (&sq)[2][4], float* slots, unsigned* cnt, const Unit& u, int wr, int wc, int fr, int fq) {
#pragma unroll
    for (int ai = 0; ai < 2; ++ai)
#pragma unroll
        for (int m = 0; m < 4; ++m) { const size_t row = (size_t)(u.pm * BM + ai * HALF + wr * 64 + m * 16 + fr);
            if (fq == 0) __hip_atomic_store(slots + row * 32 + u.pn * 4 + wc, sq[ai][m], __ATOMIC_RELAXED, __HIP_MEMORY_SCOPE_AGENT); }
    asm volatile("s_waitcnt vmcnt(0)" ::: "memory");
    if ((threadIdx.x & 63) == 0) __hip_atomic_fetch_add(cnt + 64 * u.pm, 1u, __ATOMIC_RELAXED, __HIP_MEMORY_SCOPE_AGENT);
}
__device__ __forceinline__ void panel_collect(float (&sq)[2][4], const float* slots, unsigned* cnt, const Unit& u, int wr, int fr, int fq, float eps) {
    unsigned* cw = cnt + 64 * u.pm;
    { unsigned spins = 0;
      while ((unsigned)__builtin_amdgcn_readfirstlane(__hip_atomic_load(cw, __ATOMIC_RELAXED, __HIP_MEMORY_SCOPE_AGENT)) < 64u) { __builtin_amdgcn_s_sleep(2); if (++spins > (1u << 22)) break; } }
    __builtin_amdgcn_fence(__ATOMIC_ACQUIRE, "agent");
#pragma unroll
    for (int ai = 0; ai < 2; ++ai)
#pragma unroll
        for (int m = 0; m < 4; ++m) { const size_t row = (size_t)(u.pm * BM + ai * HALF + wr * 64 + m * 16 + fr);
            const unsigned long long* sp = (const unsigned long long*)(slots + row * 32 + fq * 8); float t = 0.f;
#pragma unroll
            for (int k = 0; k < 4; ++k) { const unsigned long long w = __hip_atomic_load(sp + k, __ATOMIC_RELAXED, __HIP_MEMORY_SCOPE_AGENT); t += __uint_as_float((unsigned)w) + __uint_as_float((unsigned)(w >> 32)); }
            t += __shfl_xor(t, 16); t += __shfl_xor(t, 32);
            sq[ai][m] = __builtin_amdgcn_rsqf(t * (1.0f / 2048.0f) + eps); }
}
struct EpiFinal {
    static constexpr bool PERM = false, AFTER_DRAIN = false;
    float* X; const float* gain; float* slots; unsigned* cnt; float eps;
    __device__ __forceinline__ void operator()(const f32x4 (&acc)[2][2][4][2], const Unit& u, int wr, int wc, int fr, int fq) const {
        float sq[2][4];
#pragma unroll
        for (int ai = 0; ai < 2; ++ai)
#pragma unroll
            for (int m = 0; m < 4; ++m) { float s = 0.f;
#pragma unroll
                for (int bj = 0; bj < 2; ++bj)
#pragma unroll
                    for (int n = 0; n < 2; ++n) { const f32x4 v = acc[ai][bj][m][n]; s += (v[0] * v[0] + v[1] * v[1]) + (v[2] * v[2] + v[3] * v[3]); }
                s += __shfl_xor(s, 16); s += __shfl_xor(s, 32); sq[ai][m] = s; }
        const int col0 = u.pn * BM + wc * 32 + 4 * fq;
        panel_publish(sq, slots, cnt, u, wr, wc, fr, fq);
        f32x4 pre[4][2][2];
#pragma unroll
        for (int m = 0; m < 4; ++m) { const float* rowp = X + (size_t)(u.pm * BM + wr * 64 + m * 16 + fr) * 2048 + col0;
#pragma unroll
            for (int bj = 0; bj < 2; ++bj)
#pragma unroll
                for (int n = 0; n < 2; ++n) pre[m][bj][n] = *(const f32x4*)(rowp + bj * HALF + n * 16); }
        panel_collect(sq, slots, cnt, u, wr, fr, fq, eps);
        f32x4 gv[2][2];
#pragma unroll
        for (int bj = 0; bj < 2; ++bj)
#pragma unroll
            for (int n = 0; n < 2; ++n) gv[bj][n] = *(const f32x4*)(gain + col0 + bj * HALF + n * 16);
#pragma unroll
        for (int ai = 0; ai < 2; ++ai) {
            if (ai == 1) {
#pragma unroll
                for (int m = 0; m < 4; ++m) { const float* rowp = X + (size_t)(u.pm * BM + HALF + wr * 64 + m * 16 + fr) * 2048 + col0;
#pragma unroll
                    for (int bj = 0; bj < 2; ++bj)
#pragma unroll
                        for (int n = 0; n < 2; ++n) pre[m][bj][n] = *(const f32x4*)(rowp + bj * HALF + n * 16); } }
#pragma unroll
            for (int m = 0; m < 4; ++m) { float* rowp = X + (size_t)(u.pm * BM + ai * HALF + wr * 64 + m * 16 + fr) * 2048 + col0; const float rs = sq[ai][m];
#pragma unroll
                for (int bj = 0; bj < 2; ++bj)
#pragma unroll
                    for (int n = 0; n < 2; ++n) *(f32x4*)(rowp + bj * HALF + n * 16) = pre[m][bj][n] + acc[ai][bj][m][n] * rs * gv[bj][n]; }
            asm volatile("" ::: "memory");
        }
    }
};

template <class Epi, class Sched, bool ALIGN_EPI = false, bool SP2 = false>
__device__ __forceinline__ void gemm_phase(PG8_LAS unsigned char* lds, const Gemm g, const Sched& S, const Epi& E) {
    const int tid = threadIdx.x, wid = __builtin_amdgcn_readfirstlane(tid >> 6), lane = tid & 63, wr = wid >> 2, wc = wid & 3, fr = lane & 15, fq = lane >> 4;
    const int K = g.K, nt = K / BK;
    unsigned voffA[2], voffB[2];
#pragma unroll
    for (int i = 0; i < 2; ++i) { int R, C; stage_rc(tid * 16 + i * 8192, R, C); const int Rb = Epi::PERM ? ((R & ~31) + perm32(R & 31)) : R;
        voffA[i] = (unsigned)(R * K + C) * 2u; voffB[i] = (unsigned)(Rb * K + C) * 2u; }
    const size_t kstep = (size_t)(BK * 2);
    const size_t hstep = (size_t)HALF * K * 2;
    const size_t tstep = 2 * hstep;
    const unsigned ldsw = (unsigned)wid * 1024u;
    const int aoff = lds_byte(wr * 64 + fr, fq * 8), boff = lds_byte(wc * 32 + fr, fq * 8);
#define PG8_SA(b, h) (((b) * 2 + (h)) * HTB)
#define PG8_SB(b, h) ((4 + (b) * 2 + (h)) * HTB)
#define PG8_STAGE(bufoff, gbase, voff) do { _Pragma("unroll") for (int _i = 0; _i < 2; ++_i) \
        __builtin_amdgcn_global_load_lds((const unsigned*)((const char*)(gbase) + (voff)[_i]), (PG8_LAS unsigned*)(lds + (bufoff) + ldsw + _i * 8192), 16, 0, 0); } while (0)
#define PG8_LDA(dst, b, h) do { _Pragma("unroll") for (int m = 0; m < 4; ++m) _Pragma("unroll") for (int k = 0; k < 2; ++k) dst[m][k] = *(const PG8_LAS bf16x8*)(lds + PG8_SA(b, h) + aoff + m * 2048 + k * 1024); } while (0)
#define PG8_LDB(dst, b, h) do { _Pragma("unroll") for (int n = 0; n < 2; ++n) _Pragma("unroll") for (int k = 0; k < 2; ++k) dst[n][k] = *(const PG8_LAS bf16x8*)(lds + PG8_SB(b, h) + boff + n * 2048 + k * 1024); } while (0)
#define PG8_MMA(ai, bj, At, Bt) do { __builtin_amdgcn_s_setprio(1); _Pragma("unroll") for (int m = 0; m < 4; ++m) _Pragma("unroll") for (int n = 0; n < 2; ++n) _Pragma("unroll") for (int k = 0; k < 2; ++k) \
        acc[ai][bj][m][n] = __builtin_amdgcn_mfma_f32_16x16x32_bf16(Bt[n][k], At[m][k], acc[ai][bj][m][n], 0, 0, 0); __builtin_amdgcn_s_setprio(0); } while (0)
#define PG8_WAIT_V(n) asm volatile("s_waitcnt vmcnt(" #n ")" ::: "memory")
#define PG8_WAIT_L(n) asm volatile("s_waitcnt lgkmcnt(" #n ")" ::: "memory")
#define PG8_BAR __builtin_amdgcn_s_barrier()
#define PG8_SCHED __builtin_amdgcn_sched_barrier(0)
    Unit cur, nxt; int ui = 0;
    if (!S.next(0, cur)) return;
    f32x4 acc[2][2][4][2];
#pragma unroll
    for (int a = 0; a < 2; ++a)
#pragma unroll
        for (int b = 0; b < 2; ++b)
#pragma unroll
            for (int m = 0; m < 4; ++m)
#pragma unroll
                for (int n = 0; n < 2; ++n) acc[a][b][m][n] = (f32x4){0.f, 0.f, 0.f, 0.f};
    bf16x8 At[4][2], B0[2][2], B1[2][2];
    const char* cA = (const char*)g.A + (size_t)cur.pm * tstep; const char* cB = (const char*)g.Bt + (size_t)cur.pn * tstep;
    S.a_ready(cur);
    if constexpr (SP2) {
        PG8_STAGE(PG8_SB(0, 0), cB, voffB); PG8_STAGE(PG8_SB(0, 1), cB + hstep, voffB); PG8_STAGE(PG8_SA(0, 0), cA, voffA); PG8_STAGE(PG8_SA(0, 1), cA + hstep, voffA);
        if (wr == 1) PG8_BAR;
        PG8_WAIT_V(2); PG8_BAR;
        PG8_STAGE(PG8_SB(1, 0), cB + kstep, voffB); PG8_STAGE(PG8_SA(1, 0), cA + kstep, voffA); PG8_STAGE(PG8_SB(1, 1), cB + hstep + kstep, voffB);
        PG8_WAIT_V(6); PG8_BAR;
    } else {
        PG8_STAGE(PG8_SB(0, 0), cB, voffB); PG8_STAGE(PG8_SA(0, 0), cA, voffA); PG8_STAGE(PG8_SB(0, 1), cB + hstep, voffB); PG8_STAGE(PG8_SA(0, 1), cA + hstep, voffA);
        if (wr == 1) PG8_BAR;
        PG8_WAIT_V(4); PG8_BAR;
        PG8_STAGE(PG8_SB(1, 0), cB + kstep, voffB); PG8_STAGE(PG8_SA(1, 0), cA + kstep, voffA); PG8_STAGE(PG8_SB(1, 1), cB + hstep + kstep, voffB);
        PG8_WAIT_V(6); PG8_BAR;
    }
    for (;;) {
        const bool has_next = S.next(ui + 1, nxt);
        const char* nA = has_next ? (const char*)g.A + (size_t)nxt.pm * tstep : cA; const char* nB = has_next ? (const char*)g.Bt + (size_t)nxt.pn * tstep : cB;
        for (int t = 0; t < nt; t += 2) {
            const bool last = (t == nt - 2);
            const char* a1 = cA + (size_t)(t + 1) * kstep;
            const char* a2 = last ? nA : cA + (size_t)(t + 2) * kstep; const char* b2 = last ? nB : cB + (size_t)(t + 2) * kstep;
            const char* a3 = a2 + kstep; const char* b3 = b2 + kstep;
            if (last && has_next) S.a_ready(nxt);
            if constexpr (SP2) {
            PG8_LDB(B0, 0, 0); PG8_LDB(B1, 0, 1); PG8_SCHED; PG8_LDA(At, 0, 0); PG8_STAGE(PG8_SA(1, 1), a1 + hstep, voffA);
            PG8_WAIT_V(8); PG8_WAIT_L(0); PG8_BAR; PG8_MMA(0, 0, At, B0); PG8_MMA(0, 1, At, B1); PG8_BAR; PG8_SCHED;
            PG8_LDA(At, 0, 1); PG8_STAGE(PG8_SB(0, 0), b2, voffB); PG8_STAGE(PG8_SB(0, 1), b2 + hstep, voffB); PG8_STAGE(PG8_SA(0, 0), a2, voffA);
            PG8_WAIT_V(8); PG8_WAIT_L(0); PG8_BAR; PG8_MMA(1, 0, At, B0); PG8_MMA(1, 1, At, B1); PG8_BAR; PG8_SCHED;
            PG8_LDB(B0, 1, 0); PG8_LDB(B1, 1, 1); PG8_SCHED; PG8_LDA(At, 1, 0); PG8_STAGE(PG8_SA(0, 1), a2 + hstep, voffA);
            PG8_WAIT_V(8); PG8_WAIT_L(0); PG8_BAR; PG8_MMA(0, 0, At, B0); PG8_MMA(0, 1, At, B1); PG8_BAR; PG8_SCHED;
            PG8_LDA(At, 1, 1); PG8_STAGE(PG8_SB(1, 0), b3, voffB); PG8_STAGE(PG8_SB(1, 1), b3 + hstep, voffB); PG8_STAGE(PG8_SA(1, 0), a3, voffA);
            PG8_WAIT_V(8); PG8_WAIT_L(0); PG8_BAR; PG8_MMA(1, 0, At, B0); PG8_MMA(1, 1, At, B1); PG8_BAR; PG8_SCHED;
            } else {
            PG8_LDB(B0, 0, 0); PG8_SCHED; PG8_LDA(At, 0, 0); PG8_STAGE(PG8_SA(1, 1), a1 + hstep, voffA);
            PG8_WAIT_L(8); PG8_BAR; PG8_WAIT_L(0); PG8_MMA(0, 0, At, B0); PG8_BAR; PG8_SCHED;
            PG8_LDB(B1, 0, 1); PG8_STAGE(PG8_SB(0, 0), b2, voffB);
            PG8_BAR; PG8_WAIT_L(0); PG8_MMA(0, 1, At, B1); PG8_BAR;
            PG8_LDA(At, 0, 1); PG8_STAGE(PG8_SA(0, 0), a2, voffA);
            PG8_BAR; PG8_WAIT_L(0); PG8_MMA(1, 0, At, B0); PG8_BAR; PG8_SCHED;
            PG8_STAGE(PG8_SB(0, 1), b2 + hstep, voffB);
            PG8_WAIT_V(6); PG8_BAR; PG8_MMA(1, 1, At, B1); PG8_BAR;
            PG8_LDB(B0, 1, 0); PG8_SCHED; PG8_LDA(At, 1, 0); PG8_STAGE(PG8_SA(0, 1), a2 + hstep, voffA);
            PG8_WAIT_L(8); PG8_BAR; PG8_WAIT_L(0); PG8_MMA(0, 0, At, B0); PG8_BAR; PG8_SCHED;
            PG8_LDB(B1, 1, 1); PG8_STAGE(PG8_SB(1, 0), b3, voffB);
            PG8_BAR; PG8_WAIT_L(0); PG8_MMA(0, 1, At, B1); PG8_BAR;
            PG8_LDA(At, 1, 1); PG8_STAGE(PG8_SA(1, 0), a3, voffA);
            PG8_BAR; PG8_WAIT_L(0); PG8_MMA(1, 0, At, B0); PG8_BAR; PG8_SCHED;
            PG8_STAGE(PG8_SB(1, 1), b3 + hstep, voffB);
            PG8_WAIT_V(6); PG8_BAR; PG8_MMA(1, 1, At, B1); PG8_BAR;
            }
        }
        if constexpr (ALIGN_EPI) { if (wr == 0) PG8_BAR; }
        if constexpr (!Epi::AFTER_DRAIN) { E(acc, cur, wr, wc, fr, fq); S.done(cur); }
        if (!has_next) break;
#pragma unroll
        for (int a = 0; a < 2; ++a)
#pragma unroll
            for (int b = 0; b < 2; ++b)
#pragma unroll
                for (int m = 0; m < 4; ++m)
#pragma unroll
                    for (int n = 0; n < 2; ++n) acc[a][b][m][n] = (f32x4){0.f, 0.f, 0.f, 0.f};
        cur = nxt; cA = nA; cB = nB; ++ui;
        if constexpr (ALIGN_EPI) { if (wr == 1) PG8_BAR; }
    }
    PG8_WAIT_V(0);
    if constexpr (!ALIGN_EPI) { if (wr == 0) PG8_BAR; }
    PG8_BAR;
    if constexpr (Epi::AFTER_DRAIN) { E.fused(acc, cur, wr, wc, fr, fq, lds, wid, lane); S.done(cur); }
#undef PG8_SA
#undef PG8_SB
#undef PG8_STAGE
#undef PG8_LDA
#undef PG8_LDB
#undef PG8_MMA
#undef PG8_WAIT_V
#undef PG8_WAIT_L
#undef PG8_BAR
#undef PG8_SCHED
}
}
namespace att {
using bf16 = unsigned short;
constexpr int   D = 128, NW = 8, QBLK = 32, KVBLK = 64;
constexpr float SCALE = 0.088388347648318440f;
#ifndef ATT_THR
#define ATT_THR 8.f
#endif
constexpr float THR = ATT_THR;
constexpr int SDEPTH = 2;
constexpr int LDQ = 128, LDK = 128, LDO = 2048;
constexpr size_t SHM_V = KVBLK * D * 2, SHM_K = KVBLK * D * 2, SHM_ATTN = 2 * SHM_V + 2 * SHM_K + NW * 64 * 4;
using bf16x8 = __attribute__((ext_vector_type(8))) short;
using s16x4  = __attribute__((ext_vector_type(4))) short;
using f32x16 = __attribute__((ext_vector_type(16))) float;
using f32x8  = __attribute__((ext_vector_type(8))) float;
using u32x4  = __attribute__((ext_vector_type(4))) unsigned;
#define KSWZ(row, colB) ((row) * 256 + ((colB) ^ (((row) & 7) << 4)))
#define SBAR() __builtin_amdgcn_sched_barrier(0)
__device__ __forceinline__ int crow(int r, int hi) { return (r & 3) + 8 * (r >> 2) + 4 * hi; }
__device__ __forceinline__ unsigned cvtpk(float lo, float hi) {
  unsigned r; asm volatile("v_cvt_pk_bf16_f32 %0, %1, %2" : "=v"(r) : "v"(lo), "v"(hi)); return r;
}
template <typename TIn> struct Stage;
template <> struct Stage<bf16>  { using T = bf16x8;
  __device__ static __forceinline__ T ld8(const bf16* p) { return *reinterpret_cast<const bf16x8*>(p); }
  __device__ static __forceinline__ bf16x8 tobf(T x) { return x; } };
template <> struct Stage<float> { using T = f32x8;
  __device__ static __forceinline__ T ld8(const float* p) { return *reinterpret_cast<const f32x8*>(p); }
  __device__ static __forceinline__ bf16x8 tobf(T x) {
    u32x4 w = {cvtpk(x[0], x[1]), cvtpk(x[2], x[3]), cvtpk(x[4], x[5]), cvtpk(x[6], x[7])}; return *reinterpret_cast<bf16x8*>(&w); } };

__device__ __forceinline__ void partialSM(f32x16& p0, f32x16& p1, float& m_reg, float& mn, float& alpha) {
  constexpr float C = SCALE * 1.4426950408889634f;
  float pmax = p0[0]; for (int r = 1; r < 16; ++r) pmax = fmaxf(pmax, p0[r]); for (int r = 0; r < 16; ++r) pmax = fmaxf(pmax, p1[r]);
  { auto rr = __builtin_amdgcn_permlane32_swap(__float_as_uint(pmax), __float_as_uint(pmax), false, false);
    pmax = fmaxf(__uint_as_float(rr[0]), __uint_as_float(rr[1])); }
  if (__builtin_expect(__all(pmax - m_reg <= THR / SCALE), 1)) { mn = m_reg; alpha = 1.f; }
  else { mn = fmaxf(m_reg, pmax); alpha = __builtin_amdgcn_exp2f((m_reg - mn) * C); m_reg = mn; }
  float mnC = -mn * C;
  for (int r = 0; r < 16; ++r) p0[r] = fmaf(p0[r], C, mnC); for (int r = 0; r < 16; ++r) p1[r] = fmaf(p1[r], C, mnC);
  for (int r = 0; r < 16; ++r) p0[r] = __builtin_amdgcn_exp2f(p0[r]);
}
__device__ __forceinline__ void finishSM(f32x16& p0, f32x16& p1, float alpha, float& l_reg, bf16x8& pa0, bf16x8& pa1, bf16x8& pa2, bf16x8& pa3) {
  for (int r = 0; r < 16; ++r) p1[r] = __builtin_amdgcn_exp2f(p1[r]);
  float ps = 0; for (int r = 0; r < 16; ++r) ps += p0[r]; for (int r = 0; r < 16; ++r) ps += p1[r];
  { auto rr = __builtin_amdgcn_permlane32_swap(__float_as_uint(ps), __float_as_uint(ps), false, false);
    ps = __uint_as_float(rr[0]) + __uint_as_float(rr[1]); }
  l_reg = l_reg * alpha + ps;
#define PK4(P, BASE, OUT) do { unsigned a0 = cvtpk(P[BASE + 0], P[BASE + 1]), a1 = cvtpk(P[BASE + 2], P[BASE + 3]);   \
    unsigned b0 = cvtpk(P[BASE + 4], P[BASE + 5]), b1 = cvtpk(P[BASE + 6], P[BASE + 7]);                              \
    auto r0 = __builtin_amdgcn_permlane32_swap(a0, b0, false, false); auto r1 = __builtin_amdgcn_permlane32_swap(a1, b1, false, false); \
    u32x4 w = {r0[0], r1[0], r0[1], r1[1]}; OUT = *reinterpret_cast<bf16x8*>(&w); } while (0)
  PK4(p0, 0, pa0); PK4(p0, 8, pa1); PK4(p1, 0, pa2); PK4(p1, 8, pa3);
#undef PK4
}
__device__ __forceinline__ void qkt(f32x16& p0, f32x16& p1, const bf16* Ks, const bf16x8* qr, int r32, int hi) {
  p0 = f32x16{}; p1 = f32x16{};
  for (int d0 = 0; d0 < 8; ++d0) { int cb = (d0 * 16 + hi * 8) * 2;
    bf16x8 b0 = *reinterpret_cast<const bf16x8*>((const char*)Ks + KSWZ(r32, cb));
    bf16x8 b1 = *reinterpret_cast<const bf16x8*>((const char*)Ks + KSWZ(32 + r32, cb));
    p0 = __builtin_amdgcn_mfma_f32_32x32x16_bf16(b0, qr[d0], p0, 0, 0, 0);
    p1 = __builtin_amdgcn_mfma_f32_32x32x16_bf16(b1, qr[d0], p1, 0, 0, 0); }
}
__device__ __forceinline__ int v_st(int k, int c) { const int kk = (k & ~0xC) | ((k & 4) << 1) | ((k & 8) >> 1); return ((kk >> 3) * 4 + (c >> 5)) * 512 + ((kk & 7) * 32 + (c & 31)) * 2; }
__device__ __forceinline__ int v_rd_base(int lane) { return ((lane & 3) << 3) | (((lane >> 2) & 3) << 6) | (((lane >> 4) & 1) << 5) | (((lane >> 5) & 1) << 8); }
constexpr int v_rd_off(int d0, int ks, int half) { return d0 * 512 + ks * 4096 + half * 2048; }
template <int OFF> __device__ __forceinline__ s16x4 tr_read(int vb) {
  s16x4 r; asm volatile("ds_read_b64_tr_b16 %0, %1 offset:%2" : "=&v"(r) : "v"(vb), "i"(OFF) : "memory"); return r;
}
template <int D0> __device__ __forceinline__ void pv_one(f32x16& od, int vb, bf16x8 pa0, bf16x8 pa1, bf16x8 pa2, bf16x8 pa3) {
  const s16x4 l0 = tr_read<v_rd_off(D0, 0, 0)>(vb), h0 = tr_read<v_rd_off(D0, 0, 1)>(vb), l1 = tr_read<v_rd_off(D0, 1, 0)>(vb), h1 = tr_read<v_rd_off(D0, 1, 1)>(vb);
  const s16x4 l2 = tr_read<v_rd_off(D0, 2, 0)>(vb), h2 = tr_read<v_rd_off(D0, 2, 1)>(vb), l3 = tr_read<v_rd_off(D0, 3, 0)>(vb), h3 = tr_read<v_rd_off(D0, 3, 1)>(vb);
  asm volatile("s_waitcnt lgkmcnt(0)" ::: "memory"); SBAR();
#define PK(L, H) (bf16x8){L[0], L[1], L[2], L[3], H[0], H[1], H[2], H[3]}
  od = __builtin_amdgcn_mfma_f32_32x32x16_bf16(pa0, PK(l0, h0), od, 0, 0, 0);
  od = __builtin_amdgcn_mfma_f32_32x32x16_bf16(pa1, PK(l1, h1), od, 0, 0, 0);
  od = __builtin_amdgcn_mfma_f32_32x32x16_bf16(pa2, PK(l2, h2), od, 0, 0, 0);
  od = __builtin_amdgcn_mfma_f32_32x32x16_bf16(pa3, PK(l3, h3), od, 0, 0, 0);
#undef PK
}
__device__ __forceinline__ void pv_d0(f32x16* o, int vb, bf16x8 pa0, bf16x8 pa1, bf16x8 pa2, bf16x8 pa3) {
  pv_one<0>(o[0], vb, pa0, pa1, pa2, pa3); pv_one<1>(o[1], vb, pa0, pa1, pa2, pa3); pv_one<2>(o[2], vb, pa0, pa1, pa2, pa3); pv_one<3>(o[3], vb, pa0, pa1, pa2, pa3);
}

template <typename TQ>
__device__ __forceinline__ void attn_dense_body(const TQ* __restrict__ Qb, const bf16* __restrict__ Kh, const bf16* __restrict__ Vh,
                                                bf16* __restrict__ Ob, int seq, char* lds) {
  using St = Stage<bf16>; using SQ = Stage<TQ>;
  const int tid = threadIdx.x, wid = tid >> 6, lane = tid & 63, r32 = lane & 31, hi = lane >> 5;
  bf16* V_lds = (bf16*)lds; bf16* K_lds = (bf16*)(lds + 2 * SHM_V);
  float* ws = (float*)(lds + 2 * SHM_V + 2 * SHM_K) + wid * 64; float* li_l = ws; float* al_l = ws + 32;
  float m_reg = -1e30f, l_reg = 0; f32x16 o[4] = {}; bf16x8 qr[8];
  const TQ* Qw = Qb + (long)(wid * QBLK + r32) * LDQ + hi * 8;
#pragma unroll
  for (int d0 = 0; d0 < 8; ++d0) qr[d0] = SQ::tobf(SQ::ld8(Qw + d0 * 16));
  const int sr = tid >> 4, sc = (tid & 15) * 8, vst0 = v_st(sr, sc), vst1 = v_st(32 + sr, sc);
  const int vb0 = (int)(uintptr_t)V_lds + v_rd_base(lane);
  struct { typename St::T vs0, vs1, ks0, ks1; } sr_[SDEPTH];
#define SLOAD(i, k0) do { sr_[i].vs0 = St::ld8(&Vh[(long)((k0) + sr) * LDK + sc]); sr_[i].vs1 = St::ld8(&Vh[(long)((k0) + 32 + sr) * LDK + sc]); \
    sr_[i].ks0 = St::ld8(&Kh[(long)((k0) + sr) * LDK + sc]); sr_[i].ks1 = St::ld8(&Kh[(long)((k0) + 32 + sr) * LDK + sc]); } while (0)
#define SWRITE(b, i) do { *(bf16x8*)((char*)V_lds + (b) * SHM_V + vst0) = St::tobf(sr_[i].vs0);          \
    *(bf16x8*)((char*)V_lds + (b) * SHM_V + vst1) = St::tobf(sr_[i].vs1); int kc = sc * 2;               \
    *(bf16x8*)((char*)K_lds + (b) * SHM_K + KSWZ(sr, kc)) = St::tobf(sr_[i].ks0);                       \
    *(bf16x8*)((char*)K_lds + (b) * SHM_K + KSWZ(32 + sr, kc)) = St::tobf(sr_[i].ks1); } while (0)
#define SWAIT() do { if constexpr (SDEPTH == 2) asm volatile("s_waitcnt vmcnt(4)" ::: "memory"); else asm volatile("s_waitcnt vmcnt(0)" ::: "memory"); } while (0)
#define RESC(a) do { if (__any((a) < 1.f)) { if (hi == 0) al_l[r32] = (a); asm volatile("s_waitcnt lgkmcnt(0)" ::: "memory"); \
    for (int d = 0; d < 4; ++d) for (int r = 0; r < 16; ++r) o[d][r] *= al_l[crow(r, hi)]; } } while (0)
  f32x16 pA0, pA1, pB0, pB1; float mnA, mnB, alA, alB; bf16x8 pa0, pa1, pa2, pa3; const int NT = seq / KVBLK;
  constexpr int SE = 0, SO = SDEPTH - 1;
  SLOAD(SE, 0); asm volatile("s_waitcnt vmcnt(0)" ::: "memory"); SWRITE(0, SE); __syncthreads();
  qkt(pA0, pA1, K_lds, qr, r32, hi); partialSM(pA0, pA1, m_reg, mnA, alA);
  SLOAD(SO, KVBLK); if constexpr (SDEPTH == 2) { if (2 < NT) SLOAD(SE, 2 * KVBLK); }
  SWAIT(); SWRITE(1, SO); __syncthreads();
  for (int j = 1; j + 1 < NT; j += 2) {
    SBAR(); qkt(pB0, pB1, (bf16*)((char*)K_lds + SHM_K), qr, r32, hi);
    finishSM(pA0, pA1, alA, l_reg, pa0, pa1, pa2, pa3); SBAR();
    SLOAD(SO, (j + SDEPTH) * KVBLK); SBAR();
    pv_d0(o, vb0, pa0, pa1, pa2, pa3); partialSM(pB0, pB1, m_reg, mnB, alB);
    __syncthreads(); SWAIT(); SWRITE(0, SE);
    RESC(alB); __syncthreads();
    SBAR(); qkt(pA0, pA1, K_lds, qr, r32, hi);
    finishSM(pB0, pB1, alB, l_reg, pa0, pa1, pa2, pa3); SBAR();
    if (SDEPTH == 1 || j + 3 < NT) SLOAD(SE, (j + 1 + SDEPTH) * KVBLK); SBAR();
    pv_d0(o, vb0 + (int)SHM_V, pa0, pa1, pa2, pa3); partialSM(pA0, pA1, m_reg, mnA, alA);
    __syncthreads(); SWAIT(); SWRITE(1, SO);
    RESC(alA); __syncthreads();
  }
  SBAR(); qkt(pB0, pB1, (bf16*)((char*)K_lds + SHM_K), qr, r32, hi);
  finishSM(pA0, pA1, alA, l_reg, pa0, pa1, pa2, pa3); SBAR();
  pv_d0(o, vb0, pa0, pa1, pa2, pa3); partialSM(pB0, pB1, m_reg, mnB, alB);
  __syncthreads(); RESC(alB);
  finishSM(pB0, pB1, alB, l_reg, pa0, pa1, pa2, pa3); SBAR();
  pv_d0(o, vb0 + (int)SHM_V, pa0, pa1, pa2, pa3);
  if (hi == 0) li_l[r32] = l_reg; asm volatile("s_waitcnt lgkmcnt(0)" ::: "memory");
  float rli[16];
#pragma unroll
  for (int r = 0; r < 16; ++r) rli[r] = __builtin_amdgcn_rcpf(li_l[crow(r, hi)]);
  bf16* Ow = Ob + (long)(wid * QBLK) * LDO;
#pragma unroll
  for (int r = 0; r < 16; ++r) { int orow = crow(r, hi);
    for (int d0 = 0; d0 < 4; ++d0) Ow[(long)orow * LDO + d0 * 32 + r32] = (bf16)(cvtpk(o[d0][r] * rli[r], 0.f) & 0xffffu); }
#undef SLOAD
#undef SWRITE
#undef SWAIT
#undef RESC
}

#define ATT_LAS __attribute__((address_space(3)))
__device__ __forceinline__ void qkt_lean(f32x16& p0, f32x16& p1, const bf16* Ks, const bf16x8* qr, int r32, int hi) {
  p0 = f32x16{}; p1 = f32x16{};
#pragma unroll
  for (int d0 = 0; d0 < 8; ++d0) { const int cb = (d0 * 16 + hi * 8) * 2;
    const bf16x8 b0 = *reinterpret_cast<const bf16x8*>((const char*)Ks + KSWZ(r32, cb));
    const bf16x8 b1 = *reinterpret_cast<const bf16x8*>((const char*)Ks + KSWZ(32 + r32, cb));
    p0 = __builtin_amdgcn_mfma_f32_32x32x16_bf16(b0, qr[d0], p0, 0, 0, 0);
    p1 = __builtin_amdgcn_mfma_f32_32x32x16_bf16(b1, qr[d0], p1, 0, 0, 0);
    if (d0 & 1) SBAR(); }
}
#define A2_WAITL(n) do { asm volatile("s_waitcnt lgkmcnt(" #n ")" ::: "memory"); SBAR(); } while (0)
__device__ __forceinline__ void kq_rd(int a0, bf16x8& b0, bf16x8& b1) {
  asm volatile("ds_read_b128 %0, %1" : "=&v"(b0) : "v"(a0) : "memory");
  asm volatile("ds_read_b128 %0, %1 offset:8192" : "=&v"(b1) : "v"(a0) : "memory");
}
__device__ __forceinline__ void qkt_pipe(f32x16& p0, f32x16& p1, int kaddr, int sw, int hi, const bf16x8* qr) {
  p0 = f32x16{}; p1 = f32x16{};
  bf16x8 a0, a1, b0, b1;
#define KA(d0) (kaddr + (((d0) * 32 + hi * 16) ^ sw))
#define KM(x0, x1, d0) do { p0 = __builtin_amdgcn_mfma_f32_32x32x16_bf16(x0, qr[d0], p0, 0, 0, 0); p1 = __builtin_amdgcn_mfma_f32_32x32x16_bf16(x1, qr[d0], p1, 0, 0, 0); } while (0)
  kq_rd(KA(0), a0, a1); kq_rd(KA(1), b0, b1);
  A2_WAITL(2); KM(a0, a1, 0); SBAR(); kq_rd(KA(2), a0, a1);
  A2_WAITL(2); KM(b0, b1, 1); SBAR(); kq_rd(KA(3), b0, b1);
  A2_WAITL(2); KM(a0, a1, 2); SBAR(); kq_rd(KA(4), a0, a1);
  A2_WAITL(2); KM(b0, b1, 3); SBAR(); kq_rd(KA(5), b0, b1);
  A2_WAITL(2); KM(a0, a1, 4); SBAR(); kq_rd(KA(6), a0, a1);
  A2_WAITL(2); KM(b0, b1, 5); SBAR(); kq_rd(KA(7), b0, b1);
  A2_WAITL(2); KM(a0, a1, 6);
  A2_WAITL(0); KM(b0, b1, 7);
#undef KA
#undef KM
}
template <int HB> __device__ __forceinline__ void pv_rd(int vb, s16x4& la, s16x4& ha, s16x4& lb, s16x4& hb) {
  constexpr int blk = HB >> 1, part = HB & 1, D0 = blk & 3, base = (blk >> 2) * 16384;
  la = tr_read<base + v_rd_off(D0, 2 * part, 0)>(vb); ha = tr_read<base + v_rd_off(D0, 2 * part, 1)>(vb);
  lb = tr_read<base + v_rd_off(D0, 2 * part + 1, 0)>(vb); hb = tr_read<base + v_rd_off(D0, 2 * part + 1, 1)>(vb);
}
template <int HB> __device__ __forceinline__ void pv_mm(f32x16* o, s16x4 la, s16x4 ha, s16x4 lb, s16x4 hb, bf16x8 pa0, bf16x8 pa1, bf16x8 pa2, bf16x8 pa3) {
#define PK(L, H) (bf16x8){L[0], L[1], L[2], L[3], H[0], H[1], H[2], H[3]}
  f32x16& od = o[HB >> 1];
  od = __builtin_amdgcn_mfma_f32_32x32x16_bf16((HB & 1) ? pa2 : pa0, PK(la, ha), od, 0, 0, 0);
  od = __builtin_amdgcn_mfma_f32_32x32x16_bf16((HB & 1) ? pa3 : pa1, PK(lb, hb), od, 0, 0, 0);
#undef PK
}
__device__ __forceinline__ void pv_pipe(f32x16* o, int vb, bf16x8 pa0, bf16x8 pa1, bf16x8 pa2, bf16x8 pa3) {
  s16x4 a0, a1, a2, a3, b0, b1, b2, b3;
  pv_rd<0>(vb, a0, a1, a2, a3); pv_rd<1>(vb, b0, b1, b2, b3);
#define STEP(H) A2_WAITL(4); pv_mm<H>(o, a0, a1, a2, a3, pa0, pa1, pa2, pa3); SBAR(); pv_rd<H + 2>(vb, a0, a1, a2, a3); \
                A2_WAITL(4); pv_mm<H + 1>(o, b0, b1, b2, b3, pa0, pa1, pa2, pa3); SBAR(); pv_rd<H + 3>(vb, b0, b1, b2, b3);
  STEP(0) STEP(2) STEP(4) STEP(6) STEP(8) STEP(10) STEP(12)
#undef STEP
  A2_WAITL(4); pv_mm<14>(o, a0, a1, a2, a3, pa0, pa1, pa2, pa3);
  A2_WAITL(0); pv_mm<15>(o, b0, b1, b2, b3, pa0, pa1, pa2, pa3);
}
__device__ __forceinline__ void qkt_asm(f32x16& p0, f32x16& p1, int kaddr, int sw, int hi, const bf16x8* qr) {
  p0 = f32x16{}; p1 = f32x16{};
#pragma unroll
  for (int d0 = 0; d0 < 8; ++d0) {
    const int a0 = kaddr + ((d0 * 32 + hi * 16) ^ sw);
    bf16x8 b0, b1;
    asm volatile("ds_read_b128 %0, %1" : "=&v"(b0) : "v"(a0) : "memory");
    asm volatile("ds_read_b128 %0, %1 offset:8192" : "=&v"(b1) : "v"(a0) : "memory");
    asm volatile("s_waitcnt lgkmcnt(0)" ::: "memory"); SBAR();
    p0 = __builtin_amdgcn_mfma_f32_32x32x16_bf16(b0, qr[d0], p0, 0, 0, 0);
    p1 = __builtin_amdgcn_mfma_f32_32x32x16_bf16(b1, qr[d0], p1, 0, 0, 0);
  }
}
template <int D0> __device__ __forceinline__ void pv_one_lean(f32x16& od, int vb, bf16x8 pa0, bf16x8 pa1, bf16x8 pa2, bf16x8 pa3) {
#define PK(L, H) (bf16x8){L[0], L[1], L[2], L[3], H[0], H[1], H[2], H[3]}
  { const s16x4 l0 = tr_read<v_rd_off(D0, 0, 0)>(vb), h0 = tr_read<v_rd_off(D0, 0, 1)>(vb), l1 = tr_read<v_rd_off(D0, 1, 0)>(vb), h1 = tr_read<v_rd_off(D0, 1, 1)>(vb);
    asm volatile("s_waitcnt lgkmcnt(0)" ::: "memory"); SBAR();
    od = __builtin_amdgcn_mfma_f32_32x32x16_bf16(pa0, PK(l0, h0), od, 0, 0, 0);
    od = __builtin_amdgcn_mfma_f32_32x32x16_bf16(pa1, PK(l1, h1), od, 0, 0, 0); }
  { const s16x4 l2 = tr_read<v_rd_off(D0, 2, 0)>(vb), h2 = tr_read<v_rd_off(D0, 2, 1)>(vb), l3 = tr_read<v_rd_off(D0, 3, 0)>(vb), h3 = tr_read<v_rd_off(D0, 3, 1)>(vb);
    asm volatile("s_waitcnt lgkmcnt(0)" ::: "memory"); SBAR();
    od = __builtin_amdgcn_mfma_f32_32x32x16_bf16(pa2, PK(l2, h2), od, 0, 0, 0);
    od = __builtin_amdgcn_mfma_f32_32x32x16_bf16(pa3, PK(l3, h3), od, 0, 0, 0); }
#undef PK
}
__device__ __forceinline__ void pv_d0_lean(f32x16* o, int vb, bf16x8 pa0, bf16x8 pa1, bf16x8 pa2, bf16x8 pa3) {
  pv_one_lean<0>(o[0], vb, pa0, pa1, pa2, pa3); pv_one_lean<1>(o[1], vb, pa0, pa1, pa2, pa3); pv_one_lean<2>(o[2], vb, pa0, pa1, pa2, pa3); pv_one_lean<3>(o[3], vb, pa0, pa1, pa2, pa3);
}
constexpr int A2_K = 0, A2_V = 32768, A2_WS = 131072 + 1024;
template <int MODE> __device__ __forceinline__ void attn256_unit(const bf16* __restrict__ Qb, const bf16* __restrict__ Kh, const bf16* __restrict__ V0h, const bf16* __restrict__ V1h,
                                             bf16* Ob, int ntiles, char* lds, ATT_LAS unsigned char* ldsl, bf16* __restrict__ OAb, const float* __restrict__ subw, float lam, float eps, float osc) {
  int tid = threadIdx.x; asm volatile("" : "+v"(tid));
  const int wid = tid >> 6, lane = tid & 63, r32 = lane & 31, hi = lane >> 5;
  float m_reg = -1e30f, l_reg = 0; f32x16 o[8] = {}; bf16x8 qr[8];
  { const bf16* Qw = Qb + (long)(wid * QBLK + r32) * 128 + hi * 8;
#pragma unroll
    for (int d0 = 0; d0 < 8; ++d0) qr[d0] = *reinterpret_cast<const bf16x8*>(Qw + d0 * 16);
#pragma unroll
    for (int d0 = 0; d0 < 8; ++d0) asm volatile("" : "+v"(qr[d0])); }
  unsigned koff, voff;
  { const int L = wid * 1024 + lane * 16;
    { const int row = L >> 8; koff = (unsigned)(row * 256 + ((L & 255) ^ ((row & 7) << 4))); }
    { const int sub = L >> 9, w = L & 511, kk = ((sub >> 2) << 3) | (w >> 6), k = (kk & ~0xC) | ((kk & 4) << 1) | ((kk & 8) >> 1), c = (sub & 3) * 32 + ((w & 63) >> 1); voff = (unsigned)(k * 256 + c * 2); } }
  const unsigned ldsw = (unsigned)__builtin_amdgcn_readfirstlane(wid) * 1024u;
#define A2_DMA(kbuf, vbuf, t) do { const char* kb_ = (const char*)Kh + (size_t)(t) * (64 * 256); const char* v0_ = (const char*)V0h + (size_t)(t) * (64 * 256); const char* v1_ = (const char*)V1h + (size_t)(t) * (64 * 256); \
    _Pragma("unroll") for (int i_ = 0; i_ < 2; ++i_) { \
      __builtin_amdgcn_global_load_lds((const unsigned*)(kb_ + i_ * 8192 + koff), (ATT_LAS unsigned*)(ldsl + A2_K + (kbuf) * 16384 + ldsw + i_ * 8192), 16, 0, 0); \
      __builtin_amdgcn_global_load_lds((const unsigned*)(v0_ + i_ * 8192 + voff), (ATT_LAS unsigned*)(ldsl + A2_V + (vbuf) * 32768 + ldsw + i_ * 8192), 16, 0, 0); \
      __builtin_amdgcn_global_load_lds((const unsigned*)(v1_ + i_ * 8192 + voff), (ATT_LAS unsigned*)(ldsl + A2_V + (vbuf) * 32768 + 16384 + ldsw + i_ * 8192), 16, 0, 0); } } while (0)
#define A2_SYNC() do { asm volatile("s_waitcnt vmcnt(0) lgkmcnt(0)" ::: "memory"); __builtin_amdgcn_s_barrier(); asm volatile("" ::: "memory"); } while (0)
  const int vb0 = (int)(uintptr_t)(lds + A2_V) + v_rd_base(lane);
  const int kad0 = (int)(uintptr_t)(lds + A2_K) + r32 * 256, ksw = (r32 & 7) << 4;
  const bool grpB = __builtin_amdgcn_readfirstlane(wid) >= 4;
  A2_DMA(0, 0, 0); A2_SYNC();
  int vc = 0, vp = 2, vn = 1;
  bf16x8 pa0, pa1, pa2, pa3;
  for (int j = 0; j < ntiles; ++j) {
    if (j + 1 < ntiles) A2_DMA((j + 1) & 1, vn, j + 1);
    SBAR();
    if (grpB && j > 0) { pv_pipe(o, vb0 + vp * 32768, pa0, pa1, pa2, pa3); }
    f32x16 p0, p1; float mn, alpha;
    qkt_pipe(p0, p1, kad0 + (j & 1) * 16384, ksw, hi, qr);
    partialSM(p0, p1, m_reg, mn, alpha);
    finishSM(p0, p1, alpha, l_reg, pa0, pa1, pa2, pa3); SBAR();
    if (__any(alpha < 1.f)) {
#pragma unroll
      for (int r = 0; r < 16; ++r) { const float a0_ = __uint_as_float(__builtin_amdgcn_readlane(__float_as_uint(alpha), crow(r, 0))), a1_ = __uint_as_float(__builtin_amdgcn_readlane(__float_as_uint(alpha), crow(r, 1)));
        const float ar = hi ? a1_ : a0_;
#pragma unroll
        for (int d = 0; d < 8; ++d) o[d][r] *= ar; } }
    if (!grpB) { pv_pipe(o, vb0 + vc * 32768, pa0, pa1, pa2, pa3); }
    A2_SYNC();
    vp = vc; vc = vn; vn = (vn == 2) ? 0 : vn + 1;
  }
  if (grpB) { pv_pipe(o, vb0 + vp * 32768, pa0, pa1, pa2, pa3); }
  { int t2 = threadIdx.x; asm volatile("" : "+v"(t2));
    const int wid2 = t2 >> 6, r32b = t2 & 31, hib = (t2 >> 5) & 1;
    float* li2 = (float*)(lds + A2_WS) + wid2 * 64;
    if (hib == 0) li2[r32b] = l_reg; asm volatile("s_waitcnt lgkmcnt(0)" ::: "memory");
    bf16* Ow = Ob + (long)(wid2 * QBLK) * LDO + r32b;
    if constexpr (MODE == 0) {
#pragma unroll
      for (int r = 0; r < 16; ++r) { const int orow = crow(r, hib); const float rl = __builtin_amdgcn_rcpf(li2[orow]);
#pragma unroll
        for (int d0 = 0; d0 < 8; ++d0) Ow[(long)orow * LDO + d0 * 32] = (bf16)(cvtpk(o[d0][r] * rl, 0.f) & 0xffffu); }
    } else {
      float sw[8];
#pragma unroll
      for (int d0 = 0; d0 < 8; ++d0) sw[d0] = subw[d0 * 32 + r32b] * osc;
      bf16* OAw = OAb + (long)(wid2 * QBLK) * 1024 + r32b;
#pragma unroll
      for (int r = 0; r < 16; ++r) { const int orow = crow(r, hib); const float rl = __builtin_amdgcn_rcpf(li2[orow]) * lam; float dv[8]; float ss = 0.f;
#pragma unroll
        for (int d0 = 0; d0 < 8; ++d0) { const float o0 = __uint_as_float(((unsigned)Ow[(long)orow * LDO + d0 * 32]) << 16); dv[d0] = o0 - o[d0][r] * rl; ss += dv[d0] * dv[d0]; }
#pragma unroll
        for (int sh = 1; sh < 32; sh <<= 1) ss += __shfl_xor(ss, sh);
        const float rs = __builtin_amdgcn_rsqf(ss * (1.0f / 256.0f) + eps);
#pragma unroll
        for (int d0 = 0; d0 < 8; ++d0) OAw[(long)orow * 1024 + d0 * 32] = (bf16)(cvtpk(dv[d0] * rs * sw[d0], 0.f) & 0xffffu); }
    } }
  A2_SYNC();
#undef A2_DMA
#undef A2_SYNC
}

typedef float f32x4a __attribute__((ext_vector_type(4)));
#if defined(ATT_CLUSTER_PRIO)
#define A3_PRIO(p) __builtin_amdgcn_s_setprio(p)
#else
#define A3_PRIO(p) do { } while (0)
#endif
__device__ __forceinline__ float xmax16(float v) { auto r = __builtin_amdgcn_permlane16_swap(__float_as_uint(v), __float_as_uint(v), false, false); return fmaxf(__uint_as_float(r[0]), __uint_as_float(r[1])); }
__device__ __forceinline__ float xmax32(float v) { auto r = __builtin_amdgcn_permlane32_swap(__float_as_uint(v), __float_as_uint(v), false, false); return fmaxf(__uint_as_float(r[0]), __uint_as_float(r[1])); }
__device__ __forceinline__ float xadd16(float v) { auto r = __builtin_amdgcn_permlane16_swap(__float_as_uint(v), __float_as_uint(v), false, false); return __uint_as_float(r[0]) + __uint_as_float(r[1]); }
__device__ __forceinline__ float xadd32(float v) { auto r = __builtin_amdgcn_permlane32_swap(__float_as_uint(v), __float_as_uint(v), false, false); return __uint_as_float(r[0]) + __uint_as_float(r[1]); }
__device__ __forceinline__ unsigned cvtpk_b(float lo, float hi) { typedef __bf16 bf2 __attribute__((ext_vector_type(2))); typedef float f2 __attribute__((ext_vector_type(2))); f2 v = {lo, hi}; bf2 b = __builtin_convertvector(v, bf2); return __builtin_bit_cast(unsigned, b); }
__device__ __forceinline__ void rows4(float x, int g, float (&out)[4]) {
#pragma unroll
  for (int j = 0; j < 4; ++j) { const float a0 = __uint_as_float(__builtin_amdgcn_readlane(__float_as_uint(x), j)), a1 = __uint_as_float(__builtin_amdgcn_readlane(__float_as_uint(x), 4 + j)),
      a2 = __uint_as_float(__builtin_amdgcn_readlane(__float_as_uint(x), 8 + j)), a3 = __uint_as_float(__builtin_amdgcn_readlane(__float_as_uint(x), 12 + j));
    out[j] = g == 0 ? a0 : g == 1 ? a1 : g == 2 ? a2 : a3; }
}
template <int OFF> __device__ __forceinline__ bf16x8 krd(int a) { bf16x8 r; asm volatile("ds_read_b128 %0, %1 offset:%2" : "=&v"(r) : "v"(a), "i"(OFF) : "memory"); return r; }
template <int MODE> __device__ __forceinline__ void attn256_unit16(const bf16* __restrict__ Qb, const bf16* __restrict__ Kh, const bf16* __restrict__ V0h, const bf16* __restrict__ V1h,
                                             bf16* Ob, int ntiles, char* lds, ATT_LAS unsigned char* ldsl, bf16* __restrict__ OAb, const float* __restrict__ subw, float lam, float eps, float osc) {
  constexpr float C = SCALE * 1.4426950408889634f;
  int tid = threadIdx.x; asm volatile("" : "+v"(tid));
  const int wid = tid >> 6, lane = tid & 63, q16 = lane & 15, g = lane >> 4;
  float m_reg[2] = {-1e30f, -1e30f}, l_reg[2] = {0.f, 0.f};
  f32x4a o[2][16];
#pragma unroll
  for (int a_ = 0; a_ < 2; ++a_)
#pragma unroll
    for (int b_ = 0; b_ < 16; ++b_) o[a_][b_] = (f32x4a){0.f, 0.f, 0.f, 0.f};
  bf16x8 qr[2][4];
  { const bf16* Qw = Qb + (long)(wid * 32 + q16) * 128 + g * 8;
#pragma unroll
    for (int qb = 0; qb < 2; ++qb)
#pragma unroll
      for (int s = 0; s < 4; ++s) qr[qb][s] = *reinterpret_cast<const bf16x8*>(Qw + qb * 16 * 128 + s * 32);
#pragma unroll
    for (int qb = 0; qb < 2; ++qb)
#pragma unroll
      for (int s = 0; s < 4; ++s) asm volatile("" : "+v"(qr[qb][s])); }
  unsigned koff, voff;
  { const int L = wid * 1024 + lane * 16;
    { const int row = L >> 8; koff = (unsigned)(row * 256 + ((L & 255) ^ ((row & 15) << 4))); }
    { const int sub = L >> 9, w = L & 511, kk = ((sub >> 2) << 3) | (w >> 6), k = (kk & ~0xC) | ((kk & 4) << 1) | ((kk & 8) >> 1), c = (sub & 3) * 32 + (((w & 63) ^ (((sub >> 2) & 1) << 5)) >> 1); voff = (unsigned)(k * 256 + c * 2); } }
  const unsigned ldsw = (unsigned)__builtin_amdgcn_readfirstlane(wid) * 1024u;
#define B3_DMA(kbuf, vbuf, t) do { const char* kb_ = (const char*)Kh + (size_t)(t) * (64 * 256); const char* v0_ = (const char*)V0h + (size_t)(t) * (64 * 256); const char* v1_ = (const char*)V1h + (size_t)(t) * (64 * 256); \
    _Pragma("unroll") for (int i_ = 0; i_ < 2; ++i_) { \
      __builtin_amdgcn_global_load_lds((const unsigned*)(kb_ + i_ * 8192 + koff), (ATT_LAS unsigned*)(ldsl + A2_K + (kbuf) * 16384 + ldsw + i_ * 8192), 16, 0, 0); \
      __builtin_amdgcn_global_load_lds((const unsigned*)(v0_ + i_ * 8192 + voff), (ATT_LAS unsigned*)(ldsl + A2_V + (vbuf) * 32768 + ldsw + i_ * 8192), 16, 0, 0); \
      __builtin_amdgcn_global_load_lds((const unsigned*)(v1_ + i_ * 8192 + voff), (ATT_LAS unsigned*)(ldsl + A2_V + (vbuf) * 32768 + 16384 + ldsw + i_ * 8192), 16, 0, 0); } } while (0)
#define B3_SYNC() do { asm volatile("s_waitcnt vmcnt(0) lgkmcnt(0)" ::: "memory"); __builtin_amdgcn_s_barrier(); asm volatile("" ::: "memory"); } while (0)
#define B3_WAITL(n) do { asm volatile("s_waitcnt lgkmcnt(" #n ")" ::: "memory"); SBAR(); } while (0)
  int ka[4];
#pragma unroll
  for (int s = 0; s < 4; ++s) ka[s] = (int)(uintptr_t)(lds + A2_K) + q16 * 256 + ((64 * s + 16 * g) ^ (q16 << 4));
  const int gs = ((g & 1) << 1) | (g >> 1);
  const int vbE = (int)(uintptr_t)(lds + A2_V) + (gs >> 1) * 2048 + ((q16 >> 2) + 4 * (gs & 1)) * 64 + 8 * (q16 & 3) + (g & 1) * 32, vbO = vbE + 32 - (g & 1) * 64;
#define VOFF(cb, m, t) ((t) * 4096 + (m) * 8192 + (((cb) & 7) >> 1) * 512 + ((cb) >> 3) * 16384)
  const bool grpB = __builtin_amdgcn_readfirstlane(wid) >= 4;
  B3_DMA(0, 0, 0); B3_SYNC();
#if defined(ATT_PRIO)
  if (grpB) __builtin_amdgcn_s_setprio(1);
#endif
  int vc = 0, vp = 2, vn = 1;
  bf16x8 pa[2][2];
#define PV_RD(cb, x0, x1, x2, x3, vb) do { const int vq_ = (((cb) & 1) ? vbO : vbE) + (vb); x0 = tr_read<VOFF(cb, 0, 0)>(vq_); x1 = tr_read<VOFF(cb, 0, 1)>(vq_); x2 = tr_read<VOFF(cb, 1, 0)>(vq_); x3 = tr_read<VOFF(cb, 1, 1)>(vq_); } while (0)
#define PKB(L, H) (bf16x8){L[0], L[1], L[2], L[3], H[0], H[1], H[2], H[3]}
#define PV_MM(cb, x0, x1, x2, x3) do { const bf16x8 b0_ = PKB(x0, x1), b1_ = PKB(x2, x3); \
    o[0][cb] = __builtin_amdgcn_mfma_f32_16x16x32_bf16(pa[0][0], b0_, o[0][cb], 0, 0, 0); o[1][cb] = __builtin_amdgcn_mfma_f32_16x16x32_bf16(pa[1][0], b0_, o[1][cb], 0, 0, 0); \
    o[0][cb] = __builtin_amdgcn_mfma_f32_16x16x32_bf16(pa[0][1], b1_, o[0][cb], 0, 0, 0); o[1][cb] = __builtin_amdgcn_mfma_f32_16x16x32_bf16(pa[1][1], b1_, o[1][cb], 0, 0, 0); } while (0)
#define PV_STEP(cb) B3_WAITL(4); PV_MM(cb, a0, a1, a2, a3); SBAR(); PV_RD(cb + 2, a0, a1, a2, a3, vb_); B3_WAITL(4); PV_MM(cb + 1, b0, b1, b2, b3); SBAR(); PV_RD(cb + 3, b0, b1, b2, b3, vb_);
#define PV_TILE(vbuf) do { const int vb_ = (vbuf) * 32768; s16x4 a0, a1, a2, a3, b0, b1, b2, b3; A3_PRIO(1); \
    PV_RD(0, a0, a1, a2, a3, vb_); PV_RD(1, b0, b1, b2, b3, vb_); \
    PV_STEP(0) PV_STEP(2) PV_STEP(4) PV_STEP(6) PV_STEP(8) PV_STEP(10) PV_STEP(12) \
    B3_WAITL(4); PV_MM(14, a0, a1, a2, a3); B3_WAITL(0); PV_MM(15, b0, b1, b2, b3); A3_PRIO(0); } while (0)
  for (int j = 0; j < ntiles; ++j) {
    if (j + 1 < ntiles) B3_DMA((j + 1) & 1, vn, j + 1);
    SBAR();
    if (grpB && j > 0) PV_TILE(vp);
    f32x4a sc[4][2];
#pragma unroll
    for (int kb = 0; kb < 4; ++kb) { sc[kb][0] = (f32x4a){0.f, 0.f, 0.f, 0.f}; sc[kb][1] = (f32x4a){0.f, 0.f, 0.f, 0.f}; }
    { const int kofs = (j & 1) * 16384; bf16x8 a0, a1, b0, b1;
#define QK_RD(kb, sp, x0, x1) do { x0 = krd<(kb) * 4096>(ka[2 * (sp)] + kofs); x1 = krd<(kb) * 4096>(ka[2 * (sp) + 1] + kofs); } while (0)
#define QK_MM(kb, sp, x0, x1) do { sc[kb][0] = __builtin_amdgcn_mfma_f32_16x16x32_bf16(x0, qr[0][2 * (sp)], sc[kb][0], 0, 0, 0); sc[kb][1] = __builtin_amdgcn_mfma_f32_16x16x32_bf16(x0, qr[1][2 * (sp)], sc[kb][1], 0, 0, 0); \
      sc[kb][0] = __builtin_amdgcn_mfma_f32_16x16x32_bf16(x1, qr[0][2 * (sp) + 1], sc[kb][0], 0, 0, 0); sc[kb][1] = __builtin_amdgcn_mfma_f32_16x16x32_bf16(x1, qr[1][2 * (sp) + 1], sc[kb][1], 0, 0, 0); } while (0)
      A3_PRIO(1); QK_RD(0, 0, a0, a1); QK_RD(0, 1, b0, b1);
      B3_WAITL(2); QK_MM(0, 0, a0, a1); SBAR(); QK_RD(1, 0, a0, a1);
      B3_WAITL(2); QK_MM(0, 1, b0, b1); SBAR(); QK_RD(1, 1, b0, b1);
      B3_WAITL(2); QK_MM(1, 0, a0, a1); SBAR(); QK_RD(2, 0, a0, a1);
      B3_WAITL(2); QK_MM(1, 1, b0, b1); SBAR(); QK_RD(2, 1, b0, b1);
      B3_WAITL(2); QK_MM(2, 0, a0, a1); SBAR(); QK_RD(3, 0, a0, a1);
      B3_WAITL(2); QK_MM(2, 1, b0, b1); SBAR(); QK_RD(3, 1, b0, b1);
      B3_WAITL(2); QK_MM(3, 0, a0, a1);
      B3_WAITL(0); QK_MM(3, 1, b0, b1); A3_PRIO(0);
#undef QK_RD
#undef QK_MM
    }
    float pm[2], alpha[2];
#pragma unroll
    for (int qb = 0; qb < 2; ++qb) { float v = sc[0][qb][0];
#pragma unroll
      for (int kb = 0; kb < 4; ++kb)
#pragma unroll
        for (int e = 0; e < 4; ++e) v = fmaxf(v, sc[kb][qb][e]);
      pm[qb] = xmax32(xmax16(v)); }
    if (__builtin_expect(__all(pm[0] - m_reg[0] <= THR / SCALE && pm[1] - m_reg[1] <= THR / SCALE), 1)) { alpha[0] = 1.f; alpha[1] = 1.f; }
    else {
#pragma unroll
      for (int qb = 0; qb < 2; ++qb) { const float mn = fmaxf(m_reg[qb], pm[qb]); alpha[qb] = __builtin_amdgcn_exp2f((m_reg[qb] - mn) * C); m_reg[qb] = mn; } }
#pragma unroll
    for (int qb = 0; qb < 2; ++qb) { const float mnC = -m_reg[qb] * C; float ps = 0.f;
#pragma unroll
      for (int kb = 0; kb < 4; ++kb) { sc[kb][qb] = sc[kb][qb] * C + mnC;
#pragma unroll
        for (int e = 0; e < 4; ++e) { sc[kb][qb][e] = __builtin_amdgcn_exp2f(sc[kb][qb][e]); ps += sc[kb][qb][e]; } }
      ps = xadd32(xadd16(ps));
      l_reg[qb] = l_reg[qb] * alpha[qb] + ps;
#pragma unroll
      for (int m = 0; m < 2; ++m) { u32x4 w = {cvtpk_b(sc[2 * m][qb][0], sc[2 * m][qb][1]), cvtpk_b(sc[2 * m][qb][2], sc[2 * m][qb][3]), cvtpk_b(sc[2 * m + 1][qb][0], sc[2 * m + 1][qb][1]), cvtpk_b(sc[2 * m + 1][qb][2], sc[2 * m + 1][qb][3])};
        pa[qb][m] = *reinterpret_cast<bf16x8*>(&w); } }
    SBAR();
    if (__any(alpha[0] < 1.f || alpha[1] < 1.f)) {
#pragma unroll
      for (int qb = 0; qb < 2; ++qb) { float ar[4]; rows4(alpha[qb], g, ar);
#pragma unroll
        for (int cb = 0; cb < 16; ++cb)
#pragma unroll
          for (int e = 0; e < 4; ++e) o[qb][cb][e] *= ar[e]; } }
    if (!grpB) PV_TILE(vc);
    B3_SYNC();
    vp = vc; vc = vn; vn = (vn == 2) ? 0 : vn + 1;
  }
  if (grpB) PV_TILE(vp);
#if defined(ATT_PRIO)
  __builtin_amdgcn_s_setprio(0);
#endif
  { int t2 = threadIdx.x; asm volatile("" : "+v"(t2));
    const int wid2 = t2 >> 6, c16 = t2 & 15, g2 = (t2 >> 4) & 3;
    bf16* Ow = Ob + (long)(wid2 * 32 + 4 * g2) * LDO + c16;
    float inv[2][4];
#pragma unroll
    for (int qb = 0; qb < 2; ++qb) { float lr[4]; rows4(l_reg[qb], g2, lr);
#pragma unroll
      for (int e = 0; e < 4; ++e) inv[qb][e] = __builtin_amdgcn_rcpf(lr[e]); }
    if constexpr (MODE == 0) {
#pragma unroll
      for (int qb = 0; qb < 2; ++qb)
#pragma unroll
        for (int e = 0; e < 4; ++e)
#pragma unroll
          for (int cb = 0; cb < 16; ++cb) Ow[(long)(qb * 16 + e) * LDO + cb * 16] = (bf16)(cvtpk_b(o[qb][cb][e] * inv[qb][e], 0.f) & 0xffffu);
    } else {
      float sw[16];
#pragma unroll
      for (int cb = 0; cb < 16; ++cb) sw[cb] = subw[cb * 16 + c16] * osc;
      bf16* OAw = OAb + (long)(wid2 * 32 + 4 * g2) * 1024 + c16;
#pragma unroll
      for (int qb = 0; qb < 2; ++qb)
#pragma unroll
        for (int e = 0; e < 4; ++e) { unsigned short of[16];
#pragma unroll
          for (int cb = 0; cb < 16; ++cb) of[cb] = Ow[(long)(qb * 16 + e) * LDO + cb * 16];
          asm volatile("" ::: "memory");
          float dv[16]; float ss = 0.f; const float rl = inv[qb][e] * lam;
#pragma unroll
          for (int cb = 0; cb < 16; ++cb) { dv[cb] = __uint_as_float(((unsigned)of[cb]) << 16) - o[qb][cb][e] * rl; ss += dv[cb] * dv[cb]; }
#pragma unroll
          for (int sh = 1; sh < 16; sh <<= 1) ss += __shfl_xor(ss, sh);
          const float rs = __builtin_amdgcn_rsqf(ss * (1.0f / 256.0f) + eps);
#pragma unroll
          for (int cb = 0; cb < 16; ++cb) OAw[(long)(qb * 16 + e) * 1024 + cb * 16] = (bf16)(cvtpk_b(dv[cb] * rs * sw[cb], 0.f) & 0xffffu);
          asm volatile("" ::: "memory"); }
    } }
  B3_SYNC();
#undef B3_DMA
#undef B3_SYNC
#undef B3_WAITL
#undef VOFF
#undef PV_RD
#undef PKB
#undef PV_MM
#undef PV_STEP
#undef PV_TILE
}

__device__ __forceinline__ void na_unit(const bf16* __restrict__ QKV, bf16* __restrict__ ON, const float* __restrict__ rpb, int b, int h, int rblk, char* lds) {
  constexpr float C = SCALE * 1.4426950408889634f, L2E = 1.4426950408889634f;
  const int tid = threadIdx.x, wid = tid >> 6, lane = tid & 63, r32 = lane & 31, hi = lane >> 5;
  bf16* V_lds = (bf16*)lds; bf16* K_lds = (bf16*)(lds + 2 * SHM_V);
  float* wsf = (float*)(lds + 2 * SHM_V + 2 * SHM_K) + wid * 64; float* li_l = wsf; float* al_l = wsf + 32;
  float* biasL = (float*)(lds + 2 * SHM_V + 2 * SHM_K + NW * 64 * 4);
  const int r = rblk * 4 + (wid >> 1), c = (wid & 1) * 32 + r32;
  const int rs = min(max(r - 4, 0), 120), cs = min(max(c - 8, 0), 48);
  bf16x8 qr[8];
  const bf16* const hb = QKV + ((long)b * 48 + h) * 8192 * 128;
  { const bf16* Qw = hb + (24L * 8192 + r * 64 + c) * 128 + hi * 8;
#pragma unroll
    for (int d0 = 0; d0 < 8; ++d0) qr[d0] = *reinterpret_cast<const bf16x8*>(Qw + d0 * 16); }
  for (int idx = tid; idx < 15 * 32; idx += 512) { const int dr = idx >> 5, dc = idx & 31; biasL[idx] = dc < 31 ? rpb[(h * 15 + dr) * 31 + dc] * L2E : 0.f; }
  const int kr_lo = min(max(rblk * 4 - 4, 0), 120), kr_hi = min(max(rblk * 4 + 3 - 4, 0), 120) + 7;
  const int sr = tid >> 4, sc = (tid & 15) * 8, vst0 = v_st(sr, sc), vst1 = v_st(32 + sr, sc);
  const int vb0 = (int)(uintptr_t)V_lds + v_rd_base(lane);
  float m_reg = -1e30f, l_reg = 0.f; f32x16 o[4] = {};
  const bf16* kp = hb + (32L * 8192 + kr_lo * 64 + sr) * 128 + sc;
  bf16x8 k0 = *reinterpret_cast<const bf16x8*>(kp), k1 = *reinterpret_cast<const bf16x8*>(kp + 32 * 128);
  bf16x8 v0 = *reinterpret_cast<const bf16x8*>(kp + 8L * 8192 * 128), v1 = *reinterpret_cast<const bf16x8*>(kp + 8L * 8192 * 128 + 32 * 128);
  for (int kr = kr_lo; kr <= kr_hi; ++kr) {
    const int bo = ((kr - kr_lo) & 1) * (int)SHM_V;
    *(bf16x8*)((char*)K_lds + bo + KSWZ(sr, sc * 2)) = k0; *(bf16x8*)((char*)K_lds + bo + KSWZ(32 + sr, sc * 2)) = k1;
    *(bf16x8*)((char*)V_lds + bo + vst0) = v0; *(bf16x8*)((char*)V_lds + bo + vst1) = v1;
    __syncthreads();
    if (kr < kr_hi) { kp += 64 * 128;
      k0 = *reinterpret_cast<const bf16x8*>(kp); k1 = *reinterpret_cast<const bf16x8*>(kp + 32 * 128);
      v0 = *reinterpret_cast<const bf16x8*>(kp + 8L * 8192 * 128); v1 = *reinterpret_cast<const bf16x8*>(kp + 8L * 8192 * 128 + 32 * 128); }
    if (kr >= rs && kr < rs + 8) {
      f32x16 p0, p1; qkt(p0, p1, (const bf16*)((const char*)K_lds + bo), qr, r32, hi);
      const float* bl = biasL + (kr - r + 7) * 32;
      float pmax = -INFINITY;
#pragma unroll
      for (int rr = 0; rr < 16; ++rr) { const int kc0 = crow(rr, hi), kc1 = kc0 + 32;
        const bool ok0 = (unsigned)(kc0 - cs) < 16u, ok1 = (unsigned)(kc1 - cs) < 16u;
        const float b0 = bl[ok0 ? kc0 - c + 15 : 0], b1 = bl[ok1 ? kc1 - c + 15 : 0];
        p0[rr] = ok0 ? fmaf(p0[rr], C, b0) : -INFINITY; p1[rr] = ok1 ? fmaf(p1[rr], C, b1) : -INFINITY;
        pmax = fmaxf(pmax, fmaxf(p0[rr], p1[rr])); }
      { auto t = __builtin_amdgcn_permlane32_swap(__float_as_uint(pmax), __float_as_uint(pmax), false, false);
        pmax = fmaxf(__uint_as_float(t[0]), __uint_as_float(t[1])); }
      const bool grow = !__all(pmax - m_reg <= 11.5f);
      float alpha = 1.f;
      if (grow) { const float mn = fmaxf(m_reg, pmax); alpha = __builtin_amdgcn_exp2f(m_reg - mn); m_reg = mn; }
      float ps = 0.f;
#pragma unroll
      for (int rr = 0; rr < 16; ++rr) { p0[rr] = __builtin_amdgcn_exp2f(p0[rr] - m_reg); p1[rr] = __builtin_amdgcn_exp2f(p1[rr] - m_reg); ps += p0[rr] + p1[rr]; }
      { auto t = __builtin_amdgcn_permlane32_swap(__float_as_uint(ps), __float_as_uint(ps), false, false);
        ps = __uint_as_float(t[0]) + __uint_as_float(t[1]); }
      l_reg = l_reg * alpha + ps;
      if (grow) { if (hi == 0) al_l[r32] = alpha; asm volatile("s_waitcnt lgkmcnt(0)" ::: "memory");
#pragma unroll
        for (int d = 0; d < 4; ++d)
#pragma unroll
          for (int rr = 0; rr < 16; ++rr) o[d][rr] *= al_l[crow(rr, hi)]; }
      bf16x8 pa0, pa1, pa2, pa3;
#define PK4(P, BASE, OUT) do { unsigned a0 = cvtpk(P[BASE + 0], P[BASE + 1]), a1 = cvtpk(P[BASE + 2], P[BASE + 3]);   \
    unsigned b0_ = cvtpk(P[BASE + 4], P[BASE + 5]), b1_ = cvtpk(P[BASE + 6], P[BASE + 7]);                              \
    auto r0 = __builtin_amdgcn_permlane32_swap(a0, b0_, false, false); auto r1 = __builtin_amdgcn_permlane32_swap(a1, b1_, false, false); \
    u32x4 w = {r0[0], r1[0], r0[1], r1[1]}; OUT = *reinterpret_cast<bf16x8*>(&w); } while (0)
      PK4(p0, 0, pa0); PK4(p0, 8, pa1); PK4(p1, 0, pa2); PK4(p1, 8, pa3);
#undef PK4
      pv_d0(o, vb0 + bo, pa0, pa1, pa2, pa3);
    }
  }
  if (hi == 0) li_l[r32] = l_reg; asm volatile("s_waitcnt lgkmcnt(0)" ::: "memory");
  bf16* Ow = ON + ((long)b * 8192 + r * 64 + (wid & 1) * 32) * 1024 + h * 128;
#pragma unroll
  for (int rr = 0; rr < 16; ++rr) { const int orow = crow(rr, hi); const float rl = __builtin_amdgcn_rcpf(li_l[orow]);
#pragma unroll
    for (int d0 = 0; d0 < 4; ++d0) Ow[(long)orow * 1024 + d0 * 32 + r32] = (bf16)(cvtpk(o[d0][rr] * rl, 0.f) & 0xffffu); }
  __syncthreads();
}
}

constexpr int NWAVES = 8;
constexpr int BATCH = 4, SEQ = 8192, DM = 2048, MTOK = BATCH * SEQ, DFF = 8192, NIN = 10240;
constexpr float EPS = 1e-6f;
constexpr size_t MiB = 1u << 20;
constexpr size_t WS_SS = 0;
constexpr size_t WS_ROPE = 0;
constexpr size_t WS_CTL = 4 * MiB, CTL_ZERO_BYTES = 262144, WS_CNT = WS_CTL + 65536;
constexpr size_t WS_WIN = 8 * MiB, WS_WA = 48 * MiB, WS_WB = 52 * MiB, WS_WOUT = 56 * MiB, WS_WUP = 64 * MiB, WS_WDN = 96 * MiB;
constexpr size_t WS_H1 = 128 * MiB;
constexpr size_t WS_ON = 128 * MiB, WS_OA = 192 * MiB, WS_H2 = 128 * MiB;
constexpr size_t WS_QKV = 256 * MiB;
constexpr size_t WS_T = 256 * MiB, WS_MX = 512 * MiB, WS_U = 256 * MiB;
constexpr size_t WS_G = 640 * MiB;
constexpr size_t WS_OD = 896 * MiB;
constexpr size_t WS_Y = 896 * MiB;
constexpr size_t WS_Y2 = 768 * MiB;
constexpr size_t WS_END = 1024 * MiB;
constexpr int LDS_BYTES = 147456, MISC_OFF = 131072 + 320;

typedef unsigned short bf16;
typedef float f32x4 __attribute__((ext_vector_type(4)));
typedef unsigned u32x4v __attribute__((ext_vector_type(4)));
typedef unsigned u32x2v __attribute__((ext_vector_type(2)));
#define LAS __attribute__((address_space(3)))
#define LDS_WAIT() asm volatile("s_waitcnt lgkmcnt(0)" ::: "memory")

__device__ __forceinline__ unsigned pk2(float lo, float hi) { return pg8::cvt_pk_bf16(lo, hi); }
__device__ __forceinline__ float wave_sum(float v) {
#pragma unroll
    for (int o = 1; o < 64; o <<= 1) v += __shfl_xor(v, o);
    return v;
}
template <bool ROPE> __device__ __forceinline__ void p0_transpose_item(const float* W, int K, int N, bf16* WT, LAS float* scr, int item, int lane) {
    const int nblk = N / 32, kb = item / nblk, nb = item % nblk, k0 = 64 * kb, n0 = 32 * nb;
    f32x4 wv[8];
#pragma unroll
    for (int i = 0; i < 8; ++i) wv[i] = *(const f32x4*)(W + (size_t)(k0 + 8 * i + (lane >> 3)) * N + n0 + (lane & 7) * 4);
#pragma unroll
    for (int i = 0; i < 8; ++i) { LAS float* d = scr + (8 * i + (lane >> 3)) * 33 + (lane & 7) * 4; d[0] = wv[i].x; d[1] = wv[i].y; d[2] = wv[i].z; d[3] = wv[i].w; }
    LDS_WAIT(); asm volatile("" ::: "memory");
    const int c = lane & 7;
#pragma unroll
    for (int j = 0; j < 4; ++j) { const int n = (lane >> 3) + 8 * j; const LAS float* s = scr + (8 * c) * 33 + n;
        u32x4v o; o.x = pk2(s[0 * 33], s[1 * 33]); o.y = pk2(s[2 * 33], s[3 * 33]); o.z = pk2(s[4 * 33], s[5 * 33]); o.w = pk2(s[6 * 33], s[7 * 33]);
        int dn = n0 + n;
        if (ROPE && dn < 2048) { const int jj = dn & 127; dn = (dn & ~127) + (jj < 64 ? 2 * jj : 2 * (jj - 64) + 1); }
        *(u32x4v*)(WT + (size_t)dn * K + k0 + 8 * c) = o; }
    LDS_WAIT(); asm volatile("" ::: "memory");
}

#define XB_TMO      128
#define XB_XCNT(j)  (256  + 64 * (j))
#define XB_XSUB(j)  (1280 + 64 * (j))
#define XB_XGEN(j)  (2304 + 64 * (j))
#define XB_TOP      3328
#define XB_TOPGEN   3392
#define XCD_BAR_WORDS 3456
#define XB_SPIN_CAP (1u << 18)

__device__ __forceinline__ unsigned xb_ld(unsigned* p)              { return __hip_atomic_load(p, __ATOMIC_RELAXED, __HIP_MEMORY_SCOPE_AGENT); }
__device__ __forceinline__ unsigned xb_add(unsigned* p, unsigned v) { return __hip_atomic_fetch_add(p, v, __ATOMIC_RELAXED, __HIP_MEMORY_SCOPE_AGENT); }
__device__ __forceinline__ unsigned xb_xcc_id() { return (unsigned)__builtin_amdgcn_s_getreg((3 << 11) | 20) & 0xFu; }
#define XB_SPIN(cond, bar) do { unsigned _sp = 0; while (cond) { __builtin_amdgcn_s_sleep(1); \
    if ((++_sp & 255u) == 0u) { if (xb_ld(&(bar)[XB_TMO])) break; if (_sp > XB_SPIN_CAP) { atomicAdd(&(bar)[XB_TMO], 1u); break; } } } } while (0)

struct XcdBarrier {
    unsigned* bar; unsigned x;
    volatile LAS unsigned* st;
};

__device__ __forceinline__ XcdBarrier xcd_barrier_post(unsigned* bar, volatile LAS unsigned* st) {
    XcdBarrier b; b.bar = bar; b.x = xb_xcc_id(); b.st = st;
    if (threadIdx.x == 0) (void)xb_add(&bar[XB_XCNT(b.x)], 1u);
    return b;
}
__device__ __forceinline__ void xcd_barrier_complete(unsigned* bar, unsigned x, unsigned& nloc, unsigned& nx) {
    const unsigned G = gridDim.x * gridDim.y * gridDim.z;
    unsigned sum, cnt, mine, sp = 0u;
    for (;;) {
        sum = 0u; cnt = 0u; mine = 0u;
#pragma unroll
        for (unsigned j = 0; j < 16; ++j) { const unsigned c = xb_ld(&bar[XB_XCNT(j)]); sum += c; cnt += (c > 0u) ? 1u : 0u; mine = (j == x) ? c : mine; }
        if (sum == G) break;
        __builtin_amdgcn_s_sleep(1);
        if ((++sp & 255u) == 0u) { if (xb_ld(&bar[XB_TMO])) break; if (sp > XB_SPIN_CAP) { atomicAdd(&bar[XB_TMO], 1u); break; } }
    }
    nloc = mine > 0u ? mine : 1u; nx = cnt > 0u ? cnt : 1u;
}

__device__ __forceinline__ void xcd_barrier(const XcdBarrier& b) {
    asm volatile("s_waitcnt vmcnt(0)" ::: "memory");
    __syncthreads();
    if (threadIdx.x == 0) {
        unsigned* bar = b.bar;
        __builtin_amdgcn_s_waitcnt(0);
        unsigned nloc = b.st[0], nx = b.st[1];
        if (nloc == 0u) { xcd_barrier_complete(bar, b.x, nloc, nx); b.st[0] = nloc; b.st[1] = nx; }
        const unsigned old = xb_add(&bar[XB_XSUB(b.x)], 1u);
        const unsigned gen = old / nloc;
        if (old + 1u == (gen + 1u) * nloc) {
            __builtin_amdgcn_fence(__ATOMIC_RELEASE, "agent");
            asm volatile("s_waitcnt vmcnt(0)" ::: "memory");
            const unsigned og = xb_add(&bar[XB_TOP], 1u);
            const unsigned tg = og / nx;
            if (og + 1u == (tg + 1u) * nx) xb_add(&bar[XB_TOPGEN], 1u);
            else XB_SPIN(xb_ld(&bar[XB_TOPGEN]) == tg, bar);
            __builtin_amdgcn_fence(__ATOMIC_ACQUIRE, "agent");
            xb_add(&bar[XB_XGEN(b.x)], 1u);
            asm volatile("s_waitcnt vmcnt(0)" ::: "memory");
        } else {
            XB_SPIN(xb_ld(&bar[XB_XGEN(b.x)]) == gen, bar);
            __builtin_amdgcn_fence(__ATOMIC_ACQUIRE, "agent");
            asm volatile("s_waitcnt vmcnt(0)" ::: "memory");
        }
    }
    __syncthreads();
}

#ifndef REP_OTHERS
#define REP_OTHERS 1
#endif
#if defined(ATT_MFMA32)
#define ATT_UNIT attn256_unit
#else
#define ATT_UNIT attn256_unit16
#endif
struct Args { const float* in[17]; float* out; unsigned char* ws; int ph_lo, ph_hi; };

__global__ void __launch_bounds__(NWAVES * 64, 2) mk_fwd(Args a) {
    extern __shared__ __attribute__((aligned(16))) unsigned char lds[];
    cg::grid_group grid = cg::this_grid();
#define tid ((int)threadIdx.x)
#define lane (tid & 63)
#define wave (__builtin_amdgcn_readfirstlane(tid >> 6))
#define G ((int)gridDim.x)
#define gw ((int)blockIdx.x * NWAVES + wave)
#define NGW (G * NWAVES)
    unsigned char* const ws = a.ws;
#define x_in (a.in[0])
#define out_p (a.out)
#define SS ((float*)(ws + WS_SS))
#define ropeC ((float*)(ws + WS_ROPE))
#define ropeS (ropeC + 8192 * 64)
#define Win_t ((bf16*)(ws + WS_WIN))
#define Wa_t ((bf16*)(ws + WS_WA))
#define Wb_t ((bf16*)(ws + WS_WB))
#define Wout_t ((bf16*)(ws + WS_WOUT))
#define Wup_t ((bf16*)(ws + WS_WUP))
#define Wdn_t ((bf16*)(ws + WS_WDN))
#define H1 ((bf16*)(ws + WS_H1))
#define ONb ((bf16*)(ws + WS_ON))
#define OAb ((bf16*)(ws + WS_OA))
#define H2 ((bf16*)(ws + WS_H2))
#define QKV ((bf16*)(ws + WS_QKV))
#define Tb ((bf16*)(ws + WS_T))
#define MX ((bf16*)(ws + WS_MX))
#define Ub ((bf16*)(ws + WS_U))
#define Gb ((bf16*)(ws + WS_G))
#define OD ((bf16*)(ws + WS_OD))
#define Yb ((bf16*)(ws + WS_Y))
#define Y2 ((bf16*)(ws + WS_Y2))
    const int lo = a.ph_lo, hi = a.ph_hi;
    for (int u = tid; u < (LDS_BYTES - 131072) / 4; u += NWAVES * 64) ((LAS unsigned*)((LAS unsigned char*)lds + 131072))[u] = 0u;
    __syncthreads();
    XcdBarrier bar = xcd_barrier_post((unsigned*)(ws + WS_CTL), (volatile LAS unsigned*)((LAS unsigned char*)lds + MISC_OFF) + 8);
    grid.sync();
#ifndef PHMASK
#define PHMASK 0x3ff
#endif
#define IN(k) (((PHMASK >> (k)) & 1) && lo <= (k) && (k) < hi)
#define SEAM(k) do { if (lo <= (k) && (k) + 1 < hi) xcd_barrier(bar); } while (0)

    if (IN(0)) {
        LAS float* scr = (LAS float*)((LAS unsigned char*)lds + wave * 16384);
        constexpr int I_IN = (DM / 64) * (NIN / 32), I_A = (1024 / 64) * (DM / 32), I_O = (DM / 64) * (DM / 32), I_UP = (DM / 64) * (DFF / 32), I_DN = (DFF / 64) * (DM / 32);
        constexpr int NITEMS = I_IN + 2 * I_A + I_O + I_UP + I_DN;
        for (int it = gw; it < NITEMS; it += NGW) {
            int r = it;
            if (r < I_IN) { p0_transpose_item<true>(a.in[1], DM, NIN, Win_t, scr, r, lane); continue; } r -= I_IN;
            if (r < I_A) { p0_transpose_item<false>(a.in[2], 1024, DM, Wa_t, scr, r, lane); continue; } r -= I_A;
            if (r < I_A) { p0_transpose_item<false>(a.in[3], 1024, DM, Wb_t, scr, r, lane); continue; } r -= I_A;
            if (r < I_O) { p0_transpose_item<false>(a.in[4], DM, DM, Wout_t, scr, r, lane); continue; } r -= I_O;
            if (r < I_UP) { p0_transpose_item<false>(a.in[15], DM, DFF, Wup_t, scr, r, lane); continue; } r -= I_UP;
            p0_transpose_item<false>(a.in[16], DFF, DM, Wdn_t, scr, r, lane);
        }
        for (int e = blockIdx.x * 512 + tid; e < 8192 * 64; e += G * 512) {
            const int pos = e >> 6, i = e & 63;
            const float inv = (float)exp(-(double)i * (9.210340371976184 / 64.0));
            const float ang = (float)pos * inv;
            const double t = (double)ang * 0.15915494309189535; const float fr = (float)(t - rint(t));
            ropeC[e] = __builtin_amdgcn_cosf(fr); ropeS[e] = __builtin_amdgcn_sinf(fr);
        }
        const float* g0 = a.in[5];
        f32x4 g0v[8];
#pragma unroll
        for (int j = 0; j < 8; ++j) g0v[j] = ((const f32x4*)g0)[lane + 64 * j];
        for (int m0 = gw; m0 < MTOK; m0 += 2 * NGW) {
            f32x4 v[2][8]; float s[2] = {0.f, 0.f};
#pragma unroll
            for (int q = 0; q < 2; ++q) { const f32x4* xr = (const f32x4*)(x_in + (size_t)(m0 + q * NGW) * DM) + lane;
#pragma unroll
                for (int j = 0; j < 8; ++j) v[q][j] = xr[64 * j]; }
#pragma unroll
            for (int q = 0; q < 2; ++q)
#pragma unroll
                for (int j = 0; j < 8; ++j) s[q] += (v[q][j].x * v[q][j].x + v[q][j].y * v[q][j].y) + (v[q][j].z * v[q][j].z + v[q][j].w * v[q][j].w);
#pragma unroll
            for (int q = 0; q < 2; ++q) { const float rstd = __builtin_amdgcn_rsqf(wave_sum(s[q]) * (1.f / DM) + EPS);
                u32x2v* o8 = (u32x2v*)(H1 + (size_t)(m0 + q * NGW) * DM) + lane;
#pragma unroll
                for (int j = 0; j < 8; ++j) { const f32x4 gv = g0v[j]; u32x2v w; w.x = pk2(v[q][j].x * rstd * gv.x, v[q][j].y * rstd * gv.y); w.y = pk2(v[q][j].z * rstd * gv.z, v[q][j].w * rstd * gv.w); o8[64 * j] = w; } }
        }
    }
#if defined(REP_P0)
    __syncthreads();
    if (IN(0)) {
        LAS float* scr = (LAS float*)((LAS unsigned char*)lds + wave * 16384);
        constexpr int I_IN = (DM / 64) * (NIN / 32), I_A = (1024 / 64) * (DM / 32), I_O = (DM / 64) * (DM / 32), I_UP = (DM / 64) * (DFF / 32), I_DN = (DFF / 64) * (DM / 32);
        constexpr int NITEMS = I_IN + 2 * I_A + I_O + I_UP + I_DN;
        for (int it = gw; it < NITEMS; it += NGW) {
            int r = it;
            if (r < I_IN) { p0_transpose_item<true>(a.in[1], DM, NIN, Win_t, scr, r, lane); continue; } r -= I_IN;
            if (r < I_A) { p0_transpose_item<false>(a.in[2], 1024, DM, Wa_t, scr, r, lane); continue; } r -= I_A;
            if (r < I_A) { p0_transpose_item<false>(a.in[3], 1024, DM, Wb_t, scr, r, lane); continue; } r -= I_A;
            if (r < I_O) { p0_transpose_item<false>(a.in[4], DM, DM, Wout_t, scr, r, lane); continue; } r -= I_O;
            if (r < I_UP) { p0_transpose_item<false>(a.in[15], DM, DFF, Wup_t, scr, r, lane); continue; } r -= I_UP;
            p0_transpose_item<false>(a.in[16], DFF, DM, Wdn_t, scr, r, lane);
        }
        for (int e = blockIdx.x * 512 + tid; e < 8192 * 64; e += G * 512) {
            const int pos = e >> 6, i = e & 63;
            const float inv = (float)exp(-(double)i * (9.210340371976184 / 64.0));
            const float ang = (float)pos * inv;
            const double t = (double)ang * 0.15915494309189535; const float fr = (float)(t - rint(t));
            ropeC[e] = __builtin_amdgcn_cosf(fr); ropeS[e] = __builtin_amdgcn_sinf(fr);
        }
        const float* g0 = a.in[5];
        f32x4 g0v[8];
#pragma unroll
        for (int j = 0; j < 8; ++j) g0v[j] = ((const f32x4*)g0)[lane + 64 * j];
        for (int m0 = gw; m0 < MTOK; m0 += 2 * NGW) {
            f32x4 v[2][8]; float s[2] = {0.f, 0.f};
#pragma unroll
            for (int q = 0; q < 2; ++q) { const f32x4* xr = (const f32x4*)(x_in + (size_t)(m0 + q * NGW) * DM) + lane;
#pragma unroll
                for (int j = 0; j < 8; ++j) v[q][j] = xr[64 * j]; }
#pragma unroll
            for (int q = 0; q < 2; ++q)
#pragma unroll
                for (int j = 0; j < 8; ++j) s[q] += (v[q][j].x * v[q][j].x + v[q][j].y * v[q][j].y) + (v[q][j].z * v[q][j].z + v[q][j].w * v[q][j].w);
#pragma unroll
            for (int q = 0; q < 2; ++q) { const float rstd = __builtin_amdgcn_rsqf(wave_sum(s[q]) * (1.f / DM) + EPS);
                u32x2v* o8 = (u32x2v*)(H1 + (size_t)(m0 + q * NGW) * DM) + lane;
#pragma unroll
                for (int j = 0; j < 8; ++j) { const f32x4 gv = g0v[j]; u32x2v w; w.x = pk2(v[q][j].x * rstd * gv.x, v[q][j].y * rstd * gv.y); w.y = pk2(v[q][j].z * rstd * gv.z, v[q][j].w * rstd * gv.w); o8[64 * j] = w; } }
        }
    }
#endif
    SEAM(0);
#if defined(REP_BAR)
    for (int rb = 0; rb < 20; ++rb) xcd_barrier(bar);
#endif
    if (IN(1)) {
#if defined(STAGGER_US)
        { const unsigned long long t0_ = __builtin_amdgcn_s_memrealtime(), dt_ = (unsigned long long)(((blockIdx.x >> 3) & 15) * (STAGGER_US * 100 / 16));
          while (__builtin_amdgcn_s_memrealtime() - t0_ < dt_) __builtin_amdgcn_s_sleep(8); }
#endif
        pg8::Gemm g{H1, Win_t, MTOK, NIN, DM}; pg8::StaticOrder S; S.init(MTOK, NIN, G, (int)blockIdx.x);
        pg8::EpiProj E{QKV, Gb, ropeC, ropeS};
        pg8::gemm_phase<pg8::EpiProj, pg8::StaticOrder, true, true>((LAS unsigned char*)lds, g, S, E);
    }
#if defined(REP_P1)
    __syncthreads();
    if (IN(1)) {
        pg8::Gemm g{H1, Win_t, MTOK, NIN, DM}; pg8::StaticOrder S; S.init(MTOK, NIN, G, (int)blockIdx.x);
        pg8::EpiProj E{QKV, Gb, ropeC, ropeS};
        pg8::gemm_phase<pg8::EpiProj, pg8::StaticOrder, true, true>((LAS unsigned char*)lds, g, S, E);
    }
#endif
    SEAM(1);
#if defined(DBG_STOP)
#define DBG_DUMP(k, off_mib, nseg) do { if (DBG_STOP == (k)) { xcd_barrier(bar); const bf16* rg = (const bf16*)(ws + (size_t)(off_mib) * MiB); \
        for (size_t i = (size_t)blockIdx.x * 512 + tid; i < (size_t)MTOK * DM; i += (size_t)G * 512) { float acc_ = 0.f; for (int sg = 0; sg < (nseg); ++sg) acc_ += __uint_as_float(((unsigned)rg[i + (size_t)sg * MTOK * DM]) << 16); out_p[i] = acc_; } return; } } while (0)
#else
#define DBG_DUMP(k, off_mib, nseg) do { } while (0)
#endif
    DBG_DUMP(1, 256, 5);
    DBG_DUMP(11, 256, 3);
    DBG_DUMP(12, 640, 2);
    if (IN(2)) {
#if !defined(ATT_D128X4)
        { int ntl = SEQ / 64; asm volatile("" : "+s"(ntl));
        const float s1_ = wave_sum(a.in[9][lane] * a.in[10][lane] + a.in[9][lane + 64] * a.in[10][lane + 64]);
        const float s2_ = wave_sum(a.in[11][lane] * a.in[12][lane] + a.in[11][lane + 64] * a.in[12][lane + 64]);
        const float lam_ = __uint_as_float(__builtin_amdgcn_readfirstlane(__float_as_uint(__builtin_amdgcn_exp2f(s1_ * 1.4426950408889634f) - __builtin_amdgcn_exp2f(s2_ * 1.4426950408889634f) + 0.2f)));
        for (int u = blockIdx.x; u < 512; u += G) {
            const int xs = u & 7, qb = (u >> 3) & 31, combo = (u >> 8) * 8 + xs, b = combo >> 2, h = combo & 3;
            const bf16* base = QKV + (size_t)b * 48 * SEQ * 128; bf16* odp = OD + ((size_t)b * SEQ + qb * 256) * 2048 + h * 512; bf16* oap = OAb + ((size_t)b * SEQ + qb * 256) * 1024 + h * 256;
            att::ATT_UNIT<0>(base + ((size_t)(2 * h) * SEQ + qb * 256) * 128, base + (size_t)(8 + 2 * h) * SEQ * 128, base + (size_t)(16 + 2 * h) * SEQ * 128, base + (size_t)(17 + 2 * h) * SEQ * 128,
                                 odp, ntl, (char*)lds, (LAS unsigned char*)lds, oap, a.in[13], lam_, EPS, 0.8f);
            att::ATT_UNIT<1>(base + ((size_t)(2 * h + 1) * SEQ + qb * 256) * 128, base + (size_t)(9 + 2 * h) * SEQ * 128, base + (size_t)(16 + 2 * h) * SEQ * 128, base + (size_t)(17 + 2 * h) * SEQ * 128,
                                 odp, ntl, (char*)lds, (LAS unsigned char*)lds, oap, a.in[13], lam_, EPS, 0.8f);
        }
#if defined(REP_ATT)
        for (int u = blockIdx.x; u < 512; u += G) {
            const int xs = u & 7, qb = (u >> 3) & 31, combo = (u >> 8) * 8 + xs, b = combo >> 2, h = combo & 3;
            const bf16* base = QKV + (size_t)b * 48 * SEQ * 128; bf16* odp = OD + ((size_t)b * SEQ + qb * 256) * 2048 + h * 512; bf16* oap = OAb + ((size_t)b * SEQ + qb * 256) * 1024 + h * 256;
            att::ATT_UNIT<0>(base + ((size_t)(2 * h) * SEQ + qb * 256) * 128, base + (size_t)(8 + 2 * h) * SEQ * 128, base + (size_t)(16 + 2 * h) * SEQ * 128, base + (size_t)(17 + 2 * h) * SEQ * 128,
                                 odp, ntl, (char*)lds, (LAS unsigned char*)lds, oap, a.in[13], lam_, EPS, 0.8f);
            att::ATT_UNIT<1>(base + ((size_t)(2 * h + 1) * SEQ + qb * 256) * 128, base + (size_t)(9 + 2 * h) * SEQ * 128, base + (size_t)(16 + 2 * h) * SEQ * 128, base + (size_t)(17 + 2 * h) * SEQ * 128,
                                 odp, ntl, (char*)lds, (LAS unsigned char*)lds, oap, a.in[13], lam_, EPS, 0.8f);
        }
#endif
        }
#else
#ifndef NO_DENSE
        int seqv = SEQ; asm volatile("" : "+s"(seqv));
        for (int u = blockIdx.x; u < 2048; u += G) {
            const int xs = u & 7, qb = (u >> 3) & 31, combo = (u >> 8) * 8 + xs, b = combo >> 4, vh = combo & 15, h = vh >> 2, c = (vh >> 1) & 1, hf = vh & 1;
            const bf16* base = QKV + (size_t)b * 48 * SEQ * 128;
            att::attn_dense_body<bf16>(base + ((size_t)(h * 2 + c) * SEQ + qb * 256) * 128, base + (size_t)(8 + h * 2 + c) * SEQ * 128, base + (size_t)(16 + h * 2 + hf) * SEQ * 128,
                                       OD + ((size_t)b * SEQ + qb * 256) * 2048 + vh * 128, seqv, (char*)lds);
            __syncthreads();
        }
#if defined(REP_DENSE)
        int seqv2 = SEQ; asm volatile("" : "+s"(seqv2));
        for (int u = blockIdx.x; u < 2048; u += G) {
            const int xs = u & 7, qb = (u >> 3) & 31, combo = (u >> 8) * 8 + xs, b = combo >> 4, vh = combo & 15, h = vh >> 2, c = (vh >> 1) & 1, hf = vh & 1;
            const bf16* base = QKV + (size_t)b * 48 * SEQ * 128;
            att::attn_dense_body<bf16>(base + ((size_t)(h * 2 + c) * SEQ + qb * 256) * 128, base + (size_t)(8 + h * 2 + c) * SEQ * 128, base + (size_t)(16 + h * 2 + hf) * SEQ * 128,
                                       OD + ((size_t)b * SEQ + qb * 256) * 2048 + vh * 128, seqv2, (char*)lds);
            __syncthreads();
        }
#endif
#endif
#endif
#ifndef NO_NA
            for (int u = blockIdx.x; u < 1024; u += G) {
            const int xs = u & 7, rb = (u >> 3) & 31, combo = (u >> 8) * 8 + xs, b = combo >> 3, h = combo & 7;
            att::na_unit(QKV, ONb, a.in[14], b, h, rb, (char*)lds);
        }
#if defined(REP_NA)
            for (int u = blockIdx.x; u < 1024; u += G) {
            const int xs = u & 7, rb = (u >> 3) & 31, combo = (u >> 8) * 8 + xs, b = combo >> 3, h = combo & 7;
            att::na_unit(QKV, ONb, a.in[14], b, h, rb, (char*)lds);
        }
#endif
#endif
    }
    SEAM(2);
    DBG_DUMP(2, 896, 1);
    DBG_DUMP(22, 128, 1);
#if defined(ATT_D128X4)
    if (IN(3)) {
        const float s1 = wave_sum(a.in[9][lane] * a.in[10][lane] + a.in[9][lane + 64] * a.in[10][lane + 64]);
        const float s2 = wave_sum(a.in[11][lane] * a.in[12][lane] + a.in[11][lane + 64] * a.in[12][lane + 64]);
        const float lam = __builtin_amdgcn_exp2f(s1 * 1.4426950408889634f) - __builtin_amdgcn_exp2f(s2 * 1.4426950408889634f) + 0.2f;
        const f32x4 sw = ((const f32x4*)a.in[13])[lane];
        for (int m = gw; m < MTOK; m += NGW) {
#pragma unroll
            for (int h = 0; h < 4; ++h) {
                const bf16* od = OD + (size_t)m * 2048 + h * 512 + 4 * lane;
                const u32x2v p = *(const u32x2v*)od, q = *(const u32x2v*)(od + 256);
                f32x4 d;
                d.x = __uint_as_float(p.x << 16) - lam * __uint_as_float(q.x << 16); d.y = __uint_as_float(p.x & 0xffff0000u) - lam * __uint_as_float(q.x & 0xffff0000u);
                d.z = __uint_as_float(p.y << 16) - lam * __uint_as_float(q.y << 16); d.w = __uint_as_float(p.y & 0xffff0000u) - lam * __uint_as_float(q.y & 0xffff0000u);
                const float rstd = __builtin_amdgcn_rsqf(wave_sum((d.x * d.x + d.y * d.y) + (d.z * d.z + d.w * d.w)) * (1.f / 256.f) + EPS) * 0.8f;
                u32x2v w; w.x = pk2(d.x * rstd * sw.x, d.y * rstd * sw.y); w.y = pk2(d.z * rstd * sw.z, d.w * rstd * sw.w);
                *(u32x2v*)(OAb + (size_t)m * 1024 + h * 256 + 4 * lane) = w;
            }
        }
    }
#if defined(REP_P3)
    __syncthreads();
    if (IN(3)) {
        const float s1 = wave_sum(a.in[9][lane] * a.in[10][lane] + a.in[9][lane + 64] * a.in[10][lane + 64]);
        const float s2 = wave_sum(a.in[11][lane] * a.in[12][lane] + a.in[11][lane + 64] * a.in[12][lane + 64]);
        const float lam = __builtin_amdgcn_exp2f(s1 * 1.4426950408889634f) - __builtin_amdgcn_exp2f(s2 * 1.4426950408889634f) + 0.2f;
        const f32x4 sw = ((const f32x4*)a.in[13])[lane];
        for (int m = gw; m < MTOK; m += NGW) {
#pragma unroll
            for (int h = 0; h < 4; ++h) {
                const bf16* od = OD + (size_t)m * 2048 + h * 512 + 4 * lane;
                const u32x2v p = *(const u32x2v*)od, q = *(const u32x2v*)(od + 256);
                f32x4 d;
                d.x = __uint_as_float(p.x << 16) - lam * __uint_as_float(q.x << 16); d.y = __uint_as_float(p.x & 0xffff0000u) - lam * __uint_as_float(q.x & 0xffff0000u);
                d.z = __uint_as_float(p.y << 16) - lam * __uint_as_float(q.y << 16); d.w = __uint_as_float(p.y & 0xffff0000u) - lam * __uint_as_float(q.y & 0xffff0000u);
                const float rstd = __builtin_amdgcn_rsqf(wave_sum((d.x * d.x + d.y * d.y) + (d.z * d.z + d.w * d.w)) * (1.f / 256.f) + EPS) * 0.8f;
                u32x2v w; w.x = pk2(d.x * rstd * sw.x, d.y * rstd * sw.y); w.y = pk2(d.z * rstd * sw.z, d.w * rstd * sw.w);
                *(u32x2v*)(OAb + (size_t)m * 1024 + h * 256 + 4 * lane) = w;
            }
        }
    }
#endif
    SEAM(3);
#endif
    DBG_DUMP(3, 128, 1);
    if (IN(4)) {
        { pg8::Gemm g{OAb, Wa_t, MTOK, DM, 1024}; pg8::StaticOrder S; S.init(MTOK, DM, G, (int)blockIdx.x);
          pg8::EpiBranch<0> E{Gb, Tb, MX};
          pg8::gemm_phase<pg8::EpiBranch<0>, pg8::StaticOrder, true, true>((LAS unsigned char*)lds, g, S, E); }
        asm volatile("s_waitcnt vmcnt(0)" ::: "memory"); __syncthreads();
        { pg8::Gemm g{ONb, Wb_t, MTOK, DM, 1024}; pg8::StaticOrder S; S.init(MTOK, DM, G, (int)blockIdx.x);
          pg8::EpiBranch<1> E{Gb, Tb, MX};
          pg8::gemm_phase<pg8::EpiBranch<1>, pg8::StaticOrder, true, true>((LAS unsigned char*)lds, g, S, E); }
    }
#if defined(REP_P4)
    __syncthreads();
    if (IN(4)) {
        { pg8::Gemm g{OAb, Wa_t, MTOK, DM, 1024}; pg8::StaticOrder S; S.init(MTOK, DM, G, (int)blockIdx.x);
          pg8::EpiBranch<0> E{Gb, Tb, MX};
          pg8::gemm_phase<pg8::EpiBranch<0>, pg8::StaticOrder, true, true>((LAS unsigned char*)lds, g, S, E); }
        asm volatile("s_waitcnt vmcnt(0)" ::: "memory"); __syncthreads();
        { pg8::Gemm g{ONb, Wb_t, MTOK, DM, 1024}; pg8::StaticOrder S; S.init(MTOK, DM, G, (int)blockIdx.x);
          pg8::EpiBranch<1> E{Gb, Tb, MX};
          pg8::gemm_phase<pg8::EpiBranch<1>, pg8::StaticOrder, true, true>((LAS unsigned char*)lds, g, S, E); }
    }
#endif
    SEAM(4);
    DBG_DUMP(4, 512, 1);
    DBG_DUMP(41, 256, 2);
    if (IN(5)) {
        pg8::Gemm g{MX, Wout_t, MTOK, DM, DM}; pg8::StaticOrder S; S.init(MTOK, DM, G, (int)blockIdx.x);
        pg8::EpiYss<bf16> E{Yb, SS};
        pg8::gemm_phase<pg8::EpiYss<bf16>, pg8::StaticOrder, true, true>((LAS unsigned char*)lds, g, S, E);
    }
#if defined(REP_P5)
    __syncthreads();
    if (IN(5)) {
        pg8::Gemm g{MX, Wout_t, MTOK, DM, DM}; pg8::StaticOrder S; S.init(MTOK, DM, G, (int)blockIdx.x);
        pg8::EpiYss<bf16> E{Yb, SS};
        pg8::gemm_phase<pg8::EpiYss<bf16>, pg8::StaticOrder, true, true>((LAS unsigned char*)lds, g, S, E);
    }
#endif
    SEAM(5);
    DBG_DUMP(5, 896, 1);
    if (IN(6)) {
        const float* g1 = a.in[6]; const float* g2 = a.in[7];
        f32x4 g1v[8], g2v[8];
#pragma unroll
        for (int j = 0; j < 8; ++j) { g1v[j] = ((const f32x4*)g1)[lane + 64 * j]; g2v[j] = ((const f32x4*)g2)[lane + 64 * j]; }
        for (int m0 = gw; m0 < MTOK; m0 += 2 * NGW) {
            f32x4 v[2][8]; u32x2v yw[2][8]; float ssv[2];
#pragma unroll
            for (int q = 0; q < 2; ++q) { const size_t m = (size_t)(m0 + q * NGW); ssv[q] = lane < 32 ? SS[m * 32 + lane] : 0.f;
                const f32x4* xr = (const f32x4*)(x_in + m * DM) + lane; const u32x2v* yr = (const u32x2v*)(Yb + m * DM) + lane;
#pragma unroll
                for (int j = 0; j < 8; ++j) { v[q][j] = xr[64 * j]; yw[q][j] = yr[64 * j]; } }
#pragma unroll
            for (int q = 0; q < 2; ++q) { const size_t m = (size_t)(m0 + q * NGW);
                const float rstd = __builtin_amdgcn_rsqf(wave_sum(ssv[q]) * (1.f / DM) + EPS); f32x4* orow = (f32x4*)(out_p + m * DM) + lane; float s = 0.f;
#pragma unroll
                for (int j = 0; j < 8; ++j) { const f32x4 gv = g1v[j]; const u32x2v w = yw[q][j];
                    f32x4 y; y.x = __uint_as_float(w.x << 16); y.y = __uint_as_float(w.x & 0xffff0000u); y.z = __uint_as_float(w.y << 16); y.w = __uint_as_float(w.y & 0xffff0000u);
                    v[q][j] = v[q][j] + y * rstd * gv; orow[64 * j] = v[q][j];
                    s += (v[q][j].x * v[q][j].x + v[q][j].y * v[q][j].y) + (v[q][j].z * v[q][j].z + v[q][j].w * v[q][j].w); }
                const float rstd1 = __builtin_amdgcn_rsqf(wave_sum(s) * (1.f / DM) + EPS);
                u32x2v* o8 = (u32x2v*)(H2 + m * DM) + lane;
#pragma unroll
                for (int j = 0; j < 8; ++j) { const f32x4 gv = g2v[j]; u32x2v w; w.x = pk2(v[q][j].x * rstd1 * gv.x, v[q][j].y * rstd1 * gv.y); w.y = pk2(v[q][j].z * rstd1 * gv.z, v[q][j].w * rstd1 * gv.w); o8[64 * j] = w; } }
        }
    }
#if defined(REP_P6)
    __syncthreads();
    if (IN(6)) {
        const float* g1 = a.in[6]; const float* g2 = a.in[7];
        f32x4 g1v[8], g2v[8];
#pragma unroll
        for (int j = 0; j < 8; ++j) { g1v[j] = ((const f32x4*)g1)[lane + 64 * j]; g2v[j] = ((const f32x4*)g2)[lane + 64 * j]; }
        for (int m0 = gw; m0 < MTOK; m0 += 2 * NGW) {
            f32x4 v[2][8]; u32x2v yw[2][8]; float ssv[2];
#pragma unroll
            for (int q = 0; q < 2; ++q) { const size_t m = (size_t)(m0 + q * NGW); ssv[q] = lane < 32 ? SS[m * 32 + lane] : 0.f;
                const f32x4* xr = (const f32x4*)(x_in + m * DM) + lane; const u32x2v* yr = (const u32x2v*)(Yb + m * DM) + lane;
#pragma unroll
                for (int j = 0; j < 8; ++j) { v[q][j] = xr[64 * j]; yw[q][j] = yr[64 * j]; } }
#pragma unroll
            for (int q = 0; q < 2; ++q) { const size_t m = (size_t)(m0 + q * NGW);
                const float rstd = __builtin_amdgcn_rsqf(wave_sum(ssv[q]) * (1.f / DM) + EPS); f32x4* orow = (f32x4*)(out_p + m * DM) + lane; float s = 0.f;
#pragma unroll
                for (int j = 0; j < 8; ++j) { const f32x4 gv = g1v[j]; const u32x2v w = yw[q][j];
                    f32x4 y; y.x = __uint_as_float(w.x << 16); y.y = __uint_as_float(w.x & 0xffff0000u); y.z = __uint_as_float(w.y << 16); y.w = __uint_as_float(w.y & 0xffff0000u);
                    v[q][j] = v[q][j] + y * rstd * gv; orow[64 * j] = v[q][j];
                    s += (v[q][j].x * v[q][j].x + v[q][j].y * v[q][j].y) + (v[q][j].z * v[q][j].z + v[q][j].w * v[q][j].w); }
                const float rstd1 = __builtin_amdgcn_rsqf(wave_sum(s) * (1.f / DM) + EPS);
                u32x2v* o8 = (u32x2v*)(H2 + m * DM) + lane;
#pragma unroll
                for (int j = 0; j < 8; ++j) { const f32x4 gv = g2v[j]; u32x2v w; w.x = pk2(v[q][j].x * rstd1 * gv.x, v[q][j].y * rstd1 * gv.y); w.y = pk2(v[q][j].z * rstd1 * gv.z, v[q][j].w * rstd1 * gv.w); o8[64 * j] = w; } }
        }
    }
#endif
    SEAM(6);
    DBG_DUMP(6, 128, 1);
    if (IN(7)) {
#if defined(STAGGER_US)
        { const unsigned long long t0_ = __builtin_amdgcn_s_memrealtime(), dt_ = (unsigned long long)(((blockIdx.x >> 3) & 15) * (STAGGER_US * 100 / 16));
          while (__builtin_amdgcn_s_memrealtime() - t0_ < dt_) __builtin_amdgcn_s_sleep(8); }
#endif
        pg8::Gemm g{H2, Wup_t, MTOK, DFF, DM}; pg8::StaticOrder S; S.init(MTOK, DFF, G, (int)blockIdx.x);
        pg8::EpiRelu2 E{Ub, DFF};
        pg8::gemm_phase<pg8::EpiRelu2, pg8::StaticOrder, true, true>((LAS unsigned char*)lds, g, S, E);
    }
#if defined(REP_P7)
    __syncthreads();
    if (IN(7)) {
        pg8::Gemm g{H2, Wup_t, MTOK, DFF, DM}; pg8::StaticOrder S; S.init(MTOK, DFF, G, (int)blockIdx.x);
        pg8::EpiRelu2 E{Ub, DFF};
        pg8::gemm_phase<pg8::EpiRelu2, pg8::StaticOrder, true, true>((LAS unsigned char*)lds, g, S, E);
    }
#endif
    SEAM(7);
    DBG_DUMP(7, 256, 4);
    if (IN(8)) {
#if defined(FUSE_P8)
        pg8::Gemm g{Ub, Wdn_t, MTOK, DM, DFF}; pg8::PanelOrder S; S.init((int)blockIdx.x);
        pg8::EpiFinal E{out_p, a.in[8], SS, (unsigned*)(ws + WS_CNT), EPS};
        pg8::gemm_phase<pg8::EpiFinal, pg8::PanelOrder, true, true>((LAS unsigned char*)lds, g, S, E);
#else
        pg8::Gemm g{Ub, Wdn_t, MTOK, DM, DFF}; pg8::StaticOrder S; S.init(MTOK, DM, G, (int)blockIdx.x);
        pg8::EpiYss<bf16> E{Y2, SS};
        pg8::gemm_phase<pg8::EpiYss<bf16>, pg8::StaticOrder, true, true>((LAS unsigned char*)lds, g, S, E);
#endif
    }
#if !defined(FUSE_P8)
    SEAM(8);
    if (IN(9)) {
        const float* g3 = a.in[8];
        f32x4 g3v[8];
#pragma unroll
        for (int j = 0; j < 8; ++j) g3v[j] = ((const f32x4*)g3)[lane + 64 * j];
        for (int m0 = gw; m0 < MTOK; m0 += 2 * NGW) {
            f32x4 v[2][8]; u32x2v yw[2][8]; float ssv[2];
#pragma unroll
            for (int q = 0; q < 2; ++q) { const size_t m = (size_t)(m0 + q * NGW); ssv[q] = lane < 32 ? SS[m * 32 + lane] : 0.f;
                const f32x4* xr = (const f32x4*)(out_p + m * DM) + lane; const u32x2v* yr = (const u32x2v*)(Y2 + m * DM) + lane;
#pragma unroll
                for (int j = 0; j < 8; ++j) { v[q][j] = xr[64 * j]; yw[q][j] = yr[64 * j]; } }
#pragma unroll
            for (int q = 0; q < 2; ++q) { const size_t m = (size_t)(m0 + q * NGW);
                const float rstd = __builtin_amdgcn_rsqf(wave_sum(ssv[q]) * (1.f / DM) + EPS); f32x4* orow = (f32x4*)(out_p + m * DM) + lane;
#pragma unroll
                for (int j = 0; j < 8; ++j) { const f32x4 gv = g3v[j]; const u32x2v w = yw[q][j];
                    f32x4 y; y.x = __uint_as_float(w.x << 16); y.y = __uint_as_float(w.x & 0xffff0000u); y.z = __uint_as_float(w.y << 16); y.w = __uint_as_float(w.y & 0xffff0000u);
                    orow[64 * j] = v[q][j] + y * rstd * gv; } }
        }
    }
#endif
#undef IN
#undef SEAM
#undef tid
#undef lane
#undef wave
#undef G
#undef gw
#undef NGW
}

extern "C" void kernel_launch(void* const* d_in, const int* in_sizes, int n_in, void* d_out, int out_size, void* d_ws, size_t ws_size, hipStream_t stream) {
    static int grid = 0;
    if (grid == 0) {
        if (n_in != 17 || in_sizes[0] != MTOK * DM || out_size != MTOK * DM || ws_size < WS_END) { fprintf(stderr, "kernel_launch: shape/workspace mismatch: n_in %d in0 %d out %d ws %zu (need %zu)\n", n_in, n_in > 0 ? in_sizes[0] : -1, out_size, ws_size, (size_t)WS_END); grid = -1; return; }
        int dev = 0, cus = 0, per_cu = 0;
        (void)hipGetDevice(&dev); (void)hipDeviceGetAttribute(&cus, hipDeviceAttributeMultiprocessorCount, dev);
        if (hipFuncSetAttribute((const void*)mk_fwd, hipFuncAttributeMaxDynamicSharedMemorySize, LDS_BYTES) != hipSuccess) { fprintf(stderr, "kernel_launch: hipFuncSetAttribute failed\n"); grid = -1; return; }
        if (hipOccupancyMaxActiveBlocksPerMultiprocessor(&per_cu, (const void*)mk_fwd, NWAVES * 64, LDS_BYTES) != hipSuccess || per_cu < 1) { fprintf(stderr, "kernel_launch: occupancy query says %d\n", per_cu); per_cu = 1; }
        (void)hipGetLastError();
        grid = cus * per_cu;
        if (grid != 256) fprintf(stderr, "kernel_launch: grid %d != 256: the fused-norm phases need exactly 256 workgroups\n", grid);
        if (grid > 256) grid = 256;
    }
    if (grid < 0) return;
    if (hipMemsetAsync((char*)d_ws + WS_CTL, 0, CTL_ZERO_BYTES, stream) != hipSuccess) { fprintf(stderr, "kernel_launch: hipMemsetAsync failed\n"); return; }
    Args a{};
    for (int i = 0; i < 17; ++i) a.in[i] = (const float*)d_in[i];
    a.out = (float*)d_out; a.ws = (unsigned char*)d_ws; a.ph_lo = 0; a.ph_hi = 10;
    void* args[] = {&a};
    hipError_t e = hipLaunchCooperativeKernel((const void*)mk_fwd, dim3(grid), dim3(NWAVES * 64), args, LDS_BYTES, stream);
    if (e != hipSuccess) fprintf(stderr, "kernel_launch: cooperative launch failed: %s (grid %d)\n", hipGetErrorString(e), grid);
}
```

```cpp
#include <hip/hip_runtime.h>
#include <hip/hip_cooperative_groups.h>
#include <cstdio>
#include <cstdint>
#include <cmath>
namespace cg = cooperative_groups;
namespace pg8 {
#define PG8_LAS __attribute__((address_space(3)))
typedef unsigned short bf16_t;
typedef short bf16x8 __attribute__((ext_vector_type(8)));
typedef float f32x4 __attribute__((ext_vector_type(4)));
typedef unsigned u32x4 __attribute__((ext_vector_type(4)));
constexpr int BM = 256, BK = 64, HALF = 128, HTB = HALF * BK * 2  , STAGE_BYTES = 8 * HTB, NXCD = 8, WGM = 8;

__host__ __device__ __forceinline__ int lds_byte(int r, int c) { const int st = (r >> 4) * 2 + (c >> 5), rr = r & 15, cc = c & 31, ob = rr * 64 + cc * 2; return st * 1024 + (ob ^ (((ob >> 9) & 1) << 5)); }
__host__ __device__ __forceinline__ void stage_rc(int b, int& R, int& C) { const int st = b / 1024, sb = b % 1024, swz = sb ^ (((sb >> 9) & 1) << 5); R = (st >> 1) * 16 + swz / 64; C = (st & 1) * 32 + (swz % 64) / 2; }
__host__ __device__ __forceinline__ int perm32(int rho) { const int n = rho >> 4, i = rho & 15; return 8 * (i >> 2) + 4 * n + (i & 3); }

struct Unit { int pm, pn; };
struct Gemm { const bf16_t* A; const bf16_t* Bt; int M, N, K; };

struct StaticOrder {
    int nM, nN, nwg, G, c;
    __host__ __device__ void init(int M, int N, int G_, int c_) { nM = M / BM; nN = N / BM; nwg = nM * nN; G = G_; c = c_; }
    __host__ __device__ bool next(int i, Unit& u) const {
        const long L = (long)i * G + c; if (L >= nwg) return false;
        int wgid = (int)L; { const int q = nwg / NXCD, r = nwg % NXCD, xcd = wgid % NXCD, off = wgid / NXCD; wgid = (xcd < r ? xcd * (q + 1) : r * (q + 1) + (xcd - r) * q) + off; }
        const int nig = WGM * nN, gid = wgid / nig, fm = gid * WGM, gsz = (nM - fm) < WGM ? (nM - fm) : WGM;
        u.pm = fm + ((wgid % nig) % gsz); u.pn = (wgid % nig) / gsz; return true;
    }
    __device__ __forceinline__ void a_ready(const Unit&) const {}
    __device__ __forceinline__ void done(const Unit&) const {}
};

typedef __bf16 bf16x2_t __attribute__((ext_vector_type(2))); typedef float f32x2_t __attribute__((ext_vector_type(2)));
__device__ __forceinline__ unsigned cvt_pk_bf16(float lo, float hi) { f32x2_t v = {lo, hi}; bf16x2_t b = __builtin_convertvector(v, bf16x2_t); return __builtin_bit_cast(unsigned, b); }
__device__ __forceinline__ float bf2f(unsigned short b) { return __uint_as_float(((unsigned)b) << 16); }
__device__ __forceinline__ void unpack8(const u32x4 w, float (&f)[8]) {
    f[0] = __uint_as_float(w.x << 16); f[1] = __uint_as_float(w.x & 0xffff0000u); f[2] = __uint_as_float(w.y << 16); f[3] = __uint_as_float(w.y & 0xffff0000u);
    f[4] = __uint_as_float(w.z << 16); f[5] = __uint_as_float(w.z & 0xffff0000u); f[6] = __uint_as_float(w.w << 16); f[7] = __uint_as_float(w.w & 0xffff0000u);
}
__device__ __forceinline__ u32x4 pack8(const f32x4 v0, const f32x4 v1) { u32x4 w; w.x = cvt_pk_bf16(v0[0], v0[1]); w.y = cvt_pk_bf16(v0[2], v0[3]); w.z = cvt_pk_bf16(v1[0], v1[1]); w.w = cvt_pk_bf16(v1[2], v1[3]); return w; }
__device__ __forceinline__ float sigmoidf_(float v) { return __builtin_amdgcn_rcpf(1.0f + __builtin_amdgcn_exp2f(-1.4426950408889634f * v)); }

struct EpiProj {
    static constexpr bool PERM = true, AFTER_DRAIN = false;
    bf16_t* QKV; bf16_t* G; const float* ropeC; const float* ropeS;
    __device__ __forceinline__ void operator()(const f32x4 (&acc)[2][2][4][2], const Unit& u, int wr, int wc, int fr, int fq) const {
        const int row0 = u.pm * BM + wr * 64 + fr, colt = u.pn * BM, cl = wc * 32 + 8 * fq;
        if (colt < 2048) {
            const int i0 = 16 * wc + 4 * fq;
            f32x4 cc[2][4], sn[2][4];
#pragma unroll
            for (int ai = 0; ai < 2; ++ai)
#pragma unroll
                for (int m = 0; m < 4; ++m) { const int pos = (row0 + ai * HALF + m * 16) & 8191;
                    cc[ai][m] = *(const f32x4*)(ropeC + (size_t)pos * 64 + i0); sn[ai][m] = *(const f32x4*)(ropeS + (size_t)pos * 64 + i0); }
            asm volatile("" ::: "memory");
#pragma unroll
            for (int ai = 0; ai < 2; ++ai)
#pragma unroll
                for (int m = 0; m < 4; ++m) { const int row = row0 + ai * HALF + m * 16, pos = row & 8191;
                    const f32x4 c = cc[ai][m], s = sn[ai][m];
                    bf16_t* rowp = QKV + (((size_t)(row >> 13) * 48 + (colt >> 7)) * 8192 + pos) * 128 + cl;
#pragma unroll
                    for (int bj = 0; bj < 2; ++bj) { const f32x4 v0 = acc[ai][bj][m][0], v1 = acc[ai][bj][m][1]; f32x4 o0, o1;
                        o0[0] = v0[0] * c[0] - v0[1] * s[0]; o0[1] = v0[1] * c[0] + v0[0] * s[0]; o0[2] = v0[2] * c[1] - v0[3] * s[1]; o0[3] = v0[3] * c[1] + v0[2] * s[1];
                        o1[0] = v1[0] * c[2] - v1[1] * s[2]; o1[1] = v1[1] * c[2] + v1[0] * s[2]; o1[2] = v1[2] * c[3] - v1[3] * s[3]; o1[3] = v1[3] * c[3] + v1[2] * s[3];
                        *(u32x4*)(rowp + (size_t)bj * 8192 * 128) = pack8(o0, o1); } }
        } else if (colt < 6144) {
#pragma unroll
            for (int ai = 0; ai < 2; ++ai)
#pragma unroll
                for (int m = 0; m < 4; ++m) { const int row = row0 + ai * HALF + m * 16; bf16_t* rowp = QKV + (((size_t)(row >> 13) * 48 + (colt >> 7)) * 8192 + (row & 8191)) * 128 + cl;
#pragma unroll
                    for (int bj = 0; bj < 2; ++bj) *(u32x4*)(rowp + (size_t)bj * 8192 * 128) = pack8(acc[ai][bj][m][0], acc[ai][bj][m][1]); }
        } else {
#pragma unroll
            for (int ai = 0; ai < 2; ++ai)
#pragma unroll
                for (int m = 0; m < 4; ++m) { bf16_t* rowp = G + (size_t)(row0 + ai * HALF + m * 16) * 4096 + (colt - 6144) + cl;
#pragma unroll
                    for (int bj = 0; bj < 2; ++bj) { f32x4 v0 = acc[ai][bj][m][0], v1 = acc[ai][bj][m][1];
#pragma unroll
                        for (int j = 0; j < 4; ++j) { v0[j] = sigmoidf_(v0[j]); v1[j] = sigmoidf_(v1[j]); }
                        *(u32x4*)(rowp + bj * HALF) = pack8(v0, v1); } }
        }
    }
};
template <int SECOND> struct EpiBranch {
    static constexpr bool PERM = true, AFTER_DRAIN = false;
    const bf16_t* G; bf16_t* T; bf16_t* MX;
    __device__ __forceinline__ void operator()(const f32x4 (&acc)[2][2][4][2], const Unit& u, int wr, int wc, int fr, int fq) const {
        const int row0 = u.pm * BM + wr * 64 + fr, col0 = u.pn * BM + wc * 32 + 8 * fq;
#pragma unroll
        for (int ai = 0; ai < 2; ++ai) {
            u32x4 gw[4][2], tw[4][2];
#pragma unroll
            for (int m = 0; m < 4; ++m)
#pragma unroll
                for (int bj = 0; bj < 2; ++bj) { const size_t row = (size_t)(row0 + ai * HALF + m * 16); const int col = col0 + bj * HALF;
                    gw[m][bj] = *(const u32x4*)(G + row * 4096 + SECOND * 2048 + col);
                    if (SECOND) tw[m][bj] = *(const u32x4*)(T + row * 2048 + col); }
            asm volatile("" ::: "memory");
#pragma unroll
            for (int m = 0; m < 4; ++m)
#pragma unroll
                for (int bj = 0; bj < 2; ++bj) { const size_t row = (size_t)(row0 + ai * HALF + m * 16); const int col = col0 + bj * HALF;
                    float g[8]; unpack8(gw[m][bj], g);
                    f32x4 v0 = acc[ai][bj][m][0], v1 = acc[ai][bj][m][1];
#pragma unroll
                    for (int jj = 0; jj < 4; ++jj) { v0[jj] *= g[jj]; v1[jj] *= g[4 + jj]; }
                    if (SECOND == 0) { *(u32x4*)(T + row * 2048 + col) = pack8(v0, v1); }
                    else { float t[8]; unpack8(tw[m][bj], t);
#pragma unroll
                        for (int jj = 0; jj < 4; ++jj) { v0[jj] += t[jj]; v1[jj] += t[4 + jj]; }
                        *(u32x4*)(MX + row * 2048 + col) = pack8(v0, v1); } }
            asm volatile("" ::: "memory");
        }
    }
};
template <typename TO> struct EpiYss {
    static constexpr bool PERM = true, AFTER_DRAIN = false;
    TO* Y; float* SS;
    __device__ __forceinline__ void operator()(const f32x4 (&acc)[2][2][4][2], const Unit& u, int wr, int wc, int fr, int fq) const {
        const int row0 = u.pm * BM + wr * 64 + fr, col0 = u.pn * BM + wc * 32 + 8 * fq;
#pragma unroll
        for (int ai = 0; ai < 2; ++ai)
#pragma unroll
            for (int m = 0; m < 4; ++m) { const size_t row = (size_t)(row0 + ai * HALF + m * 16); float s = 0.f;
#pragma unroll
                for (int bj = 0; bj < 2; ++bj) { const f32x4 v0 = acc[ai][bj][m][0], v1 = acc[ai][bj][m][1];
                    s += (v0[0] * v0[0] + v0[1] * v0[1]) + (v0[2] * v0[2] + v0[3] * v0[3]) + (v1[0] * v1[0] + v1[1] * v1[1]) + (v1[2] * v1[2] + v1[3] * v1[3]);
                    if constexpr (sizeof(TO) == 2) *(u32x4*)((bf16_t*)Y + row * 2048 + col0 + bj * HALF) = pack8(v0, v1);
                    else { float* yp = (float*)Y + row * 2048 + col0 + bj * HALF; *(f32x4*)yp = v0; *(f32x4*)(yp + 4) = v1; } }
                s += __shfl_xor(s, 16); s += __shfl_xor(s, 32);
                if (fq == 0) SS[row * 32 + u.pn * 4 + wc] = s; }
    }
};
struct EpiRelu2 {
    static constexpr bool PERM = true, AFTER_DRAIN = false;
    bf16_t* U; int ldc;
    __device__ __forceinline__ void operator()(const f32x4 (&acc)[2][2][4][2], const Unit& u, int wr, int wc, int fr, int fq) const {
        const int row0 = u.pm * BM + wr * 64 + fr, col0 = u.pn * BM + wc * 32 + 8 * fq;
#pragma unroll
        for (int ai = 0; ai < 2; ++ai)
#pragma unroll
            for (int m = 0; m < 4; ++m) { bf16_t* rowp = U + (size_t)(row0 + ai * HALF + m * 16) * ldc + col0;
#pragma unroll
                for (int bj = 0; bj < 2; ++bj) { f32x4 v0 = acc[ai][bj][m][0], v1 = acc[ai][bj][m][1];
#pragma unroll
                    for (int j = 0; j < 4; ++j) { const float a = fmaxf(v0[j], 0.f), b = fmaxf(v1[j], 0.f); v0[j] = a * a; v1[j] = b * b; }
                    *(u32x4*)(rowp + bj * HALF) = pack8(v0, v1); } }
    }
};
struct PanelOrder {
    int c;
    __device__ void init(int c_) { c = c_; }
    __device__ bool next(int i, Unit& u) const { if (i >= 4) return false; const int li = c >> 3; u.pm = 16 * (c & 7) + 4 * i + (li >> 3); u.pn = li & 7; return true; }
    __device__ __forceinline__ void a_ready(const Unit&) const {}
    __device__ __forceinline__ void done(const Unit&) const {}
};
__device__ __forceinline__ void panel_publish(const float (&sq)[2][4], float* slots, unsigned* cnt, const Unit& u, int wr, int wc, int fr, int fq) {
#pragma unroll
    for (int ai = 0; ai < 2; ++ai)
#pragma unroll
        for (int m = 0; m < 4; ++m) { const size_t row = (size_t)(u.pm * BM + ai * HALF + wr * 64 + m * 16 + fr);
            if (fq == 0) __hip_atomic_store(slots + row * 32 + u.pn * 4 + wc, sq[ai][m], __ATOMIC_RELAXED, __HIP_MEMORY_SCOPE_AGENT); }
    asm volatile("s_waitcnt vmcnt(0)" ::: "memory");
    if ((threadIdx.x & 63) == 0) __hip_atomic_fetch_add(cnt + 64 * u.pm, 1u, __ATOMIC_RELAXED, __HIP_MEMORY_SCOPE_AGENT);
}
__device__ __forceinline__ void panel_collect(float (&sq)[2][4], const float* slots, unsigned* cnt, const Unit& u, int wr, int fr, int fq, float eps) {
    unsigned* cw = cnt + 64 * u.pm;
    { unsigned spins = 0;
      while ((unsigned)__builtin_amdgcn_readfirstlane(__hip_atomic_load(cw, __ATOMIC_RELAXED, __HIP_MEMORY_SCOPE_AGENT)) < 64u) { __builtin_amdgcn_s_sleep(2); if (++spins > (1u << 22)) break; } }
    __builtin_amdgcn_fence(__ATOMIC_ACQUIRE, "agent");
#pragma unroll
    for (int ai = 0; ai < 2; ++ai)
#pragma unroll
        for (int m = 0; m < 4; ++m) { const size_t row = (size_t)(u.pm * BM + ai * HALF + wr * 64 + m * 16 + fr);
            const unsigned long long* sp = (const unsigned long long*)(slots + row * 32 + fq * 8); float t = 0.f;
#pragma unroll
            for (int k = 0; k < 4; ++k) { const unsigned long long w = __hip_atomic_load(sp + k, __ATOMIC_RELAXED, __HIP_MEMORY_SCOPE_AGENT); t += __uint_as_float((unsigned)w) + __uint_as_float((unsigned)(w >> 32)); }
            t += __shfl_xor(t, 16); t += __shfl_xor(t, 32);
            sq[ai][m] = __builtin_amdgcn_rsqf(t * (1.0f / 2048.0f) + eps); }
}
struct EpiFinal {
    static constexpr bool PERM = false, AFTER_DRAIN = false;
    float* X; const float* gain; float* slots; unsigned* cnt; float eps;
    __device__ __forceinline__ void operator()(const f32x4 (&acc)[2][2][4][2], const Unit& u, int wr, int wc, int fr, int fq) const {
        float sq[2][4];
#pragma unroll
        for (int ai = 0; ai < 2; ++ai)
#pragma unroll
            for (int m = 0; m < 4; ++m) { float s = 0.f;
#pragma unroll
                for (int bj = 0; bj < 2; ++bj)
#pragma unroll
                    for (int n = 0; n < 2; ++n) { const f32x4 v = acc[ai][bj][m][n]; s += (v[0] * v[0] + v[1] * v[1]) + (v[2] * v[2] + v[3] * v[3]); }
                s += __shfl_xor(s, 16); s += __shfl_xor(s, 32); sq[ai][m] = s; }
        const int col0 = u.pn * BM + wc * 32 + 4 * fq;
        panel_publish(sq, slots, cnt, u, wr, wc, fr, fq);
        f32x4 pre[4][2][2];
#pragma unroll
        for (int m = 0; m < 4; ++m) { const float* rowp = X + (size_t)(u.pm * BM + wr * 64 + m * 16 + fr) * 2048 + col0;
#pragma unroll
            for (int bj = 0; bj < 2; ++bj)
#pragma unroll
                for (int n = 0; n < 2; ++n) pre[m][bj][n] = *(const f32x4*)(rowp + bj * HALF + n * 16); }
        panel_collect(sq, slots, cnt, u, wr, fr, fq, eps);
        f32x4 gv[2][2];
#pragma unroll
        for (int bj = 0; bj < 2; ++bj)
#pragma unroll
            for (int n = 0; n < 2; ++n) gv[bj][n] = *(const f32x4*)(gain + col0 + bj * HALF + n * 16);
#pragma unroll
        for (int ai = 0; ai < 2; ++ai) {
            if (ai == 1) {
#pragma unroll
                for (int m = 0; m < 4; ++m) { const float* rowp = X + (size_t)(u.pm * BM + HALF + wr * 64 + m * 16 + fr) * 2048 + col0;
#pragma unroll
                    for (int bj = 0; bj < 2; ++bj)
#pragma unroll
                        for (int n = 0; n < 2; ++n) pre[m][bj][n] = *(const f32x4*)(rowp + bj * HALF + n * 16); } }
#pragma unroll
            for (int m = 0; m < 4; ++m) { float* rowp = X + (size_t)(u.pm * BM + ai * HALF + wr * 64 + m * 16 + fr) * 2048 + col0; const float rs = sq[ai][m];
#pragma unroll
                for (int bj = 0; bj < 2; ++bj)
#pragma unroll
                    for (int n = 0; n < 2; ++n) *(f32x4*)(rowp + bj * HALF + n * 16) = pre[m][bj][n] + acc[ai][bj][m][n] * rs * gv[bj][n]; }
            asm volatile("" ::: "memory");
        }
    }
};

template <class Epi, class Sched, bool ALIGN_EPI = false, bool SP2 = false>
__device__ __forceinline__ void gemm_phase(PG8_LAS unsigned char* lds, const Gemm g, const Sched& S, const Epi& E) {
    const int tid = threadIdx.x, wid = __builtin_amdgcn_readfirstlane(tid >> 6), lane = tid & 63, wr = wid >> 2, wc = wid & 3, fr = lane & 15, fq = lane >> 4;
    const int K = g.K, nt = K / BK;
    unsigned voffA[2], voffB[2];
#pragma unroll
    for (int i = 0; i < 2; ++i) { int R, C; stage_rc(tid * 16 + i * 8192, R, C); const int Rb = Epi::PERM ? ((R & ~31) + perm32(R & 31)) : R;
        voffA[i] = (unsigned)(R * K + C) * 2u; voffB[i] = (unsigned)(Rb * K + C) * 2u; }
    const size_t kstep = (size_t)(BK * 2);
    const size_t hstep = (size_t)HALF * K * 2;
    const size_t tstep = 2 * hstep;
    const unsigned ldsw = (unsigned)wid * 1024u;
    const int aoff = lds_byte(wr * 64 + fr, fq * 8), boff = lds_byte(wc * 32 + fr, fq * 8);
#define PG8_SA(b, h) (((b) * 2 + (h)) * HTB)
#define PG8_SB(b, h) ((4 + (b) * 2 + (h)) * HTB)
#define PG8_STAGE(bufoff, gbase, voff) do { _Pragma("unroll") for (int _i = 0; _i < 2; ++_i) \
        __builtin_amdgcn_global_load_lds((const unsigned*)((const char*)(gbase) + (voff)[_i]), (PG8_LAS unsigned*)(lds + (bufoff) + ldsw + _i * 8192), 16, 0, 0); } while (0)
#define PG8_LDA(dst, b, h) do { _Pragma("unroll") for (int m = 0; m < 4; ++m) _Pragma("unroll") for (int k = 0; k < 2; ++k) dst[m][k] = *(const PG8_LAS bf16x8*)(lds + PG8_SA(b, h) + aoff + m * 2048 + k * 1024); } while (0)
#define PG8_LDB(dst, b, h) do { _Pragma("unroll") for (int n = 0; n < 2; ++n) _Pragma("unroll") for (int k = 0; k < 2; ++k) dst[n][k] = *(const PG8_LAS bf16x8*)(lds + PG8_SB(b, h) + boff + n * 2048 + k * 1024); } while (0)
#define PG8_MMA(ai, bj, At, Bt) do { __builtin_amdgcn_s_setprio(1); _Pragma("unroll") for (int m = 0; m < 4; ++m) _Pragma("unroll") for (int n = 0; n < 2; ++n) _Pragma("unroll") for (int k = 0; k < 2; ++k) \
        acc[ai][bj][m][n] = __builtin_amdgcn_mfma_f32_16x16x32_bf16(Bt[n][k], At[m][k], acc[ai][bj][m][n], 0, 0, 0); __builtin_amdgcn_s_setprio(0); } while (0)
#define PG8_WAIT_V(n) asm volatile("s_waitcnt vmcnt(" #n ")" ::: "memory")
#define PG8_WAIT_L(n) asm volatile("s_waitcnt lgkmcnt(" #n ")" ::: "memory")
#define PG8_BAR __builtin_amdgcn_s_barrier()
#define PG8_SCHED __builtin_amdgcn_sched_barrier(0)
    Unit cur, nxt; int ui = 0;
    if (!S.next(0, cur)) return;
    f32x4 acc[2][2][4][2];
#pragma unroll
    for (int a = 0; a < 2; ++a)
#pragma unroll
        for (int b = 0; b < 2; ++b)
#pragma unroll
            for (int m = 0; m < 4; ++m)
#pragma unroll
                for (int n = 0; n < 2; ++n) acc[a][b][m][n] = (f32x4){0.f, 0.f, 0.f, 0.f};
    bf16x8 At[4][2], B0[2][2], B1[2][2];
    const char* cA = (const char*)g.A + (size_t)cur.pm * tstep; const char* cB = (const char*)g.Bt + (size_t)cur.pn * tstep;
    S.a_ready(cur);
    if constexpr (SP2) {
        PG8_STAGE(PG8_SB(0, 0), cB, voffB); PG8_STAGE(PG8_SB(0, 1), cB + hstep, voffB); PG8_STAGE(PG8_SA(0, 0), cA, voffA); PG8_STAGE(PG8_SA(0, 1), cA + hstep, voffA);
        if (wr == 1) PG8_BAR;
        PG8_WAIT_V(2); PG8_BAR;
        PG8_STAGE(PG8_SB(1, 0), cB + kstep, voffB); PG8_STAGE(PG8_SA(1, 0), cA + kstep, voffA); PG8_STAGE(PG8_SB(1, 1), cB + hstep + kstep, voffB);
        PG8_WAIT_V(6); PG8_BAR;
    } else {
        PG8_STAGE(PG8_SB(0, 0), cB, voffB); PG8_STAGE(PG8_SA(0, 0), cA, voffA); PG8_STAGE(PG8_SB(0, 1), cB + hstep, voffB); PG8_STAGE(PG8_SA(0, 1), cA + hstep, voffA);
        if (wr == 1) PG8_BAR;
        PG8_WAIT_V(4); PG8_BAR;
        PG8_STAGE(PG8_SB(1, 0), cB + kstep, voffB); PG8_STAGE(PG8_SA(1, 0), cA + kstep, voffA); PG8_STAGE(PG8_SB(1, 1), cB + hstep + kstep, voffB);
        PG8_WAIT_V(6); PG8_BAR;
    }
    for (;;) {
        const bool has_next = S.next(ui + 1, nxt);
        const char* nA = has_next ? (const char*)g.A + (size_t)nxt.pm * tstep : cA; const char* nB = has_next ? (const char*)g.Bt + (size_t)nxt.pn * tstep : cB;
        for (int t = 0; t < nt; t += 2) {
            const bool last = (t == nt - 2);
            const char* a1 = cA + (size_t)(t + 1) * kstep;
            const char* a2 = last ? nA : cA + (size_t)(t + 2) * kstep; const char* b2 = last ? nB : cB + (size_t)(t + 2) * kstep;
            const char* a3 = a2 + kstep; const char* b3 = b2 + kstep;
            if (last && has_next) S.a_ready(nxt);
            if constexpr (SP2) {
            PG8_LDB(B0, 0, 0); PG8_LDB(B1, 0, 1); PG8_SCHED; PG8_LDA(At, 0, 0); PG8_STAGE(PG8_SA(1, 1), a1 + hstep, voffA);
            PG8_WAIT_V(8); PG8_WAIT_L(0); PG8_BAR; PG8_MMA(0, 0, At, B0); PG8_MMA(0, 1, At, B1); PG8_BAR; PG8_SCHED;
            PG8_LDA(At, 0, 1); PG8_STAGE(PG8_SB(0, 0), b2, voffB); PG8_STAGE(PG8_SB(0, 1), b2 + hstep, voffB); PG8_STAGE(PG8_SA(0, 0), a2, voffA);
            PG8_WAIT_V(8); PG8_WAIT_L(0); PG8_BAR; PG8_MMA(1, 0, At, B0); PG8_MMA(1, 1, At, B1); PG8_BAR; PG8_SCHED;
            PG8_LDB(B0, 1, 0); PG8_LDB(B1, 1, 1); PG8_SCHED; PG8_LDA(At, 1, 0); PG8_STAGE(PG8_SA(0, 1), a2 + hstep, voffA);
            PG8_WAIT_V(8); PG8_WAIT_L(0); PG8_BAR; PG8_MMA(0, 0, At, B0); PG8_MMA(0, 1, At, B1); PG8_BAR; PG8_SCHED;
            PG8_LDA(At, 1, 1); PG8_STAGE(PG8_SB(1, 0), b3, voffB); PG8_STAGE(PG8_SB(1, 1), b3 + hstep, voffB); PG8_STAGE(PG8_SA(1, 0), a3, voffA);
            PG8_WAIT_V(8); PG8_WAIT_L(0); PG8_BAR; PG8_MMA(1, 0, At, B0); PG8_MMA(1, 1, At, B1); PG8_BAR; PG8_SCHED;
            } else {
            PG8_LDB(B0, 0, 0); PG8_SCHED; PG8_LDA(At, 0, 0); PG8_STAGE(PG8_SA(1, 1), a1 + hstep, voffA);
            PG8_WAIT_L(8); PG8_BAR; PG8_WAIT_L(0); PG8_MMA(0, 0, At, B0); PG8_BAR; PG8_SCHED;
            PG8_LDB(B1, 0, 1); PG8_STAGE(PG8_SB(0, 0), b2, voffB);
            PG8_BAR; PG8_WAIT_L(0); PG8_MMA(0, 1, At, B1); PG8_BAR;
            PG8_LDA(At, 0, 1); PG8_STAGE(PG8_SA(0, 0), a2, voffA);
            PG8_BAR; PG8_WAIT_L(0); PG8_MMA(1, 0, At, B0); PG8_BAR; PG8_SCHED;
            PG8_STAGE(PG8_SB(0, 1), b2 + hstep, voffB);
            PG8_WAIT_V(6); PG8_BAR; PG8_MMA(1, 1, At, B1); PG8_BAR;
            PG8_LDB(B0, 1, 0); PG8_SCHED; PG8_LDA(At, 1, 0); PG8_STAGE(PG8_SA(0, 1), a2 + hstep, voffA);
            PG8_WAIT_L(8); PG8_BAR; PG8_WAIT_L(0); PG8_MMA(0, 0, At, B0); PG8_BAR; PG8_SCHED;
            PG8_LDB(B1, 1, 1); PG8_STAGE(PG8_SB(1, 0), b3, voffB);
            PG8_BAR; PG8_WAIT_L(0); PG8_MMA(0, 1, At, B1); PG8_BAR;
            PG8_LDA(At, 1, 1); PG8_STAGE(PG8_SA(1, 0), a3, voffA);
            PG8_BAR; PG8_WAIT_L(0); PG8_MMA(1, 0, At, B0); PG8_BAR; PG8_SCHED;
            PG8_STAGE(PG8_SB(1, 1), b3 + hstep, voffB);
            PG8_WAIT_V(6); PG8_BAR; PG8_MMA(1, 1, At, B1); PG8_BAR;
            }
        }
        if constexpr (ALIGN_EPI) { if (wr == 0) PG8_BAR; }
        if constexpr (!Epi::AFTER_DRAIN) { E(acc, cur, wr, wc, fr, fq); S.done(cur); }
        if (!has_next) break;
#pragma unroll
        for (int a = 0; a < 2; ++a)
#pragma unroll
            for (int b = 0; b < 2; ++b)
#pragma unroll
                for (int m = 0; m < 4; ++m)
#pragma unroll
                    for (int n = 0; n < 2; ++n) acc[a][b][m][n] = (f32x4){0.f, 0.f, 0.f, 0.f};
        cur = nxt; cA = nA; cB = nB; ++ui;
        if constexpr (ALIGN_EPI) { if (wr == 1) PG8_BAR; }
    }
    PG8_WAIT_V(0);
    if constexpr (!ALIGN_EPI) { if (wr == 0) PG8_BAR; }
    PG8_BAR;
    if constexpr (Epi::AFTER_DRAIN) { E.fused(acc, cur, wr, wc, fr, fq, lds, wid, lane); S.done(cur); }
#undef PG8_SA
#undef PG8_SB
#undef PG8_STAGE
#undef PG8_LDA
#undef PG8_LDB
#undef PG8_MMA
#undef PG8_WAIT_V
#undef PG8_WAIT_L
#undef PG8_BAR
#undef PG8_SCHED
}
}
namespace att {
using bf16 = unsigned short;
constexpr int   D = 128, NW = 8, QBLK = 32, KVBLK = 64;
constexpr float SCALE = 0.088388347648318440f;
#ifndef ATT_THR
#define ATT_THR 8.f
#endif
constexpr float THR = ATT_THR;
constexpr int SDEPTH = 2;
constexpr int LDQ = 128, LDK = 128, LDO = 2048;
constexpr size_t SHM_V = KVBLK * D * 2, SHM_K = KVBLK * D * 2, SHM_ATTN = 2 * SHM_V + 2 * SHM_K + NW * 64 * 4;
using bf16x8 = __attribute__((ext_vector_type(8))) short;
using s16x4  = __attribute__((ext_vector_type(4))) short;
using f32x16 = __attribute__((ext_vector_type(16))) float;
using f32x8  = __attribute__((ext_vector_type(8))) float;
using u32x4  = __attribute__((ext_vector_type(4))) unsigned;
#define KSWZ(row, colB) ((row) * 256 + ((colB) ^ (((row) & 7) << 4)))
#define SBAR() __builtin_amdgcn_sched_barrier(0)
__device__ __forceinline__ int crow(int r, int hi) { return (r & 3) + 8 * (r >> 2) + 4 * hi; }
__device__ __forceinline__ unsigned cvtpk(float lo, float hi) {
  unsigned r; asm volatile("v_cvt_pk_bf16_f32 %0, %1, %2" : "=v"(r) : "v"(lo), "v"(hi)); return r;
}
template <typename TIn> struct Stage;
template <> struct Stage<bf16>  { using T = bf16x8;
  __device__ static __forceinline__ T ld8(const bf16* p) { return *reinterpret_cast<const bf16x8*>(p); }
  __device__ static __forceinline__ bf16x8 tobf(T x) { return x; } };
template <> struct Stage<float> { using T = f32x8;
  __device__ static __forceinline__ T ld8(const float* p) { return *reinterpret_cast<const f32x8*>(p); }
  __device__ static __forceinline__ bf16x8 tobf(T x) {
    u32x4 w = {cvtpk(x[0], x[1]), cvtpk(x[2], x[3]), cvtpk(x[4], x[5]), cvtpk(x[6], x[7])}; return *reinterpret_cast<bf16x8*>(&w); } };

__device__ __forceinline__ void partialSM(f32x16& p0, f32x16& p1, float& m_reg, float& mn, float& alpha) {
  constexpr float C = SCALE * 1.4426950408889634f;
  float pmax = p0[0]; for (int r = 1; r < 16; ++r) pmax = fmaxf(pmax, p0[r]); for (int r = 0; r < 16; ++r) pmax = fmaxf(pmax, p1[r]);
  { auto rr = __builtin_amdgcn_permlane32_swap(__float_as_uint(pmax), __float_as_uint(pmax), false, false);
    pmax = fmaxf(__uint_as_float(rr[0]), __uint_as_float(rr[1])); }
  if (__builtin_expect(__all(pmax - m_reg <= THR / SCALE), 1)) { mn = m_reg; alpha = 1.f; }
  else { mn = fmaxf(m_reg, pmax); alpha = __builtin_amdgcn_exp2f((m_reg - mn) * C); m_reg = mn; }
  float mnC = -mn * C;
  for (int r = 0; r < 16; ++r) p0[r] = fmaf(p0[r], C, mnC); for (int r = 0; r < 16; ++r) p1[r] = fmaf(p1[r], C, mnC);
  for (int r = 0; r < 16; ++r) p0[r] = __builtin_amdgcn_exp2f(p0[r]);
}
__device__ __forceinline__ void finishSM(f32x16& p0, f32x16& p1, float alpha, float& l_reg, bf16x8& pa0, bf16x8& pa1, bf16x8& pa2, bf16x8& pa3) {
  for (int r = 0; r < 16; ++r) p1[r] = __builtin_amdgcn_exp2f(p1[r]);
  float ps = 0; for (int r = 0; r < 16; ++r) ps += p0[r]; for (int r = 0; r < 16; ++r) ps += p1[r];
  { auto rr = __builtin_amdgcn_permlane32_swap(__float_as_uint(ps), __float_as_uint(ps), false, false);
    ps = __uint_as_float(rr[0]) + __uint_as_float(rr[1]); }
  l_reg = l_reg * alpha + ps;
#define PK4(P, BASE, OUT) do { unsigned a0 = cvtpk(P[BASE + 0], P[BASE + 1]), a1 = cvtpk(P[BASE + 2], P[BASE + 3]);   \
    unsigned b0 = cvtpk(P[BASE + 4], P[BASE + 5]), b1 = cvtpk(P[BASE + 6], P[BASE + 7]);                              \
    auto r0 = __builtin_amdgcn_permlane32_swap(a0, b0, false, false); auto r1 = __builtin_amdgcn_permlane32_swap(a1, b1, false, false); \
    u32x4 w = {r0[0], r1[0], r0[1], r1[1]}; OUT = *reinterpret_cast<bf16x8*>(&w); } while (0)
  PK4(p0, 0, pa0); PK4(p0, 8, pa1); PK4(p1, 0, pa2); PK4(p1, 8, pa3);
#undef PK4
}
__device__ __forceinline__ void qkt(f32x16& p0, f32x16& p1, const bf16* Ks, const bf16x8* qr, int r32, int hi) {
  p0 = f32x16{}; p1 = f32x16{};
  for (int d0 = 0; d0 < 8; ++d0) { int cb = (d0 * 16 + hi * 8) * 2;
    bf16x8 b0 = *reinterpret_cast<const bf16x8*>((const char*)Ks + KSWZ(r32, cb));
    bf16x8 b1 = *reinterpret_cast<const bf16x8*>((const char*)Ks + KSWZ(32 + r32, cb));
    p0 = __builtin_amdgcn_mfma_f32_32x32x16_bf16(b0, qr[d0], p0, 0, 0, 0);
    p1 = __builtin_amdgcn_mfma_f32_32x32x16_bf16(b1, qr[d0], p1, 0, 0, 0); }
}
__device__ __forceinline__ int v_st(int k, int c) { const int kk = (k & ~0xC) | ((k & 4) << 1) | ((k & 8) >> 1); return ((kk >> 3) * 4 + (c >> 5)) * 512 + ((kk & 7) * 32 + (c & 31)) * 2; }
__device__ __forceinline__ int v_rd_base(int lane) { return ((lane & 3) << 3) | (((lane >> 2) & 3) << 6) | (((lane >> 4) & 1) << 5) | (((lane >> 5) & 1) << 8); }
constexpr int v_rd_off(int d0, int ks, int half) { return d0 * 512 + ks * 4096 + half * 2048; }
template <int OFF> __device__ __forceinline__ s16x4 tr_read(int vb) {
  s16x4 r; asm volatile("ds_read_b64_tr_b16 %0, %1 offset:%2" : "=&v"(r) : "v"(vb), "i"(OFF) : "memory"); return r;
}
template <int D0> __device__ __forceinline__ void pv_one(f32x16& od, int vb, bf16x8 pa0, bf16x8 pa1, bf16x8 pa2, bf16x8 pa3) {
  const s16x4 l0 = tr_read<v_rd_off(D0, 0, 0)>(vb), h0 = tr_read<v_rd_off(D0, 0, 1)>(vb), l1 = tr_read<v_rd_off(D0, 1, 0)>(vb), h1 = tr_read<v_rd_off(D0, 1, 1)>(vb);
  const s16x4 l2 = tr_read<v_rd_off(D0, 2, 0)>(vb), h2 = tr_read<v_rd_off(D0, 2, 1)>(vb), l3 = tr_read<v_rd_off(D0, 3, 0)>(vb), h3 = tr_read<v_rd_off(D0, 3, 1)>(vb);
  asm volatile("s_waitcnt lgkmcnt(0)" ::: "memory"); SBAR();
#define PK(L, H) (bf16x8){L[0], L[1], L[2], L[3], H[0], H[1], H[2], H[3]}
  od = __builtin_amdgcn_mfma_f32_32x32x16_bf16(pa0, PK(l0, h0), od, 0, 0, 0);
  od = __builtin_amdgcn_mfma_f32_32x32x16_bf16(pa1, PK(l1, h1), od, 0, 0, 0);
  od = __builtin_amdgcn_mfma_f32_32x32x16_bf16(pa2, PK(l2, h2), od, 0, 0, 0);
  od = __builtin_amdgcn_mfma_f32_32x32x16_bf16(pa3, PK(l3, h3), od, 0, 0, 0);
#undef PK
}
__device__ __forceinline__ void pv_d0(f32x16* o, int vb, bf16x8 pa0, bf16x8 pa1, bf16x8 pa2, bf16x8 pa3) {
  pv_one<0>(o[0], vb, pa0, pa1, pa2, pa3); pv_one<1>(o[1], vb, pa0, pa1, pa2, pa3); pv_one<2>(o[2], vb, pa0, pa1, pa2, pa3); pv_one<3>(o[3], vb, pa0, pa1, pa2, pa3);
}

template <typename TQ>
__device__ __forceinline__ void attn_dense_body(const TQ* __restrict__ Qb, const bf16* __restrict__ Kh, const bf16* __restrict__ Vh,
                                                bf16* __restrict__ Ob, int seq, char* lds) {
  using St = Stage<bf16>; using SQ = Stage<TQ>;
  const int tid = threadIdx.x, wid = tid >> 6, lane = tid & 63, r32 = lane & 31, hi = lane >> 5;
  bf16* V_lds = (bf16*)lds; bf16* K_lds = (bf16*)(lds + 2 * SHM_V);
  float* ws = (float*)(lds + 2 * SHM_V + 2 * SHM_K) + wid * 64; float* li_l = ws; float* al_l = ws + 32;
  float m_reg = -1e30f, l_reg = 0; f32x16 o[4] = {}; bf16x8 qr[8];
  const TQ* Qw = Qb + (long)(wid * QBLK + r32) * LDQ + hi * 8;
#pragma unroll
  for (int d0 = 0; d0 < 8; ++d0) qr[d0] = SQ::tobf(SQ::ld8(Qw + d0 * 16));
  const int sr = tid >> 4, sc = (tid & 15) * 8, vst0 = v_st(sr, sc), vst1 = v_st(32 + sr, sc);
  const int vb0 = (int)(uintptr_t)V_lds + v_rd_base(lane);
  struct { typename St::T vs0, vs1, ks0, ks1; } sr_[SDEPTH];
#define SLOAD(i, k0) do { sr_[i].vs0 = St::ld8(&Vh[(long)((k0) + sr) * LDK + sc]); sr_[i].vs1 = St::ld8(&Vh[(long)((k0) + 32 + sr) * LDK + sc]); \
    sr_[i].ks0 = St::ld8(&Kh[(long)((k0) + sr) * LDK + sc]); sr_[i].ks1 = St::ld8(&Kh[(long)((k0) + 32 + sr) * LDK + sc]); } while (0)
#define SWRITE(b, i) do { *(bf16x8*)((char*)V_lds + (b) * SHM_V + vst0) = St::tobf(sr_[i].vs0);          \
    *(bf16x8*)((char*)V_lds + (b) * SHM_V + vst1) = St::tobf(sr_[i].vs1); int kc = sc * 2;               \
    *(bf16x8*)((char*)K_lds + (b) * SHM_K + KSWZ(sr, kc)) = St::tobf(sr_[i].ks0);                       \
    *(bf16x8*)((char*)K_lds + (b) * SHM_K + KSWZ(32 + sr, kc)) = St::tobf(sr_[i].ks1); } while (0)
#define SWAIT() do { if constexpr (SDEPTH == 2) asm volatile("s_waitcnt vmcnt(4)" ::: "memory"); else asm volatile("s_waitcnt vmcnt(0)" ::: "memory"); } while (0)
#define RESC(a) do { if (__any((a) < 1.f)) { if (hi == 0) al_l[r32] = (a); asm volatile("s_waitcnt lgkmcnt(0)" ::: "memory"); \
    for (int d = 0; d < 4; ++d) for (int r = 0; r < 16; ++r) o[d][r] *= al_l[crow(r, hi)]; } } while (0)
  f32x16 pA0, pA1, pB0, pB1; float mnA, mnB, alA, alB; bf16x8 pa0, pa1, pa2, pa3; const int NT = seq / KVBLK;
  constexpr int SE = 0, SO = SDEPTH - 1;
  SLOAD(SE, 0); asm volatile("s_waitcnt vmcnt(0)" ::: "memory"); SWRITE(0, SE); __syncthreads();
  qkt(pA0, pA1, K_lds, qr, r32, hi); partialSM(pA0, pA1, m_reg, mnA, alA);
  SLOAD(SO, KVBLK); if constexpr (SDEPTH == 2) { if (2 < NT) SLOAD(SE, 2 * KVBLK); }
  SWAIT(); SWRITE(1, SO); __syncthreads();
  for (int j = 1; j + 1 < NT; j += 2) {
    SBAR(); qkt(pB0, pB1, (bf16*)((char*)K_lds + SHM_K), qr, r32, hi);
    finishSM(pA0, pA1, alA, l_reg, pa0, pa1, pa2, pa3); SBAR();
    SLOAD(SO, (j + SDEPTH) * KVBLK); SBAR();
    pv_d0(o, vb0, pa0, pa1, pa2, pa3); partialSM(pB0, pB1, m_reg, mnB, alB);
    __syncthreads(); SWAIT(); SWRITE(0, SE);
    RESC(alB); __syncthreads();
    SBAR(); qkt(pA0, pA1, K_lds, qr, r32, hi);
    finishSM(pB0, pB1, alB, l_reg, pa0, pa1, pa2, pa3); SBAR();
    if (SDEPTH == 1 || j + 3 < NT) SLOAD(SE, (j + 1 + SDEPTH) * KVBLK); SBAR();
    pv_d0(o, vb0 + (int)SHM_V, pa0, pa1, pa2, pa3); partialSM(pA0, pA1, m_reg, mnA, alA);
    __syncthreads(); SWAIT(); SWRITE(1, SO);
    RESC(alA); __syncthreads();
  }
  SBAR(); qkt(pB0, pB1, (bf16*)((char*)K_lds + SHM_K), qr, r32, hi);
  finishSM(pA0, pA1, alA, l_reg, pa0, pa1, pa2, pa3); SBAR();
  pv_d0(o, vb0, pa0, pa1, pa2, pa3); partialSM(pB0, pB1, m_reg, mnB, alB);
  __syncthreads(); RESC(alB);
  finishSM(pB0, pB1, alB, l_reg, pa0, pa1, pa2, pa3); SBAR();
  pv_d0(o, vb0 + (int)SHM_V, pa0, pa1, pa2, pa3);
  if (hi == 0) li_l[r32] = l_reg; asm volatile("s_waitcnt lgkmcnt(0)" ::: "memory");
  float rli[16];
#pragma unroll
  for (int r = 0; r < 16; ++r) rli[r] = __builtin_amdgcn_rcpf(li_l[crow(r, hi)]);
  bf16* Ow = Ob + (long)(wid * QBLK) * LDO;
#pragma unroll
  for (int r = 0; r < 16; ++r) { int orow = crow(r, hi);
    for (int d0 = 0; d0 < 4; ++d0) Ow[(long)orow * LDO + d0 * 32 + r32] = (bf16)(cvtpk(o[d0][r] * rli[r], 0.f) & 0xffffu); }
#undef SLOAD
#undef SWRITE
#undef SWAIT
#undef RESC
}

#define ATT_LAS __attribute__((address_space(3)))
__device__ __forceinline__ void qkt_lean(f32x16& p0, f32x16& p1, const bf16* Ks, const bf16x8* qr, int r32, int hi) {
  p0 = f32x16{}; p1 = f32x16{};
#pragma unroll
  for (int d0 = 0; d0 < 8; ++d0) { const int cb = (d0 * 16 + hi * 8) * 2;
    const bf16x8 b0 = *reinterpret_cast<const bf16x8*>((const char*)Ks + KSWZ(r32, cb));
    const bf16x8 b1 = *reinterpret_cast<const bf16x8*>((const char*)Ks + KSWZ(32 + r32, cb));
    p0 = __builtin_amdgcn_mfma_f32_32x32x16_bf16(b0, qr[d0], p0, 0, 0, 0);
    p1 = __builtin_amdgcn_mfma_f32_32x32x16_bf16(b1, qr[d0], p1, 0, 0, 0);
    if (d0 & 1) SBAR(); }
}
#define A2_WAITL(n) do { asm volatile("s_waitcnt lgkmcnt(" #n ")" ::: "memory"); SBAR(); } while (0)
__device__ __forceinline__ void kq_rd(int a0, bf16x8& b0, bf16x8& b1) {
  asm volatile("ds_read_b128 %0, %1" : "=&v"(b0) : "v"(a0) : "memory");
  asm volatile("ds_read_b128 %0, %1 offset:8192" : "=&v"(b1) : "v"(a0) : "memory");
}
__device__ __forceinline__ void qkt_pipe(f32x16& p0, f32x16& p1, int kaddr, int sw, int hi, const bf16x8* qr) {
  p0 = f32x16{}; p1 = f32x16{};
  bf16x8 a0, a1, b0, b1;
#define KA(d0) (kaddr + (((d0) * 32 + hi * 16) ^ sw))
#define KM(x0, x1, d0) do { p0 = __builtin_amdgcn_mfma_f32_32x32x16_bf16(x0, qr[d0], p0, 0, 0, 0); p1 = __builtin_amdgcn_mfma_f32_32x32x16_bf16(x1, qr[d0], p1, 0, 0, 0); } while (0)
  kq_rd(KA(0), a0, a1); kq_rd(KA(1), b0, b1);
  A2_WAITL(2); KM(a0, a1, 0); SBAR(); kq_rd(KA(2), a0, a1);
  A2_WAITL(2); KM(b0, b1, 1); SBAR(); kq_rd(KA(3), b0, b1);
  A2_WAITL(2); KM(a0, a1, 2); SBAR(); kq_rd(KA(4), a0, a1);
  A2_WAITL(2); KM(b0, b1, 3); SBAR(); kq_rd(KA(5), b0, b1);
  A2_WAITL(2); KM(a0, a1, 4); SBAR(); kq_rd(KA(6), a0, a1);
  A2_WAITL(2); KM(b0, b1, 5); SBAR(); kq_rd(KA(7), b0, b1);
  A2_WAITL(2); KM(a0, a1, 6);
  A2_WAITL(0); KM(b0, b1, 7);
#undef KA
#undef KM
}
template <int HB> __device__ __forceinline__ void pv_rd(int vb, s16x4& la, s16x4& ha, s16x4& lb, s16x4& hb) {
  constexpr int blk = HB >> 1, part = HB & 1, D0 = blk & 3, base = (blk >> 2) * 16384;
  la = tr_read<base + v_rd_off(D0, 2 * part, 0)>(vb); ha = tr_read<base + v_rd_off(D0, 2 * part, 1)>(vb);
  lb = tr_read<base + v_rd_off(D0, 2 * part + 1, 0)>(vb); hb = tr_read<base + v_rd_off(D0, 2 * part + 1, 1)>(vb);
}
template <int HB> __device__ __forceinline__ void pv_mm(f32x16* o, s16x4 la, s16x4 ha, s16x4 lb, s16x4 hb, bf16x8 pa0, bf16x8 pa1, bf16x8 pa2, bf16x8 pa3) {
#define PK(L, H) (bf16x8){L[0], L[1], L[2], L[3], H[0], H[1], H[2], H[3]}
  f32x16& od = o[HB >> 1];
  od = __builtin_amdgcn_mfma_f32_32x32x16_bf16((HB & 1) ? pa2 : pa0, PK(la, ha), od, 0, 0, 0);
  od = __builtin_amdgcn_mfma_f32_32x32x16_bf16((HB & 1) ? pa3 : pa1, PK(lb, hb), od, 0, 0, 0);
#undef PK
}
__device__ __forceinline__ void pv_pipe(f32x16* o, int vb, bf16x8 pa0, bf16x8 pa1, bf16x8 pa2, bf16x8 pa3) {
  s16x4 a0, a1, a2, a3, b0, b1, b2, b3;
  pv_rd<0>(vb, a0, a1, a2, a3); pv_rd<1>(vb, b0, b1, b2, b3);
#define STEP(H) A2_WAITL(4); pv_mm<H>(o, a0, a1, a2, a3, pa0, pa1, pa2, pa3); SBAR(); pv_rd<H + 2>(vb, a0, a1, a2, a3); \
                A2_WAITL(4); pv_mm<H + 1>(o, b0, b1, b2, b3, pa0, pa1, pa2, pa3); SBAR(); pv_rd<H + 3>(vb, b0, b1, b2, b3);
  STEP(0) STEP(2) STEP(4) STEP(6) STEP(8) STEP(10) STEP(12)
#undef STEP
  A2_WAITL(4); pv_mm<14>(o, a0, a1, a2, a3, pa0, pa1, pa2, pa3);
  A2_WAITL(0); pv_mm<15>(o, b0, b1, b2, b3, pa0, pa1, pa2, pa3);
}
__device__ __forceinline__ void qkt_asm(f32x16& p0, f32x16& p1, int kaddr, int sw, int hi, const bf16x8* qr) {
  p0 = f32x16{}; p1 = f32x16{};
#pragma unroll
  for (int d0 = 0; d0 < 8; ++d0) {
    const int a0 = kaddr + ((d0 * 32 + hi * 16) ^ sw);
    bf16x8 b0, b1;
    asm volatile("ds_read_b128 %0, %1" : "=&v"(b0) : "v"(a0) : "memory");
    asm volatile("ds_read_b128 %0, %1 offset:8192" : "=&v"(b1) : "v"(a0) : "memory");
    asm volatile("s_waitcnt lgkmcnt(0)" ::: "memory"); SBAR();
    p0 = __builtin_amdgcn_mfma_f32_32x32x16_bf16(b0, qr[d0], p0, 0, 0, 0);
    p1 = __builtin_amdgcn_mfma_f32_32x32x16_bf16(b1, qr[d0], p1, 0, 0, 0);
  }
}
template <int D0> __device__ __forceinline__ void pv_one_lean(f32x16& od, int vb, bf16x8 pa0, bf16x8 pa1, bf16x8 pa2, bf16x8 pa3) {
#define PK(L, H) (bf16x8){L[0], L[1], L[2], L[3], H[0], H[1], H[2], H[3]}
  { const s16x4 l0 = tr_read<v_rd_off(D0, 0, 0)>(vb), h0 = tr_read<v_rd_off(D0, 0, 1)>(vb), l1 = tr_read<v_rd_off(D0, 1, 0)>(vb), h1 = tr_read<v_rd_off(D0, 1, 1)>(vb);
    asm volatile("s_waitcnt lgkmcnt(0)" ::: "memory"); SBAR();
    od = __builtin_amdgcn_mfma_f32_32x32x16_bf16(pa0, PK(l0, h0), od, 0, 0, 0);
    od = __builtin_amdgcn_mfma_f32_32x32x16_bf16(pa1, PK(l1, h1), od, 0, 0, 0); }
  { const s16x4 l2 = tr_read<v_rd_off(D0, 2, 0)>(vb), h2 = tr_read<v_rd_off(D0, 2, 1)>(vb), l3 = tr_read<v_rd_off(D0, 3, 0)>(vb), h3 = tr_read<v_rd_off(D0, 3, 1)>(vb);
    asm volatile("s_waitcnt lgkmcnt(0)" ::: "memory"); SBAR();
    od = __builtin_amdgcn_mfma_f32_32x32x16_bf16(pa2, PK(l2, h2), od, 0, 0, 0);
    od = __builtin_amdgcn_mfma_f32_32x32x16_bf16(pa3, PK(l3, h3), od, 0, 0, 0); }
#undef PK
}
__device__ __forceinline__ void pv_d0_lean(f32x16* o, int vb, bf16x8 pa0, bf16x8 pa1, bf16x8 pa2, bf16x8 pa3) {
  pv_one_lean<0>(o[0], vb, pa0, pa1, pa2, pa3); pv_one_lean<1>(o[1], vb, pa0, pa1, pa2, pa3); pv_one_lean<2>(o[2], vb, pa0, pa1, pa2, pa3); pv_one_lean<3>(o[3], vb, pa0, pa1, pa2, pa3);
}
constexpr int A2_K = 0, A2_V = 32768, A2_WS = 131072 + 1024;
template <int MODE> __device__ __forceinline__ void attn256_unit(const bf16* __restrict__ Qb, const bf16* __restrict__ Kh, const bf16* __restrict__ V0h, const bf16* __restrict__ V1h,
                                             bf16* Ob, int ntiles, char* lds, ATT_LAS unsigned char* ldsl, bf16* __restrict__ OAb, const float* __restrict__ subw, float lam, float eps, float osc) {
  int tid = threadIdx.x; asm volatile("" : "+v"(tid));
  const int wid = tid >> 6, lane = tid & 63, r32 = lane & 31, hi = lane >> 5;
  float m_reg = -1e30f, l_reg = 0; f32x16 o[8] = {}; bf16x8 qr[8];
  { const bf16* Qw = Qb + (long)(wid * QBLK + r32) * 128 + hi * 8;
#pragma unroll
    for (int d0 = 0; d0 < 8; ++d0) qr[d0] = *reinterpret_cast<const bf16x8*>(Qw + d0 * 16);
#pragma unroll
    for (int d0 = 0; d0 < 8; ++d0) asm volatile("" : "+v"(qr[d0])); }
  unsigned koff, voff;
  { const int L = wid * 1024 + lane * 16;
    { const int row = L >> 8; koff = (unsigned)(row * 256 + ((L & 255) ^ ((row & 7) << 4))); }
    { const int sub = L >> 9, w = L & 511, kk = ((sub >> 2) << 3) | (w >> 6), k = (kk & ~0xC) | ((kk & 4) << 1) | ((kk & 8) >> 1), c = (sub & 3) * 32 + ((w & 63) >> 1); voff = (unsigned)(k * 256 + c * 2); } }
  const unsigned ldsw = (unsigned)__builtin_amdgcn_readfirstlane(wid) * 1024u;
#define A2_DMA(kbuf, vbuf, t) do { const char* kb_ = (const char*)Kh + (size_t)(t) * (64 * 256); const char* v0_ = (const char*)V0h + (size_t)(t) * (64 * 256); const char* v1_ = (const char*)V1h + (size_t)(t) * (64 * 256); \
    _Pragma("unroll") for (int i_ = 0; i_ < 2; ++i_) { \
      __builtin_amdgcn_global_load_lds((const unsigned*)(kb_ + i_ * 8192 + koff), (ATT_LAS unsigned*)(ldsl + A2_K + (kbuf) * 16384 + ldsw + i_ * 8192), 16, 0, 0); \
      __builtin_amdgcn_global_load_lds((const unsigned*)(v0_ + i_ * 8192 + voff), (ATT_LAS unsigned*)(ldsl + A2_V + (vbuf) * 32768 + ldsw + i_ * 8192), 16, 0, 0); \
      __builtin_amdgcn_global_load_lds((const unsigned*)(v1_ + i_ * 8192 + voff), (ATT_LAS unsigned*)(ldsl + A2_V + (vbuf) * 32768 + 16384 + ldsw + i_ * 8192), 16, 0, 0); } } while (0)
#define A2_SYNC() do { asm volatile("s_waitcnt vmcnt(0) lgkmcnt(0)" ::: "memory"); __builtin_amdgcn_s_barrier(); asm volatile("" ::: "memory"); } while (0)
  const int vb0 = (int)(uintptr_t)(lds + A2_V) + v_rd_base(lane);
  const int kad0 = (int)(uintptr_t)(lds + A2_K) + r32 * 256, ksw = (r32 & 7) << 4;
  const bool grpB = __builtin_amdgcn_readfirstlane(wid) >= 4;
  A2_DMA(0, 0, 0); A2_SYNC();
  int vc = 0, vp = 2, vn = 1;
  bf16x8 pa0, pa1, pa2, pa3;
  for (int j = 0; j < ntiles; ++j) {
    if (j + 1 < ntiles) A2_DMA((j + 1) & 1, vn, j + 1);
    SBAR();
    if (grpB && j > 0) { pv_pipe(o, vb0 + vp * 32768, pa0, pa1, pa2, pa3); }
    f32x16 p0, p1; float mn, alpha;
    qkt_pipe(p0, p1, kad0 + (j & 1) * 16384, ksw, hi, qr);
    partialSM(p0, p1, m_reg, mn, alpha);
    finishSM(p0, p1, alpha, l_reg, pa0, pa1, pa2, pa3); SBAR();
    if (__any(alpha < 1.f)) {
#pragma unroll
      for (int r = 0; r < 16; ++r) { const float a0_ = __uint_as_float(__builtin_amdgcn_readlane(__float_as_uint(alpha), crow(r, 0))), a1_ = __uint_as_float(__builtin_amdgcn_readlane(__float_as_uint(alpha), crow(r, 1)));
        const float ar = hi ? a1_ : a0_;
#pragma unroll
        for (int d = 0; d < 8; ++d) o[d][r] *= ar; } }
    if (!grpB) { pv_pipe(o, vb0 + vc * 32768, pa0, pa1, pa2, pa3); }
    A2_SYNC();
    vp = vc; vc = vn; vn = (vn == 2) ? 0 : vn + 1;
  }
  if (grpB) { pv_pipe(o, vb0 + vp * 32768, pa0, pa1, pa2, pa3); }
  { int t2 = threadIdx.x; asm volatile("" : "+v"(t2));
    const int wid2 = t2 >> 6, r32b = t2 & 31, hib = (t2 >> 5) & 1;
    float* li2 = (float*)(lds + A2_WS) + wid2 * 64;
    if (hib == 0) li2[r32b] = l_reg; asm volatile("s_waitcnt lgkmcnt(0)" ::: "memory");
    bf16* Ow = Ob + (long)(wid2 * QBLK) * LDO + r32b;
    if constexpr (MODE == 0) {
#pragma unroll
      for (int r = 0; r < 16; ++r) { const int orow = crow(r, hib); const float rl = __builtin_amdgcn_rcpf(li2[orow]);
#pragma unroll
        for (int d0 = 0; d0 < 8; ++d0) Ow[(long)orow * LDO + d0 * 32] = (bf16)(cvtpk(o[d0][r] * rl, 0.f) & 0xffffu); }
    } else {
      float sw[8];
#pragma unroll
      for (int d0 = 0; d0 < 8; ++d0) sw[d0] = subw[d0 * 32 + r32b] * osc;
      bf16* OAw = OAb + (long)(wid2 * QBLK) * 1024 + r32b;
#pragma unroll
      for (int r = 0; r < 16; ++r) { const int orow = crow(r, hib); const float rl = __builtin_amdgcn_rcpf(li2[orow]) * lam; float dv[8]; float ss = 0.f;
#pragma unroll
        for (int d0 = 0; d0 < 8; ++d0) { const float o0 = __uint_as_float(((unsigned)Ow[(long)orow * LDO + d0 * 32]) << 16); dv[d0] = o0 - o[d0][r] * rl; ss += dv[d0] * dv[d0]; }
#pragma unroll
        for (int sh = 1; sh < 32; sh <<= 1) ss += __shfl_xor(ss, sh);
        const float rs = __builtin_amdgcn_rsqf(ss * (1.0f / 256.0f) + eps);
#pragma unroll
        for (int d0 = 0; d0 < 8; ++d0) OAw[(long)orow * 1024 + d0 * 32] = (bf16)(cvtpk(dv[d0] * rs * sw[d0], 0.f) & 0xffffu); }
    } }
  A2_SYNC();
#undef A2_DMA
#undef A2_SYNC
}

typedef float f32x4a __attribute__((ext_vector_type(4)));
#if defined(ATT_CLUSTER_PRIO)
#define A3_PRIO(p) __builtin_amdgcn_s_setprio(p)
#else
#define A3_PRIO(p) do { } while (0)
#endif
__device__ __forceinline__ float xmax16(float v) { auto r = __builtin_amdgcn_permlane16_swap(__float_as_uint(v), __float_as_uint(v), false, false); return fmaxf(__uint_as_float(r[0]), __uint_as_float(r[1])); }
__device__ __forceinline__ float xmax32(float v) { auto r = __builtin_amdgcn_permlane32_swap(__float_as_uint(v), __float_as_uint(v), false, false); return fmaxf(__uint_as_float(r[0]), __uint_as_float(r[1])); }
__device__ __forceinline__ float xadd16(float v) { auto r = __builtin_amdgcn_permlane16_swap(__float_as_uint(v), __float_as_uint(v), false, false); return __uint_as_float(r[0]) + __uint_as_float(r[1]); }
__device__ __forceinline__ float xadd32(float v) { auto r = __builtin_amdgcn_permlane32_swap(__float_as_uint(v), __float_as_uint(v), false, false); return __uint_as_float(r[0]) + __uint_as_float(r[1]); }
__device__ __forceinline__ unsigned cvtpk_b(float lo, float hi) { typedef __bf16 bf2 __attribute__((ext_vector_type(2))); typedef float f2 __attribute__((ext_vector_type(2))); f2 v = {lo, hi}; bf2 b = __builtin_convertvector(v, bf2); return __builtin_bit_cast(unsigned, b); }
__device__ __forceinline__ void rows4(float x, int g, float (&out)[4]) {
#pragma unroll
  for (int j = 0; j < 4; ++j) { const float a0 = __uint_as_float(__builtin_amdgcn_readlane(__float_as_uint(x), j)), a1 = __uint_as_float(__builtin_amdgcn_readlane(__float_as_uint(x), 4 + j)),
      a2 = __uint_as_float(__builtin_amdgcn_readlane(__float_as_uint(x), 8 + j)), a3 = __uint_as_float(__builtin_amdgcn_readlane(__float_as_uint(x), 12 + j));
    out[j] = g == 0 ? a0 : g == 1 ? a1 : g == 2 ? a2 : a3; }
}
template <int OFF> __device__ __forceinline__ bf16x8 krd(int a) { bf16x8 r; asm volatile("ds_read_b128 %0, %1 offset:%2" : "=&v"(r) : "v"(a), "i"(OFF) : "memory"); return r; }
template <int MODE> __device__ __forceinline__ void attn256_unit16(const bf16* __restrict__ Qb, const bf16* __restrict__ Kh, const bf16* __restrict__ V0h, const bf16* __restrict__ V1h,
                                             bf16* Ob, int ntiles, char* lds, ATT_LAS unsigned char* ldsl, bf16* __restrict__ OAb, const float* __restrict__ subw, float lam, float eps, float osc) {
  constexpr float C = SCALE * 1.4426950408889634f;
  int tid = threadIdx.x; asm volatile("" : "+v"(tid));
  const int wid = tid >> 6, lane = tid & 63, q16 = lane & 15, g = lane >> 4;
  float m_reg[2] = {-1e30f, -1e30f}, l_reg[2] = {0.f, 0.f};
  f32x4a o[2][16];
#pragma unroll
  for (int a_ = 0; a_ < 2; ++a_)
#pragma unroll
    for (int b_ = 0; b_ < 16; ++b_) o[a_][b_] = (f32x4a){0.f, 0.f, 0.f, 0.f};
  bf16x8 qr[2][4];
  { const bf16* Qw = Qb + (long)(wid * 32 + q16) * 128 + g * 8;
#pragma unroll
    for (int qb = 0; qb < 2; ++qb)
#pragma unroll
      for (int s = 0; s < 4; ++s) qr[qb][s] = *reinterpret_cast<const bf16x8*>(Qw + qb * 16 * 128 + s * 32);
#pragma unroll
    for (int qb = 0; qb < 2; ++qb)
#pragma unroll
      for (int s = 0; s < 4; ++s) asm volatile("" : "+v"(qr[qb][s])); }
  unsigned koff, voff;
  { const int L = wid * 1024 + lane * 16;
    { const int row = L >> 8; koff = (unsigned)(row * 256 + ((L & 255) ^ ((row & 15) << 4))); }
    { const int sub = L >> 9, w = L & 511, kk = ((sub >> 2) << 3) | (w >> 6), k = (kk & ~0xC) | ((kk & 4) << 1) | ((kk & 8) >> 1), c = (sub & 3) * 32 + (((w & 63) ^ (((sub >> 2) & 1) << 5)) >> 1); voff = (unsigned)(k * 256 + c * 2); } }
  const unsigned ldsw = (unsigned)__builtin_amdgcn_readfirstlane(wid) * 1024u;
#define B3_DMA(kbuf, vbuf, t) do { const char* kb_ = (const char*)Kh + (size_t)(t) * (64 * 256); const char* v0_ = (const char*)V0h + (size_t)(t) * (64 * 256); const char* v1_ = (const char*)V1h + (size_t)(t) * (64 * 256); \
    _Pragma("unroll") for (int i_ = 0; i_ < 2; ++i_) { \
      __builtin_amdgcn_global_load_lds((const unsigned*)(kb_ + i_ * 8192 + koff), (ATT_LAS unsigned*)(ldsl + A2_K + (kbuf) * 16384 + ldsw + i_ * 8192), 16, 0, 0); \
      __builtin_amdgcn_global_load_lds((const unsigned*)(v0_ + i_ * 8192 + voff), (ATT_LAS unsigned*)(ldsl + A2_V + (vbuf) * 32768 + ldsw + i_ * 8192), 16, 0, 0); \
      __builtin_amdgcn_global_load_lds((const unsigned*)(v1_ + i_ * 8192 + voff), (ATT_LAS unsigned*)(ldsl + A2_V + (vbuf) * 32768 + 16384 + ldsw + i_ * 8192), 16, 0, 0); } } while (0)
#define B3_SYNC() do { asm volatile("s_waitcnt vmcnt(0) lgkmcnt(0)" ::: "memory"); __builtin_amdgcn_s_barrier(); asm volatile("" ::: "memory"); } while (0)
#define B3_WAITL(n) do { asm volatile("s_waitcnt lgkmcnt(" #n ")" ::: "memory"); SBAR(); } while (0)
  int ka[4];
#pragma unroll
  for (int s = 0; s < 4; ++s) ka[s] = (int)(uintptr_t)(lds + A2_K) + q16 * 256 + ((64 * s + 16 * g) ^ (q16 << 4));
  const int gs = ((g & 1) << 1) | (g >> 1);
  const int vbE = (int)(uintptr_t)(lds + A2_V) + (gs >> 1) * 2048 + ((q16 >> 2) + 4 * (gs & 1)) * 64 + 8 * (q16 & 3) + (g & 1) * 32, vbO = vbE + 32 - (g & 1) * 64;
#define VOFF(cb, m, t) ((t) * 4096 + (m) * 8192 + (((cb) & 7) >> 1) * 512 + ((cb) >> 3) * 16384)
  const bool grpB = __builtin_amdgcn_readfirstlane(wid) >= 4;
  B3_DMA(0, 0, 0); B3_SYNC();
#if defined(ATT_PRIO)
  if (grpB) __builtin_amdgcn_s_setprio(1);
#endif
  int vc = 0, vp = 2, vn = 1;
  bf16x8 pa[2][2];
#define PV_RD(cb, x0, x1, x2, x3, vb) do { const int vq_ = (((cb) & 1) ? vbO : vbE) + (vb); x0 = tr_read<VOFF(cb, 0, 0)>(vq_); x1 = tr_read<VOFF(cb, 0, 1)>(vq_); x2 = tr_read<VOFF(cb, 1, 0)>(vq_); x3 = tr_read<VOFF(cb, 1, 1)>(vq_); } while (0)
#define PKB(L, H) (bf16x8){L[0], L[1], L[2], L[3], H[0], H[1], H[2], H[3]}
#define PV_MM(cb, x0, x1, x2, x3) do { const bf16x8 b0_ = PKB(x0, x1), b1_ = PKB(x2, x3); \
    o[0][cb] = __builtin_amdgcn_mfma_f32_16x16x32_bf16(pa[0][0], b0_, o[0][cb], 0, 0, 0); o[1][cb] = __builtin_amdgcn_mfma_f32_16x16x32_bf16(pa[1][0], b0_, o[1][cb], 0, 0, 0); \
    o[0][cb] = __builtin_amdgcn_mfma_f32_16x16x32_bf16(pa[0][1], b1_, o[0][cb], 0, 0, 0); o[1][cb] = __builtin_amdgcn_mfma_f32_16x16x32_bf16(pa[1][1], b1_, o[1][cb], 0, 0, 0); } while (0)
#define PV_STEP(cb) B3_WAITL(4); PV_MM(cb, a0, a1, a2, a3); SBAR(); PV_RD(cb + 2, a0, a1, a2, a3, vb_); B3_WAITL(4); PV_MM(cb + 1, b0, b1, b2, b3); SBAR(); PV_RD(cb + 3, b0, b1, b2, b3, vb_);
#define PV_TILE(vbuf) do { const int vb_ = (vbuf) * 32768; s16x4 a0, a1, a2, a3, b0, b1, b2, b3; A3_PRIO(1); \
    PV_RD(0, a0, a1, a2, a3, vb_); PV_RD(1, b0, b1, b2, b3, vb_); \
    PV_STEP(0) PV_STEP(2) PV_STEP(4) PV_STEP(6) PV_STEP(8) PV_STEP(10) PV_STEP(12) \
    B3_WAITL(4); PV_MM(14, a0, a1, a2, a3); B3_WAITL(0); PV_MM(15, b0, b1, b2, b3); A3_PRIO(0); } while (0)
  for (int j = 0; j < ntiles; ++j) {
    if (j + 1 < ntiles) B3_DMA((j + 1) & 1, vn, j + 1);
    SBAR();
    if (grpB && j > 0) PV_TILE(vp);
    f32x4a sc[4][2];
#pragma unroll
    for (int kb = 0; kb < 4; ++kb) { sc[kb][0] = (f32x4a){0.f, 0.f, 0.f, 0.f}; sc[kb][1] = (f32x4a){0.f, 0.f, 0.f, 0.f}; }
    { const int kofs = (j & 1) * 16384; bf16x8 a0, a1, b0, b1;
#define QK_RD(kb, sp, x0, x1) do { x0 = krd<(kb) * 4096>(ka[2 * (sp)] + kofs); x1 = krd<(kb) * 4096>(ka[2 * (sp) + 1] + kofs); } while (0)
#define QK_MM(kb, sp, x0, x1) do { sc[kb][0] = __builtin_amdgcn_mfma_f32_16x16x32_bf16(x0, qr[0][2 * (sp)], sc[kb][0], 0, 0, 0); sc[kb][1] = __builtin_amdgcn_mfma_f32_16x16x32_bf16(x0, qr[1][2 * (sp)], sc[kb][1], 0, 0, 0); \
      sc[kb][0] = __builtin_amdgcn_mfma_f32_16x16x32_bf16(x1, qr[0][2 * (sp) + 1], sc[kb][0], 0, 0, 0); sc[kb][1] = __builtin_amdgcn_mfma_f32_16x16x32_bf16(x1, qr[1][2 * (sp) + 1], sc[kb][1], 0, 0, 0); } while (0)
      A3_PRIO(1); QK_RD(0, 0, a0, a1); QK_RD(0, 1, b0, b1);
      B3_WAITL(2); QK_MM(0, 0, a0, a1); SBAR(); QK_RD(1, 0, a0, a1);
      B3_WAITL(2); QK_MM(0, 1, b0, b1); SBAR(); QK_RD(1, 1, b0, b1);
      B3_WAITL(2); QK_MM(1, 0, a0, a1); SBAR(); QK_RD(2, 0, a0, a1);
      B3_WAITL(2); QK_MM(1, 1, b0, b1); SBAR(); QK_RD(2, 1, b0, b1);
      B3_WAITL(2); QK_MM(2, 0, a0, a1); SBAR(); QK_RD(3, 0, a0, a1);
      B3_WAITL(2); QK_MM(2, 1, b0, b1); SBAR(); QK_RD(3, 1, b0, b1);
      B3_WAITL(2); QK_MM(3, 0, a0, a1);
      B3_WAITL(0); QK_MM(3, 1, b0, b1); A3_PRIO(0);
#undef QK_RD
#undef QK_MM
    }
    float pm[2], alpha[2];
#pragma unroll
    for (int qb = 0; qb < 2; ++qb) { float v = sc[0][qb][0];
#pragma unroll
      for (int kb = 0; kb < 4; ++kb)
#pragma unroll
        for (int e = 0; e < 4; ++e) v = fmaxf(v, sc[kb][qb][e]);
      pm[qb] = xmax32(xmax16(v)); }
    if (__builtin_expect(__all(pm[0] - m_reg[0] <= THR / SCALE && pm[1] - m_reg[1] <= THR / SCALE), 1)) { alpha[0] = 1.f; alpha[1] = 1.f; }
    else {
#pragma unroll
      for (int qb = 0; qb < 2; ++qb) { const float mn = fmaxf(m_reg[qb], pm[qb]); alpha[qb] = __builtin_amdgcn_exp2f((m_reg[qb] - mn) * C); m_reg[qb] = mn; } }
#pragma unroll
    for (int qb = 0; qb < 2; ++qb) { const float mnC = -m_reg[qb] * C; float ps = 0.f;
#pragma unroll
      for (int kb = 0; kb < 4; ++kb) {
#pragma unroll
        for (int e = 0; e < 4; ++e) { sc[kb][qb][e] = __builtin_amdgcn_exp2f(fmaf(sc[kb][qb][e], C, mnC)); ps += sc[kb][qb][e]; } }
      ps = xadd32(xadd16(ps));
      l_reg[qb] = l_reg[qb] * alpha[qb] + ps;
#pragma unroll
      for (int m = 0; m < 2; ++m) { u32x4 w = {cvtpk_b(sc[2 * m][qb][0], sc[2 * m][qb][1]), cvtpk_b(sc[2 * m][qb][2], sc[2 * m][qb][3]), cvtpk_b(sc[2 * m + 1][qb][0], sc[2 * m + 1][qb][1]), cvtpk_b(sc[2 * m + 1][qb][2], sc[2 * m + 1][qb][3])};
        pa[qb][m] = *reinterpret_cast<bf16x8*>(&w); } }
    SBAR();
    if (__any(alpha[0] < 1.f || alpha[1] < 1.f)) {
#pragma unroll
      for (int qb = 0; qb < 2; ++qb) { float ar[4]; rows4(alpha[qb], g, ar);
#pragma unroll
        for (int cb = 0; cb < 16; ++cb)
#pragma unroll
          for (int e = 0; e < 4; ++e) o[qb][cb][e] *= ar[e]; } }
    if (!grpB) PV_TILE(vc);
    B3_SYNC();
    vp = vc; vc = vn; vn = (vn == 2) ? 0 : vn + 1;
  }
  if (grpB) PV_TILE(vp);
#if defined(ATT_PRIO)
  __builtin_amdgcn_s_setprio(0);
#endif
  { int t2 = threadIdx.x; asm volatile("" : "+v"(t2));
    const int wid2 = t2 >> 6, c16 = t2 & 15, g2 = (t2 >> 4) & 3;
    bf16* Ow = Ob + (long)(wid2 * 32 + 4 * g2) * LDO + c16;
    float inv[2][4];
#pragma unroll
    for (int qb = 0; qb < 2; ++qb) { float lr[4]; rows4(l_reg[qb], g2, lr);
#pragma unroll
      for (int e = 0; e < 4; ++e) inv[qb][e] = __builtin_amdgcn_rcpf(lr[e]); }
    if constexpr (MODE == 0) {
#pragma unroll
      for (int qb = 0; qb < 2; ++qb)
#pragma unroll
        for (int e = 0; e < 4; ++e)
#pragma unroll
          for (int cb = 0; cb < 16; ++cb) Ow[(long)(qb * 16 + e) * LDO + cb * 16] = (bf16)(cvtpk_b(o[qb][cb][e] * inv[qb][e], 0.f) & 0xffffu);
    } else {
      float sw[16];
#pragma unroll
      for (int cb = 0; cb < 16; ++cb) sw[cb] = subw[cb * 16 + c16] * osc;
      bf16* OAw = OAb + (long)(wid2 * 32 + 4 * g2) * 1024 + c16;
#pragma unroll
      for (int qb = 0; qb < 2; ++qb)
#pragma unroll
        for (int e = 0; e < 4; ++e) { unsigned short of[16];
#pragma unroll
          for (int cb = 0; cb < 16; ++cb) of[cb] = Ow[(long)(qb * 16 + e) * LDO + cb * 16];
          asm volatile("" ::: "memory");
          float dv[16]; float ss = 0.f; const float rl = inv[qb][e] * lam;
#pragma unroll
          for (int cb = 0; cb < 16; ++cb) { dv[cb] = __uint_as_float(((unsigned)of[cb]) << 16) - o[qb][cb][e] * rl; ss += dv[cb] * dv[cb]; }
#pragma unroll
          for (int sh = 1; sh < 16; sh <<= 1) ss += __shfl_xor(ss, sh);
          const float rs = __builtin_amdgcn_rsqf(ss * (1.0f / 256.0f) + eps);
#pragma unroll
          for (int cb = 0; cb < 16; ++cb) OAw[(long)(qb * 16 + e) * 1024 + cb * 16] = (bf16)(cvtpk_b(dv[cb] * rs * sw[cb], 0.f) & 0xffffu);
          asm volatile("" ::: "memory"); }
    } }
  B3_SYNC();
#undef B3_DMA
#undef B3_SYNC
#undef B3_WAITL
#undef VOFF
#undef PV_RD
#undef PKB
#undef PV_MM
#undef PV_STEP
#undef PV_TILE
}

__device__ __forceinline__ void na_unit(const bf16* __restrict__ QKV, bf16* __restrict__ ON, const float* __restrict__ rpb, int b, int h, int rblk, char* lds) {
  constexpr float C = SCALE * 1.4426950408889634f, L2E = 1.4426950408889634f;
  const int tid = threadIdx.x, wid = tid >> 6, lane = tid & 63, r32 = lane & 31, hi = lane >> 5;
  bf16* V_lds = (bf16*)lds; bf16* K_lds = (bf16*)(lds + 2 * SHM_V);
  float* wsf = (float*)(lds + 2 * SHM_V + 2 * SHM_K) + wid * 64; float* li_l = wsf; float* al_l = wsf + 32;
  float* biasL = (float*)(lds + 2 * SHM_V + 2 * SHM_K + NW * 64 * 4);
  const int r = rblk * 4 + (wid >> 1), c = (wid & 1) * 32 + r32;
  const int rs = min(max(r - 4, 0), 120), cs = min(max(c - 8, 0), 48);
  bf16x8 qr[8];
  const bf16* const hb = QKV + ((long)b * 48 + h) * 8192 * 128;
  { const bf16* Qw = hb + (24L * 8192 + r * 64 + c) * 128 + hi * 8;
#pragma unroll
    for (int d0 = 0; d0 < 8; ++d0) qr[d0] = *reinterpret_cast<const bf16x8*>(Qw + d0 * 16); }
  for (int idx = tid; idx < 15 * 32; idx += 512) { const int dr = idx >> 5, dc = idx & 31; biasL[idx] = dc < 31 ? rpb[(h * 15 + dr) * 31 + dc] * L2E : 0.f; }
  const int kr_lo = min(max(rblk * 4 - 4, 0), 120), kr_hi = min(max(rblk * 4 + 3 - 4, 0), 120) + 7;
  const int sr = tid >> 4, sc = (tid & 15) * 8, vst0 = v_st(sr, sc), vst1 = v_st(32 + sr, sc);
  const int vb0 = (int)(uintptr_t)V_lds + v_rd_base(lane);
  float m_reg = -1e30f, l_reg = 0.f; f32x16 o[4] = {};
  const bf16* kp = hb + (32L * 8192 + kr_lo * 64 + sr) * 128 + sc;
  bf16x8 k0 = *reinterpret_cast<const bf16x8*>(kp), k1 = *reinterpret_cast<const bf16x8*>(kp + 32 * 128);
  bf16x8 v0 = *reinterpret_cast<const bf16x8*>(kp + 8L * 8192 * 128), v1 = *reinterpret_cast<const bf16x8*>(kp + 8L * 8192 * 128 + 32 * 128);
  for (int kr = kr_lo; kr <= kr_hi; ++kr) {
    const int bo = ((kr - kr_lo) & 1) * (int)SHM_V;
    *(bf16x8*)((char*)K_lds + bo + KSWZ(sr, sc * 2)) = k0; *(bf16x8*)((char*)K_lds + bo + KSWZ(32 + sr, sc * 2)) = k1;
    *(bf16x8*)((char*)V_lds + bo + vst0) = v0; *(bf16x8*)((char*)V_lds + bo + vst1) = v1;
    __syncthreads();
    if (kr < kr_hi) { kp += 64 * 128;
      k0 = *reinterpret_cast<const bf16x8*>(kp); k1 = *reinterpret_cast<const bf16x8*>(kp + 32 * 128);
      v0 = *reinterpret_cast<const bf16x8*>(kp + 8L * 8192 * 128); v1 = *reinterpret_cast<const bf16x8*>(kp + 8L * 8192 * 128 + 32 * 128); }
    if (kr >= rs && kr < rs + 8) {
      f32x16 p0, p1; qkt(p0, p1, (const bf16*)((const char*)K_lds + bo), qr, r32, hi);
      const float* bl = biasL + (kr - r + 7) * 32;
      float pmax = -INFINITY;
#pragma unroll
      for (int rr = 0; rr < 16; ++rr) { const int kc0 = crow(rr, hi), kc1 = kc0 + 32;
        const bool ok0 = (unsigned)(kc0 - cs) < 16u, ok1 = (unsigned)(kc1 - cs) < 16u;
        const float b0 = bl[ok0 ? kc0 - c + 15 : 0], b1 = bl[ok1 ? kc1 - c + 15 : 0];
        p0[rr] = ok0 ? fmaf(p0[rr], C, b0) : -INFINITY; p1[rr] = ok1 ? fmaf(p1[rr], C, b1) : -INFINITY;
        pmax = fmaxf(pmax, fmaxf(p0[rr], p1[rr])); }
      { auto t = __builtin_amdgcn_permlane32_swap(__float_as_uint(pmax), __float_as_uint(pmax), false, false);
        pmax = fmaxf(__uint_as_float(t[0]), __uint_as_float(t[1])); }
      const bool grow = !__all(pmax - m_reg <= 11.5f);
      float alpha = 1.f;
      if (grow) { const float mn = fmaxf(m_reg, pmax); alpha = __builtin_amdgcn_exp2f(m_reg - mn); m_reg = mn; }
      float ps = 0.f;
#pragma unroll
      for (int rr = 0; rr < 16; ++rr) { p0[rr] = __builtin_amdgcn_exp2f(p0[rr] - m_reg); p1[rr] = __builtin_amdgcn_exp2f(p1[rr] - m_reg); ps += p0[rr] + p1[rr]; }
      { auto t = __builtin_amdgcn_permlane32_swap(__float_as_uint(ps), __float_as_uint(ps), false, false);
        ps = __uint_as_float(t[0]) + __uint_as_float(t[1]); }
      l_reg = l_reg * alpha + ps;
      if (grow) { if (hi == 0) al_l[r32] = alpha; asm volatile("s_waitcnt lgkmcnt(0)" ::: "memory");
#pragma unroll
        for (int d = 0; d < 4; ++d)
#pragma unroll
          for (int rr = 0; rr < 16; ++rr) o[d][rr] *= al_l[crow(rr, hi)]; }
      bf16x8 pa0, pa1, pa2, pa3;
#define PK4(P, BASE, OUT) do { unsigned a0 = cvtpk(P[BASE + 0], P[BASE + 1]), a1 = cvtpk(P[BASE + 2], P[BASE + 3]);   \
    unsigned b0_ = cvtpk(P[BASE + 4], P[BASE + 5]), b1_ = cvtpk(P[BASE + 6], P[BASE + 7]);                              \
    auto r0 = __builtin_amdgcn_permlane32_swap(a0, b0_, false, false); auto r1 = __builtin_amdgcn_permlane32_swap(a1, b1_, false, false); \
    u32x4 w = {r0[0], r1[0], r0[1], r1[1]}; OUT = *reinterpret_cast<bf16x8*>(&w); } while (0)
      PK4(p0, 0, pa0); PK4(p0, 8, pa1); PK4(p1, 0, pa2); PK4(p1, 8, pa3);
#undef PK4
      pv_d0(o, vb0 + bo, pa0, pa1, pa2, pa3);
    }
  }
  if (hi == 0) li_l[r32] = l_reg; asm volatile("s_waitcnt lgkmcnt(0)" ::: "memory");
  bf16* Ow = ON + ((long)b * 8192 + r * 64 + (wid & 1) * 32) * 1024 + h * 128;
#pragma unroll
  for (int rr = 0; rr < 16; ++rr) { const int orow = crow(rr, hi); const float rl = __builtin_amdgcn_rcpf(li_l[orow]);
#pragma unroll
    for (int d0 = 0; d0 < 4; ++d0) Ow[(long)orow * 1024 + d0 * 32 + r32] = (bf16)(cvtpk(o[d0][rr] * rl, 0.f) & 0xffffu); }
  __syncthreads();
}
}

constexpr int NWAVES = 8;
constexpr int BATCH = 4, SEQ = 8192, DM = 2048, MTOK = BATCH * SEQ, DFF = 8192, NIN = 10240;
constexpr float EPS = 1e-6f;
constexpr size_t MiB = 1u << 20;
constexpr size_t WS_SS = 0;
constexpr size_t WS_ROPE = 0;
constexpr size_t WS_CTL = 4 * MiB, CTL_ZERO_BYTES = 262144, WS_CNT = WS_CTL + 65536;
constexpr size_t WS_WIN = 8 * MiB, WS_WA = 48 * MiB, WS_WB = 52 * MiB, WS_WOUT = 56 * MiB, WS_WUP = 64 * MiB, WS_WDN = 96 * MiB;
constexpr size_t WS_H1 = 128 * MiB;
constexpr size_t WS_ON = 128 * MiB, WS_OA = 192 * MiB, WS_H2 = 128 * MiB;
constexpr size_t WS_QKV = 256 * MiB;
constexpr size_t WS_T = 256 * MiB, WS_MX = 512 * MiB, WS_U = 256 * MiB;
constexpr size_t WS_G = 640 * MiB;
constexpr size_t WS_OD = 896 * MiB;
constexpr size_t WS_Y = 896 * MiB;
constexpr size_t WS_Y2 = 768 * MiB;
constexpr size_t WS_END = 1024 * MiB;
constexpr int LDS_BYTES = 147456, MISC_OFF = 131072 + 320;

typedef unsigned short bf16;
typedef float f32x4 __attribute__((ext_vector_type(4)));
typedef unsigned u32x4v __attribute__((ext_vector_type(4)));
typedef unsigned u32x2v __attribute__((ext_vector_type(2)));
#define LAS __attribute__((address_space(3)))
#define LDS_WAIT() asm volatile("s_waitcnt lgkmcnt(0)" ::: "memory")

__device__ __forceinline__ unsigned pk2(float lo, float hi) { return pg8::cvt_pk_bf16(lo, hi); }
__device__ __forceinline__ float wave_sum(float v) {
#pragma unroll
    for (int o = 1; o < 64; o <<= 1) v += __shfl_xor(v, o);
    return v;
}
template <bool ROPE> __device__ __forceinline__ void p0_transpose_item(const float* W, int K, int N, bf16* WT, LAS float* scr, int item, int lane) {
    const int nblk = N / 32, kb = item / nblk, nb = item % nblk, k0 = 64 * kb, n0 = 32 * nb;
    f32x4 wv[8];
#pragma unroll
    for (int i = 0; i < 8; ++i) wv[i] = *(const f32x4*)(W + (size_t)(k0 + 8 * i + (lane >> 3)) * N + n0 + (lane & 7) * 4);
#pragma unroll
    for (int i = 0; i < 8; ++i) { LAS float* d = scr + (8 * i + (lane >> 3)) * 33 + (lane & 7) * 4; d[0] = wv[i].x; d[1] = wv[i].y; d[2] = wv[i].z; d[3] = wv[i].w; }
    LDS_WAIT(); asm volatile("" ::: "memory");
    const int c = lane & 7;
#pragma unroll
    for (int j = 0; j < 4; ++j) { const int n = (lane >> 3) + 8 * j; const LAS float* s = scr + (8 * c) * 33 + n;
        u32x4v o; o.x = pk2(s[0 * 33], s[1 * 33]); o.y = pk2(s[2 * 33], s[3 * 33]); o.z = pk2(s[4 * 33], s[5 * 33]); o.w = pk2(s[6 * 33], s[7 * 33]);
        int dn = n0 + n;
        if (ROPE && dn < 2048) { const int jj = dn & 127; dn = (dn & ~127) + (jj < 64 ? 2 * jj : 2 * (jj - 64) + 1); }
        *(u32x4v*)(WT + (size_t)dn * K + k0 + 8 * c) = o; }
    LDS_WAIT(); asm volatile("" ::: "memory");
}

#define XB_TMO      128
#define XB_XCNT(j)  (256  + 64 * (j))
#define XB_XSUB(j)  (1280 + 64 * (j))
#define XB_XGEN(j)  (2304 + 64 * (j))
#define XB_TOP      3328
#define XB_TOPGEN   3392
#define XCD_BAR_WORDS 3456
#define XB_SPIN_CAP (1u << 18)

__device__ __forceinline__ unsigned xb_ld(unsigned* p)              { return __hip_atomic_load(p, __ATOMIC_RELAXED, __HIP_MEMORY_SCOPE_AGENT); }
__device__ __forceinline__ unsigned xb_add(unsigned* p, unsigned v) { return __hip_atomic_fetch_add(p, v, __ATOMIC_RELAXED, __HIP_MEMORY_SCOPE_AGENT); }
__device__ __forceinline__ unsigned xb_xcc_id() { return (unsigned)__builtin_amdgcn_s_getreg((3 << 11) | 20) & 0xFu; }
#define XB_SPIN(cond, bar) do { unsigned _sp = 0; while (cond) { __builtin_amdgcn_s_sleep(1); \
    if ((++_sp & 255u) == 0u) { if (xb_ld(&(bar)[XB_TMO])) break; if (_sp > XB_SPIN_CAP) { atomicAdd(&(bar)[XB_TMO], 1u); break; } } } } while (0)

struct XcdBarrier {
    unsigned* bar; unsigned x;
    volatile LAS unsigned* st;
};

__device__ __forceinline__ XcdBarrier xcd_barrier_post(unsigned* bar, volatile LAS unsigned* st) {
    XcdBarrier b; b.bar = bar; b.x = xb_xcc_id(); b.st = st;
    if (threadIdx.x == 0) (void)xb_add(&bar[XB_XCNT(b.x)], 1u);
    return b;
}
__device__ __forceinline__ void xcd_barrier_complete(unsigned* bar, unsigned x, unsigned& nloc, unsigned& nx) {
    const unsigned G = gridDim.x * gridDim.y * gridDim.z;
    unsigned sum, cnt, mine, sp = 0u;
    for (;;) {
        sum = 0u; cnt = 0u; mine = 0u;
#pragma unroll
        for (unsigned j = 0; j < 16; ++j) { const unsigned c = xb_ld(&bar[XB_XCNT(j)]); sum += c; cnt += (c > 0u) ? 1u : 0u; mine = (j == x) ? c : mine; }
        if (sum == G) break;
        __builtin_amdgcn_s_sleep(1);
        if ((++sp & 255u) == 0u) { if (xb_ld(&bar[XB_TMO])) break; if (sp > XB_SPIN_CAP) { atomicAdd(&bar[XB_TMO], 1u); break; } }
    }
    nloc = mine > 0u ? mine : 1u; nx = cnt > 0u ? cnt : 1u;
}

__device__ __forceinline__ void xcd_barrier(const XcdBarrier& b) {
    asm volatile("s_waitcnt vmcnt(0)" ::: "memory");
    __syncthreads();
    if (threadIdx.x == 0) {
        unsigned* bar = b.bar;
        __builtin_amdgcn_s_waitcnt(0);
        unsigned nloc = b.st[0], nx = b.st[1];
        if (nloc == 0u) { xcd_barrier_complete(bar, b.x, nloc, nx); b.st[0] = nloc; b.st[1] = nx; }
        const unsigned old = xb_add(&bar[XB_XSUB(b.x)], 1u);
        const unsigned gen = old / nloc;
        if (old + 1u == (gen + 1u) * nloc) {
            __builtin_amdgcn_fence(__ATOMIC_RELEASE, "agent");
            asm volatile("s_waitcnt vmcnt(0)" ::: "memory");
            const unsigned og = xb_add(&bar[XB_TOP], 1u);
            const unsigned tg = og / nx;
            if (og + 1u == (tg + 1u) * nx) xb_add(&bar[XB_TOPGEN], 1u);
            else XB_SPIN(xb_ld(&bar[XB_TOPGEN]) == tg, bar);
            __builtin_amdgcn_fence(__ATOMIC_ACQUIRE, "agent");
            xb_add(&bar[XB_XGEN(b.x)], 1u);
            asm volatile("s_waitcnt vmcnt(0)" ::: "memory");
        } else {
            XB_SPIN(xb_ld(&bar[XB_XGEN(b.x)]) == gen, bar);
            __builtin_amdgcn_fence(__ATOMIC_ACQUIRE, "agent");
            asm volatile("s_waitcnt vmcnt(0)" ::: "memory");
        }
    }
    __syncthreads();
}

#ifndef REP_OTHERS
#define REP_OTHERS 1
#endif
#if defined(ATT_MFMA32)
#define ATT_UNIT attn256_unit
#else
#define ATT_UNIT attn256_unit16
#endif
struct Args { const float* in[17]; float* out; unsigned char* ws; int ph_lo, ph_hi; };

__global__ void __launch_bounds__(NWAVES * 64, 2) mk_fwd(Args a) {
    extern __shared__ __attribute__((aligned(16))) unsigned char lds[];
    cg::grid_group grid = cg::this_grid();
#define tid ((int)threadIdx.x)
#define lane (tid & 63)
#define wave (__builtin_amdgcn_readfirstlane(tid >> 6))
#define G ((int)gridDim.x)
#define gw ((int)blockIdx.x * NWAVES + wave)
#define NGW (G * NWAVES)
    unsigned char* const ws = a.ws;
#define x_in (a.in[0])
#define out_p (a.out)
#define SS ((float*)(ws + WS_SS))
#define ropeC ((float*)(ws + WS_ROPE))
#define ropeS (ropeC + 8192 * 64)
#define Win_t ((bf16*)(ws + WS_WIN))
#define Wa_t ((bf16*)(ws + WS_WA))
#define Wb_t ((bf16*)(ws + WS_WB))
#define Wout_t ((bf16*)(ws + WS_WOUT))
#define Wup_t ((bf16*)(ws + WS_WUP))
#define Wdn_t ((bf16*)(ws + WS_WDN))
#define H1 ((bf16*)(ws + WS_H1))
#define ONb ((bf16*)(ws + WS_ON))
#define OAb ((bf16*)(ws + WS_OA))
#define H2 ((bf16*)(ws + WS_H2))
#define QKV ((bf16*)(ws + WS_QKV))
#define Tb ((bf16*)(ws + WS_T))
#define MX ((bf16*)(ws + WS_MX))
#define Ub ((bf16*)(ws + WS_U))
#define Gb ((bf16*)(ws + WS_G))
#define OD ((bf16*)(ws + WS_OD))
#define Yb ((bf16*)(ws + WS_Y))
#define Y2 ((bf16*)(ws + WS_Y2))
    const int lo = a.ph_lo, hi = a.ph_hi;
    for (int u = tid; u < (LDS_BYTES - 131072) / 4; u += NWAVES * 64) ((LAS unsigned*)((LAS unsigned char*)lds + 131072))[u] = 0u;
    __syncthreads();
    XcdBarrier bar = xcd_barrier_post((unsigned*)(ws + WS_CTL), (volatile LAS unsigned*)((LAS unsigned char*)lds + MISC_OFF) + 8);
    grid.sync();
#ifndef PHMASK
#define PHMASK 0x3ff
#endif
#define IN(k) (((PHMASK >> (k)) & 1) && lo <= (k) && (k) < hi)
#define SEAM(k) do { if (lo <= (k) && (k) + 1 < hi) xcd_barrier(bar); } while (0)

    if (IN(0)) {
        LAS float* scr = (LAS float*)((LAS unsigned char*)lds + wave * 16384);
        constexpr int I_IN = (DM / 64) * (NIN / 32), I_A = (1024 / 64) * (DM / 32), I_O = (DM / 64) * (DM / 32), I_UP = (DM / 64) * (DFF / 32), I_DN = (DFF / 64) * (DM / 32);
        constexpr int NITEMS = I_IN + 2 * I_A + I_O + I_UP + I_DN;
        for (int it = gw; it < NITEMS; it += NGW) {
            int r = it;
            if (r < I_IN) { p0_transpose_item<true>(a.in[1], DM, NIN, Win_t, scr, r, lane); continue; } r -= I_IN;
            if (r < I_A) { p0_transpose_item<false>(a.in[2], 1024, DM, Wa_t, scr, r, lane); continue; } r -= I_A;
            if (r < I_A) { p0_transpose_item<false>(a.in[3], 1024, DM, Wb_t, scr, r, lane); continue; } r -= I_A;
            if (r < I_O) { p0_transpose_item<false>(a.in[4], DM, DM, Wout_t, scr, r, lane); continue; } r -= I_O;
            if (r < I_UP) { p0_transpose_item<false>(a.in[15], DM, DFF, Wup_t, scr, r, lane); continue; } r -= I_UP;
            p0_transpose_item<false>(a.in[16], DFF, DM, Wdn_t, scr, r, lane);
        }
        for (int e = blockIdx.x * 512 + tid; e < 8192 * 64; e += G * 512) {
            const int pos = e >> 6, i = e & 63;
            const float inv = (float)exp(-(double)i * (9.210340371976184 / 64.0));
            const float ang = (float)pos * inv;
            const double t = (double)ang * 0.15915494309189535; const float fr = (float)(t - rint(t));
            ropeC[e] = __builtin_amdgcn_cosf(fr); ropeS[e] = __builtin_amdgcn_sinf(fr);
        }
        const float* g0 = a.in[5];
        f32x4 g0v[8];
#pragma unroll
        for (int j = 0; j < 8; ++j) g0v[j] = ((const f32x4*)g0)[lane + 64 * j];
        for (int m0 = gw; m0 < MTOK; m0 += 2 * NGW) {
            f32x4 v[2][8]; float s[2] = {0.f, 0.f};
#pragma unroll
            for (int q = 0; q < 2; ++q) { const f32x4* xr = (const f32x4*)(x_in + (size_t)(m0 + q * NGW) * DM) + lane;
#pragma unroll
                for (int j = 0; j < 8; ++j) v[q][j] = xr[64 * j]; }
#pragma unroll
            for (int q = 0; q < 2; ++q)
#pragma unroll
                for (int j = 0; j < 8; ++j) s[q] += (v[q][j].x * v[q][j].x + v[q][j].y * v[q][j].y) + (v[q][j].z * v[q][j].z + v[q][j].w * v[q][j].w);
#pragma unroll
            for (int q = 0; q < 2; ++q) { const float rstd = __builtin_amdgcn_rsqf(wave_sum(s[q]) * (1.f / DM) + EPS);
                u32x2v* o8 = (u32x2v*)(H1 + (size_t)(m0 + q * NGW) * DM) + lane;
#pragma unroll
                for (int j = 0; j < 8; ++j) { const f32x4 gv = g0v[j]; u32x2v w; w.x = pk2(v[q][j].x * rstd * gv.x, v[q][j].y * rstd * gv.y); w.y = pk2(v[q][j].z * rstd * gv.z, v[q][j].w * rstd * gv.w); o8[64 * j] = w; } }
        }
    }
#if defined(REP_P0)
    __syncthreads();
    if (IN(0)) {
        LAS float* scr = (LAS float*)((LAS unsigned char*)lds + wave * 16384);
        constexpr int I_IN = (DM / 64) * (NIN / 32), I_A = (1024 / 64) * (DM / 32), I_O = (DM / 64) * (DM / 32), I_UP = (DM / 64) * (DFF / 32), I_DN = (DFF / 64) * (DM / 32);
        constexpr int NITEMS = I_IN + 2 * I_A + I_O + I_UP + I_DN;
        for (int it = gw; it < NITEMS; it += NGW) {
            int r = it;
            if (r < I_IN) { p0_transpose_item<true>(a.in[1], DM, NIN, Win_t, scr, r, lane); continue; } r -= I_IN;
            if (r < I_A) { p0_transpose_item<false>(a.in[2], 1024, DM, Wa_t, scr, r, lane); continue; } r -= I_A;
            if (r < I_A) { p0_transpose_item<false>(a.in[3], 1024, DM, Wb_t, scr, r, lane); continue; } r -= I_A;
            if (r < I_O) { p0_transpose_item<false>(a.in[4], DM, DM, Wout_t, scr, r, lane); continue; } r -= I_O;
            if (r < I_UP) { p0_transpose_item<false>(a.in[15], DM, DFF, Wup_t, scr, r, lane); continue; } r -= I_UP;
            p0_transpose_item<false>(a.in[16], DFF, DM, Wdn_t, scr, r, lane);
        }
        for (int e = blockIdx.x * 512 + tid; e < 8192 * 64; e += G * 512) {
            const int pos = e >> 6, i = e & 63;
            const float inv = (float)exp(-(double)i * (9.210340371976184 / 64.0));
            const float ang = (float)pos * inv;
            const double t = (double)ang * 0.15915494309189535; const float fr = (float)(t - rint(t));
            ropeC[e] = __builtin_amdgcn_cosf(fr); ropeS[e] = __builtin_amdgcn_sinf(fr);
        }
        const float* g0 = a.in[5];
        f32x4 g0v[8];
#pragma unroll
        for (int j = 0; j < 8; ++j) g0v[j] = ((const f32x4*)g0)[lane + 64 * j];
        for (int m0 = gw; m0 < MTOK; m0 += 2 * NGW) {
            f32x4 v[2][8]; float s[2] = {0.f, 0.f};
#pragma unroll
            for (int q = 0; q < 2; ++q) { const f32x4* xr = (const f32x4*)(x_in + (size_t)(m0 + q * NGW) * DM) + lane;
#pragma unroll
                for (int j = 0; j < 8; ++j) v[q][j] = xr[64 * j]; }
#pragma unroll
            for (int q = 0; q < 2; ++q)
#pragma unroll
                for (int j = 0; j < 8; ++j) s[q] += (v[q][j].x * v[q][j].x + v[q][j].y * v[q][j].y) + (v[q][j].z * v[q][j].z + v[q][j].w * v[q][j].w);
#pragma unroll
            for (int q = 0; q < 2; ++q) { const float rstd = __builtin_amdgcn_rsqf(wave_sum(s[q]) * (1.f / DM) + EPS);
                u32x2v* o8 = (u32x2v*)(H1 + (size_t)(m0 + q * NGW) * DM) + lane;
#pragma unroll
                for (int j = 0; j < 8; ++j) { const f32x4 gv = g0v[j]; u32x2v w; w.x = pk2(v[q][j].x * rstd * gv.x, v[q][j].y * rstd * gv.y); w.y = pk2(v[q][j].z * rstd * gv.z, v[q][j].w * rstd * gv.w); o8[64 * j] = w; } }
        }
    }
#endif
    SEAM(0);
#if defined(REP_BAR)
    for (int rb = 0; rb < 20; ++rb) xcd_barrier(bar);
#endif
    if (IN(1)) {
#if defined(STAGGER_US)
        { const unsigned long long t0_ = __builtin_amdgcn_s_memrealtime(), dt_ = (unsigned long long)(((blockIdx.x >> 3) & 15) * (STAGGER_US * 100 / 16));
          while (__builtin_amdgcn_s_memrealtime() - t0_ < dt_) __builtin_amdgcn_s_sleep(8); }
#endif
        pg8::Gemm g{H1, Win_t, MTOK, NIN, DM}; pg8::StaticOrder S; S.init(MTOK, NIN, G, (int)blockIdx.x);
        pg8::EpiProj E{QKV, Gb, ropeC, ropeS};
        pg8::gemm_phase<pg8::EpiProj, pg8::StaticOrder, true, true>((LAS unsigned char*)lds, g, S, E);
    }
#if defined(REP_P1)
    __syncthreads();
    if (IN(1)) {
        pg8::Gemm g{H1, Win_t, MTOK, NIN, DM}; pg8::StaticOrder S; S.init(MTOK, NIN, G, (int)blockIdx.x);
        pg8::EpiProj E{QKV, Gb, ropeC, ropeS};
        pg8::gemm_phase<pg8::EpiProj, pg8::StaticOrder, true, true>((LAS unsigned char*)lds, g, S, E);
    }
#endif
    SEAM(1);
#if defined(DBG_STOP)
#define DBG_DUMP(k, off_mib, nseg) do { if (DBG_STOP == (k)) { xcd_barrier(bar); const bf16* rg = (const bf16*)(ws + (size_t)(off_mib) * MiB); \
        for (size_t i = (size_t)blockIdx.x * 512 + tid; i < (size_t)MTOK * DM; i += (size_t)G * 512) { float acc_ = 0.f; for (int sg = 0; sg < (nseg); ++sg) acc_ += __uint_as_float(((unsigned)rg[i + (size_t)sg * MTOK * DM]) << 16); out_p[i] = acc_; } return; } } while (0)
#else
#define DBG_DUMP(k, off_mib, nseg) do { } while (0)
#endif
    DBG_DUMP(1, 256, 5);
    DBG_DUMP(11, 256, 3);
    DBG_DUMP(12, 640, 2);
    if (IN(2)) {
#if !defined(ATT_D128X4)
        { int ntl = SEQ / 64; asm volatile("" : "+s"(ntl));
        const float s1_ = wave_sum(a.in[9][lane] * a.in[10][lane] + a.in[9][lane + 64] * a.in[10][lane + 64]);
        const float s2_ = wave_sum(a.in[11][lane] * a.in[12][lane] + a.in[11][lane + 64] * a.in[12][lane + 64]);
        const float lam_ = __uint_as_float(__builtin_amdgcn_readfirstlane(__float_as_uint(__builtin_amdgcn_exp2f(s1_ * 1.4426950408889634f) - __builtin_amdgcn_exp2f(s2_ * 1.4426950408889634f) + 0.2f)));
        for (int u = blockIdx.x; u < 512; u += G) {
            const int xs = u & 7, qb = (u >> 3) & 31, combo = (u >> 8) * 8 + xs, b = combo >> 2, h = combo & 3;
            const bf16* base = QKV + (size_t)b * 48 * SEQ * 128; bf16* odp = OD + ((size_t)b * SEQ + qb * 256) * 2048 + h * 512; bf16* oap = OAb + ((size_t)b * SEQ + qb * 256) * 1024 + h * 256;
            att::ATT_UNIT<0>(base + ((size_t)(2 * h) * SEQ + qb * 256) * 128, base + (size_t)(8 + 2 * h) * SEQ * 128, base + (size_t)(16 + 2 * h) * SEQ * 128, base + (size_t)(17 + 2 * h) * SEQ * 128,
                                 odp, ntl, (char*)lds, (LAS unsigned char*)lds, oap, a.in[13], lam_, EPS, 0.8f);
            att::ATT_UNIT<1>(base + ((size_t)(2 * h + 1) * SEQ + qb * 256) * 128, base + (size_t)(9 + 2 * h) * SEQ * 128, base + (size_t)(16 + 2 * h) * SEQ * 128, base + (size_t)(17 + 2 * h) * SEQ * 128,
                                 odp, ntl, (char*)lds, (LAS unsigned char*)lds, oap, a.in[13], lam_, EPS, 0.8f);
        }
#if defined(REP_ATT)
        for (int u = blockIdx.x; u < 512; u += G) {
            const int xs = u & 7, qb = (u >> 3) & 31, combo = (u >> 8) * 8 + xs, b = combo >> 2, h = combo & 3;
            const bf16* base = QKV + (size_t)b * 48 * SEQ * 128; bf16* odp = OD + ((size_t)b * SEQ + qb * 256) * 2048 + h * 512; bf16* oap = OAb + ((size_t)b * SEQ + qb * 256) * 1024 + h * 256;
            att::ATT_UNIT<0>(base + ((size_t)(2 * h) * SEQ + qb * 256) * 128, base + (size_t)(8 + 2 * h) * SEQ * 128, base + (size_t)(16 + 2 * h) * SEQ * 128, base + (size_t)(17 + 2 * h) * SEQ * 128,
                                 odp, ntl, (char*)lds, (LAS unsigned char*)lds, oap, a.in[13], lam_, EPS, 0.8f);
            att::ATT_UNIT<1>(base + ((size_t)(2 * h + 1) * SEQ + qb * 256) * 128, base + (size_t)(9 + 2 * h) * SEQ * 128, base + (size_t)(16 + 2 * h) * SEQ * 128, base + (size_t)(17 + 2 * h) * SEQ * 128,
                                 odp, ntl, (char*)lds, (LAS unsigned char*)lds, oap, a.in[13], lam_, EPS, 0.8f);
        }
#endif
        }
#else
#ifndef NO_DENSE
        int seqv = SEQ; asm volatile("" : "+s"(seqv));
        for (int u = blockIdx.x; u < 2048; u += G) {
            const int xs = u & 7, qb = (u >> 3) & 31, combo = (u >> 8) * 8 + xs, b = combo >> 4, vh = combo & 15, h = vh >> 2, c = (vh >> 1) & 1, hf = vh & 1;
            const bf16* base = QKV + (size_t)b * 48 * SEQ * 128;
            att::attn_dense_body<bf16>(base + ((size_t)(h * 2 + c) * SEQ + qb * 256) * 128, base + (size_t)(8 + h * 2 + c) * SEQ * 128, base + (size_t)(16 + h * 2 + hf) * SEQ * 128,
                                       OD + ((size_t)b * SEQ + qb * 256) * 2048 + vh * 128, seqv, (char*)lds);
            __syncthreads();
        }
#if defined(REP_DENSE)
        int seqv2 = SEQ; asm volatile("" : "+s"(seqv2));
        for (int u = blockIdx.x; u < 2048; u += G) {
            const int xs = u & 7, qb = (u >> 3) & 31, combo = (u >> 8) * 8 + xs, b = combo >> 4, vh = combo & 15, h = vh >> 2, c = (vh >> 1) & 1, hf = vh & 1;
            const bf16* base = QKV + (size_t)b * 48 * SEQ * 128;
            att::attn_dense_body<bf16>(base + ((size_t)(h * 2 + c) * SEQ + qb * 256) * 128, base + (size_t)(8 + h * 2 + c) * SEQ * 128, base + (size_t)(16 + h * 2 + hf) * SEQ * 128,
                                       OD + ((size_t)b * SEQ + qb * 256) * 2048 + vh * 128, seqv2, (char*)lds);
            __syncthreads();
        }
#endif
#endif
#endif
#ifndef NO_NA
            for (int u = blockIdx.x; u < 1024; u += G) {
            const int xs = u & 7, rb = (u >> 3) & 31, combo = (u >> 8) * 8 + xs, b = combo >> 3, h = combo & 7;
            att::na_unit(QKV, ONb, a.in[14], b, h, rb, (char*)lds);
        }
#if defined(REP_NA)
            for (int u = blockIdx.x; u < 1024; u += G) {
            const int xs = u & 7, rb = (u >> 3) & 31, combo = (u >> 8) * 8 + xs, b = combo >> 3, h = combo & 7;
            att::na_unit(QKV, ONb, a.in[14], b, h, rb, (char*)lds);
        }
#endif
#endif
    }
    SEAM(2);
    DBG_DUMP(2, 896, 1);
    DBG_DUMP(22, 128, 1);
#if defined(ATT_D128X4)
    if (IN(3)) {
        const float s1 = wave_sum(a.in[9][lane] * a.in[10][lane] + a.in[9][lane + 64] * a.in[10][lane + 64]);
        const float s2 = wave_sum(a.in[11][lane] * a.in[12][lane] + a.in[11][lane + 64] * a.in[12][lane + 64]);
        const float lam = __builtin_amdgcn_exp2f(s1 * 1.4426950408889634f) - __builtin_amdgcn_exp2f(s2 * 1.4426950408889634f) + 0.2f;
        const f32x4 sw = ((const f32x4*)a.in[13])[lane];
        for (int m = gw; m < MTOK; m += NGW) {
#pragma unroll
            for (int h = 0; h < 4; ++h) {
                const bf16* od = OD + (size_t)m * 2048 + h * 512 + 4 * lane;
                const u32x2v p = *(const u32x2v*)od, q = *(const u32x2v*)(od + 256);
                f32x4 d;
                d.x = __uint_as_float(p.x << 16) - lam * __uint_as_float(q.x << 16); d.y = __uint_as_float(p.x & 0xffff0000u) - lam * __uint_as_float(q.x & 0xffff0000u);
                d.z = __uint_as_float(p.y << 16) - lam * __uint_as_float(q.y << 16); d.w = __uint_as_float(p.y & 0xffff0000u) - lam * __uint_as_float(q.y & 0xffff0000u);
                const float rstd = __builtin_amdgcn_rsqf(wave_sum((d.x * d.x + d.y * d.y) + (d.z * d.z + d.w * d.w)) * (1.f / 256.f) + EPS) * 0.8f;
                u32x2v w; w.x = pk2(d.x * rstd * sw.x, d.y * rstd * sw.y); w.y = pk2(d.z * rstd * sw.z, d.w * rstd * sw.w);
                *(u32x2v*)(OAb + (size_t)m * 1024 + h * 256 + 4 * lane) = w;
            }
        }
    }
#if defined(REP_P3)
    __syncthreads();
    if (IN(3)) {
        const float s1 = wave_sum(a.in[9][lane] * a.in[10][lane] + a.in[9][lane + 64] * a.in[10][lane + 64]);
        const float s2 = wave_sum(a.in[11][lane] * a.in[12][lane] + a.in[11][lane + 64] * a.in[12][lane + 64]);
        const float lam = __builtin_amdgcn_exp2f(s1 * 1.4426950408889634f) - __builtin_amdgcn_exp2f(s2 * 1.4426950408889634f) + 0.2f;
        const f32x4 sw = ((const f32x4*)a.in[13])[lane];
        for (int m = gw; m < MTOK; m += NGW) {
#pragma unroll
            for (int h = 0; h < 4; ++h) {
                const bf16* od = OD + (size_t)m * 2048 + h * 512 + 4 * lane;
                const u32x2v p = *(const u32x2v*)od, q = *(const u32x2v*)(od + 256);
                f32x4 d;
                d.x = __uint_as_float(p.x << 16) - lam * __uint_as_float(q.x << 16); d.y = __uint_as_float(p.x & 0xffff0000u) - lam * __uint_as_float(q.x & 0xffff0000u);
                d.z = __uint_as_float(p.y << 16) - lam * __uint_as_float(q.y << 16); d.w = __uint_as_float(p.y & 0xffff0000u) - lam * __uint_as_float(q.y & 0xffff0000u);
                const float rstd = __builtin_amdgcn_rsqf(wave_sum((d.x * d.x + d.y * d.y) + (d.z * d.z + d.w * d.w)) * (1.f / 256.f) + EPS) * 0.8f;
                u32x2v w; w.x = pk2(d.x * rstd * sw.x, d.y * rstd * sw.y); w.y = pk2(d.z * rstd * sw.z, d.w * rstd * sw.w);
                *(u32x2v*)(OAb + (size_t)m * 1024 + h * 256 + 4 * lane) = w;
            }
        }
    }
#endif
    SEAM(3);
#endif
    DBG_DUMP(3, 128, 1);
    if (IN(4)) {
        { pg8::Gemm g{OAb, Wa_t, MTOK, DM, 1024}; pg8::StaticOrder S; S.init(MTOK, DM, G, (int)blockIdx.x);
          pg8::EpiBranch<0> E{Gb, Tb, MX};
          pg8::gemm_phase<pg8::EpiBranch<0>, pg8::StaticOrder, true, true>((LAS unsigned char*)lds, g, S, E); }
        asm volatile("s_waitcnt vmcnt(0)" ::: "memory"); __syncthreads();
        { pg8::Gemm g{ONb, Wb_t, MTOK, DM, 1024}; pg8::StaticOrder S; S.init(MTOK, DM, G, (int)blockIdx.x);
          pg8::EpiBranch<1> E{Gb, Tb, MX};
          pg8::gemm_phase<pg8::EpiBranch<1>, pg8::StaticOrder, true, true>((LAS unsigned char*)lds, g, S, E); }
    }
#if defined(REP_P4)
    __syncthreads();
    if (IN(4)) {
        { pg8::Gemm g{OAb, Wa_t, MTOK, DM, 1024}; pg8::StaticOrder S; S.init(MTOK, DM, G, (int)blockIdx.x);
          pg8::EpiBranch<0> E{Gb, Tb, MX};
          pg8::gemm_phase<pg8::EpiBranch<0>, pg8::StaticOrder, true, true>((LAS unsigned char*)lds, g, S, E); }
        asm volatile("s_waitcnt vmcnt(0)" ::: "memory"); __syncthreads();
        { pg8::Gemm g{ONb, Wb_t, MTOK, DM, 1024}; pg8::StaticOrder S; S.init(MTOK, DM, G, (int)blockIdx.x);
          pg8::EpiBranch<1> E{Gb, Tb, MX};
          pg8::gemm_phase<pg8::EpiBranch<1>, pg8::StaticOrder, true, true>((LAS unsigned char*)lds, g, S, E); }
    }
#endif
    SEAM(4);
    DBG_DUMP(4, 512, 1);
    DBG_DUMP(41, 256, 2);
    if (IN(5)) {
        pg8::Gemm g{MX, Wout_t, MTOK, DM, DM}; pg8::StaticOrder S; S.init(MTOK, DM, G, (int)blockIdx.x);
        pg8::EpiYss<bf16> E{Yb, SS};
        pg8::gemm_phase<pg8::EpiYss<bf16>, pg8::StaticOrder, true, true>((LAS unsigned char*)lds, g, S, E);
    }
#if defined(REP_P5)
    __syncthreads();
    if (IN(5)) {
        pg8::Gemm g{MX, Wout_t, MTOK, DM, DM}; pg8::StaticOrder S; S.init(MTOK, DM, G, (int)blockIdx.x);
        pg8::EpiYss<bf16> E{Yb, SS};
        pg8::gemm_phase<pg8::EpiYss<bf16>, pg8::StaticOrder, true, true>((LAS unsigned char*)lds, g, S, E);
    }
#endif
    SEAM(5);
    DBG_DUMP(5, 896, 1);
    if (IN(6)) {
        const float* g1 = a.in[6]; const float* g2 = a.in[7];
        f32x4 g1v[8], g2v[8];
#pragma unroll
        for (int j = 0; j < 8; ++j) { g1v[j] = ((const f32x4*)g1)[lane + 64 * j]; g2v[j] = ((const f32x4*)g2)[lane + 64 * j]; }
        for (int m0 = gw; m0 < MTOK; m0 += 2 * NGW) {
            f32x4 v[2][8]; u32x2v yw[2][8]; float ssv[2];
#pragma unroll
            for (int q = 0; q < 2; ++q) { const size_t m = (size_t)(m0 + q * NGW); ssv[q] = lane < 32 ? SS[m * 32 + lane] : 0.f;
                const f32x4* xr = (const f32x4*)(x_in + m * DM) + lane; const u32x2v* yr = (const u32x2v*)(Yb + m * DM) + lane;
#pragma unroll
                for (int j = 0; j < 8; ++j) { v[q][j] = xr[64 * j]; yw[q][j] = yr[64 * j]; } }
#pragma unroll
            for (int q = 0; q < 2; ++q) { const size_t m = (size_t)(m0 + q * NGW);
                const float rstd = __builtin_amdgcn_rsqf(wave_sum(ssv[q]) * (1.f / DM) + EPS); f32x4* orow = (f32x4*)(out_p + m * DM) + lane; float s = 0.f;
#pragma unroll
                for (int j = 0; j < 8; ++j) { const f32x4 gv = g1v[j]; const u32x2v w = yw[q][j];
                    f32x4 y; y.x = __uint_as_float(w.x << 16); y.y = __uint_as_float(w.x & 0xffff0000u); y.z = __uint_as_float(w.y << 16); y.w = __uint_as_float(w.y & 0xffff0000u);
                    v[q][j] = v[q][j] + y * rstd * gv; orow[64 * j] = v[q][j];
                    s += (v[q][j].x * v[q][j].x + v[q][j].y * v[q][j].y) + (v[q][j].z * v[q][j].z + v[q][j].w * v[q][j].w); }
                const float rstd1 = __builtin_amdgcn_rsqf(wave_sum(s) * (1.f / DM) + EPS);
                u32x2v* o8 = (u32x2v*)(H2 + m * DM) + lane;
#pragma unroll
                for (int j = 0; j < 8; ++j) { const f32x4 gv = g2v[j]; u32x2v w; w.x = pk2(v[q][j].x * rstd1 * gv.x, v[q][j].y * rstd1 * gv.y); w.y = pk2(v[q][j].z * rstd1 * gv.z, v[q][j].w * rstd1 * gv.w); o8[64 * j] = w; } }
        }
    }
#if defined(REP_P6)
    __syncthreads();
    if (IN(6)) {
        const float* g1 = a.in[6]; const float* g2 = a.in[7];
        f32x4 g1v[8], g2v[8];
#pragma unroll
        for (int j = 0; j < 8; ++j) { g1v[j] = ((const f32x4*)g1)[lane + 64 * j]; g2v[j] = ((const f32x4*)g2)[lane + 64 * j]; }
        for (int m0 = gw; m0 < MTOK; m0 += 2 * NGW) {
            f32x4 v[2][8]; u32x2v yw[2][8]; float ssv[2];
#pragma unroll
            for (int q = 0; q < 2; ++q) { const size_t m = (size_t)(m0 + q * NGW); ssv[q] = lane < 32 ? SS[m * 32 + lane] : 0.f;
                const f32x4* xr = (const f32x4*)(x_in + m * DM) + lane; const u32x2v* yr = (const u32x2v*)(Yb + m * DM) + lane;
#pragma unroll
                for (int j = 0; j < 8; ++j) { v[q][j] = xr[64 * j]; yw[q][j] = yr[64 * j]; } }
#pragma unroll
            for (int q = 0; q < 2; ++q) { const size_t m = (size_t)(m0 + q * NGW);
                const float rstd = __builtin_amdgcn_rsqf(wave_sum(ssv[q]) * (1.f / DM) + EPS); f32x4* orow = (f32x4*)(out_p + m * DM) + lane; float s = 0.f;
#pragma unroll
                for (int j = 0; j < 8; ++j) { const f32x4 gv = g1v[j]; const u32x2v w = yw[q][j];
                    f32x4 y; y.x = __uint_as_float(w.x << 16); y.y = __uint_as_float(w.x & 0xffff0000u); y.z = __uint_as_float(w.y << 16); y.w = __uint_as_float(w.y & 0xffff0000u);
                    v[q][j] = v[q][j] + y * rstd * gv; orow[64 * j] = v[q][j];
                    s += (v[q][j].x * v[q][j].x + v[q][j].y * v[q][j].y) + (v[q][j].z * v[q][j].z + v[q][j].w * v[q][j].w); }
                const float rstd1 = __builtin_amdgcn_rsqf(wave_sum(s) * (1.f / DM) + EPS);
                u32x2v* o8 = (u32x2v*)(H2 + m * DM) + lane;
#pragma unroll
                for (int j = 0; j < 8; ++j) { const f32x4 gv = g2v[j]; u32x2v w; w.x = pk2(v[q][j].x * rstd1 * gv.x, v[q][j].y * rstd1 * gv.y); w.y = pk2(v[q][j].z * rstd1 * gv.z, v[q][j].w * rstd1 * gv.w); o8[64 * j] = w; } }
        }
    }
#endif
    SEAM(6);
    DBG_DUMP(6, 128, 1);
    if (IN(7)) {
#if defined(STAGGER_US)
        { const unsigned long long t0_ = __builtin_amdgcn_s_memrealtime(), dt_ = (unsigned long long)(((blockIdx.x >> 3) & 15) * (STAGGER_US * 100 / 16));
          while (__builtin_amdgcn_s_memrealtime() - t0_ < dt_) __builtin_amdgcn_s_sleep(8); }
#endif
        pg8::Gemm g{H2, Wup_t, MTOK, DFF, DM}; pg8::StaticOrder S; S.init(MTOK, DFF, G, (int)blockIdx.x);
        pg8::EpiRelu2 E{Ub, DFF};
        pg8::gemm_phase<pg8::EpiRelu2, pg8::StaticOrder, true, true>((LAS unsigned char*)lds, g, S, E);
    }
#if defined(REP_P7)
    __syncthreads();
    if (IN(7)) {
        pg8::Gemm g{H2, Wup_t, MTOK, DFF, DM}; pg8::StaticOrder S; S.init(MTOK, DFF, G, (int)blockIdx.x);
        pg8::EpiRelu2 E{Ub, DFF};
        pg8::gemm_phase<pg8::EpiRelu2, pg8::StaticOrder, true, true>((LAS unsigned char*)lds, g, S, E);
    }
#endif
    SEAM(7);
    DBG_DUMP(7, 256, 4);
    if (IN(8)) {
#if defined(FUSE_P8)
        pg8::Gemm g{Ub, Wdn_t, MTOK, DM, DFF}; pg8::PanelOrder S; S.init((int)blockIdx.x);
        pg8::EpiFinal E{out_p, a.in[8], SS, (unsigned*)(ws + WS_CNT), EPS};
        pg8::gemm_phase<pg8::EpiFinal, pg8::PanelOrder, true, true>((LAS unsigned char*)lds, g, S, E);
#else
        pg8::Gemm g{Ub, Wdn_t, MTOK, DM, DFF}; pg8::StaticOrder S; S.init(MTOK, DM, G, (int)blockIdx.x);
        pg8::EpiYss<bf16> E{Y2, SS};
        pg8::gemm_phase<pg8::EpiYss<bf16>, pg8::StaticOrder, true, true>((LAS unsigned char*)lds, g, S, E);
#endif
    }
#if !defined(FUSE_P8)
    SEAM(8);
    if (IN(9)) {
        const float* g3 = a.in[8];
        f32x4 g3v[8];
#pragma unroll
        for (int j = 0; j < 8; ++j) g3v[j] = ((const f32x4*)g3)[lane + 64 * j];
        for (int m0 = gw; m0 < MTOK; m0 += 2 * NGW) {
            f32x4 v[2][8]; u32x2v yw[2][8]; float ssv[2];
#pragma unroll
            for (int q = 0; q < 2; ++q) { const size_t m = (size_t)(m0 + q * NGW); ssv[q] = lane < 32 ? SS[m * 32 + lane] : 0.f;
                const f32x4* xr = (const f32x4*)(out_p + m * DM) + lane; const u32x2v* yr = (const u32x2v*)(Y2 + m * DM) + lane;
#pragma unroll
                for (int j = 0; j < 8; ++j) { v[q][j] = xr[64 * j]; yw[q][j] = yr[64 * j]; } }
#pragma unroll
            for (int q = 0; q < 2; ++q) { const size_t m = (size_t)(m0 + q * NGW);
                const float rstd = __builtin_amdgcn_rsqf(wave_sum(ssv[q]) * (1.f / DM) + EPS); f32x4* orow = (f32x4*)(out_p + m * DM) + lane;
#pragma unroll
                for (int j = 0; j < 8; ++j) { const f32x4 gv = g3v[j]; const u32x2v w = yw[q][j];
                    f32x4 y; y.x = __uint_as_float(w.x << 16); y.y = __uint_as_float(w.x & 0xffff0000u); y.z = __uint_as_float(w.y << 16); y.w = __uint_as_float(w.y & 0xffff0000u);
                    orow[64 * j] = v[q][j] + y * rstd * gv; } }
        }
    }
#endif
#undef IN
#undef SEAM
#undef tid
#undef lane
#undef wave
#undef G
#undef gw
#undef NGW
}

extern "C" void kernel_launch(void* const* d_in, const int* in_sizes, int n_in, void* d_out, int out_size, void* d_ws, size_t ws_size, hipStream_t stream) {
    static int grid = 0;
    if (grid == 0) {
        if (n_in != 17 || in_sizes[0] != MTOK * DM || out_size != MTOK * DM || ws_size < WS_END) { fprintf(stderr, "kernel_launch: shape/workspace mismatch: n_in %d in0 %d out %d ws %zu (need %zu)\n", n_in, n_in > 0 ? in_sizes[0] : -1, out_size, ws_size, (size_t)WS_END); grid = -1; return; }
        int dev = 0, cus = 0, per_cu = 0;
        (void)hipGetDevice(&dev); (void)hipDeviceGetAttribute(&cus, hipDeviceAttributeMultiprocessorCount, dev);
        if (hipFuncSetAttribute((const void*)mk_fwd, hipFuncAttributeMaxDynamicSharedMemorySize, LDS_BYTES) != hipSuccess) { fprintf(stderr, "kernel_launch: hipFuncSetAttribute failed\n"); grid = -1; return; }
        if (hipOccupancyMaxActiveBlocksPerMultiprocessor(&per_cu, (const void*)mk_fwd, NWAVES * 64, LDS_BYTES) != hipSuccess || per_cu < 1) { fprintf(stderr, "kernel_launch: occupancy query says %d\n", per_cu); per_cu = 1; }
        (void)hipGetLastError();
        grid = cus * per_cu;
        if (grid != 256) fprintf(stderr, "kernel_launch: grid %d != 256: the fused-norm phases need exactly 256 workgroups\n", grid);
        if (grid > 256) grid = 256;
    }
    if (grid < 0) return;
    if (hipMemsetAsync((char*)d_ws + WS_CTL, 0, CTL_ZERO_BYTES, stream) != hipSuccess) { fprintf(stderr, "kernel_launch: hipMemsetAsync failed\n"); return; }
    Args a{};
    for (int i = 0; i < 17; ++i) a.in[i] = (const float*)d_in[i];
    a.out = (float*)d_out; a.ws = (unsigned char*)d_ws; a.ph_lo = 0; a.ph_hi = 10;
    void* args[] = {&a};
    hipError_t e = hipLaunchCooperativeKernel((const void*)mk_fwd, dim3(grid), dim3(NWAVES * 64), args, LDS_BYTES, stream);
    if (e != hipSuccess) fprintf(stderr, "kernel_launch: cooperative launch failed: %s (grid %d)\n", hipGetErrorString(e), grid);
}
```
